# Optimizing an MI355X kernel written in HIP

```python
import jax
import jax.numpy as jnp
from jax import lax
import numpy as np

D_MODEL = 1024
BATCH = 2
SEQ = 8192
DEPTH = 1

GRID_W = 64
CTX_LEN = 256
N_DIR = 2
RET_HEADS = 4
RET_DK = 128
RET_DV = 128
RET_WIDTH = RET_HEADS * RET_DV
RET_CHUNK = 128
RWKV_HEADS = 8
RWKV_N = 64
RWKV_WIDTH = RWKV_HEADS * RWKV_N
DECAY_LORA = 32
AAA_LORA = 32
GATE_LORA = 96
D_FF = 2816
N_MOD = 9
ROPE_BASE = 10000.0
NORM_EPS = 1e-6
RET_GN_EPS = 1e-5
RWKV_GN_EPS = 64e-5
IN_SPLITS = (RET_WIDTH, 2 * RET_WIDTH, 3 * RET_WIDTH, 4 * RET_WIDTH,
             4 * RET_WIDTH + RWKV_WIDTH, 4 * RET_WIDTH + 2 * RWKV_WIDTH, 4 * RET_WIDTH + 3 * RWKV_WIDTH,
             4 * RET_WIDTH + 3 * RWKV_WIDTH + D_MODEL)
IN_WIDTH = 4 * RET_WIDTH + 3 * RWKV_WIDTH + 2 * D_MODEL

kernel_name = 'hybrid_retention_rwkv7_macaron_dit'


def rms_norm(x, g):
    xf = x.astype(jnp.float32)
    y = xf * lax.rsqrt(jnp.mean(xf * xf, axis=-1, keepdims=True) + NORM_EPS)
    return (y * g.astype(jnp.float32)).astype(x.dtype)


def modulate(t, shift, scale):
    return t * (1.0 + scale) + shift


def swiglu(t, w_gate, w_up, w_down):
    return (jax.nn.silu(t @ w_gate) * (t @ w_up)) @ w_down


def split_heads(t, n_heads):
    return t.reshape(t.shape[:-1] + (n_heads, t.shape[-1] // n_heads))


def head_norm(y, eps):
    mu = jnp.mean(y, axis=-1, keepdims=True)
    var = jnp.mean(jnp.square(y - mu), axis=-1, keepdims=True)
    return (y - mu) * lax.rsqrt(var + eps)


def centred_shift(z):
    zp = jnp.pad(z, ((0, 0), (1, 1), (0, 0)))
    return 0.5 * (zp[:, :-2] + zp[:, 2:])


def axial_rope(t, rows, cols):
    half = t.shape[-1] // 2
    n_freq = half // 2
    inv = ROPE_BASE ** (-jnp.arange(n_freq, dtype=jnp.float32) / n_freq)

    def rot(z, pos):
        ang = pos.astype(jnp.float32)[:, None] * inv[None, :]
        cos = jnp.cos(ang)[None, :, None, :]
        sin = jnp.sin(ang)[None, :, None, :]
        z1, z2 = z[..., :n_freq], z[..., n_freq:]
        return jnp.concatenate([z1 * cos - z2 * sin, z1 * sin + z2 * cos], axis=-1)

    return jnp.concatenate([rot(t[..., :half], rows), rot(t[..., half:], cols)], axis=-1)


def retention_chunks(q, k, v, log_gamma, state0):
    nd, bsz, length, nh, _ = q.shape
    n_chunks = length // RET_CHUNK
    idx = jnp.arange(RET_CHUNK)
    diff = idx[:, None] - idx[None, :]
    mask = diff[None] >= jnp.arange(nd)[:, None, None]
    lg = log_gamma[:, :, None, None]
    expo = jnp.where(mask[:, None], diff.astype(jnp.float32)[None, None], 0.0)
    intra = jnp.where(mask[:, None], jnp.exp(expo * lg), 0.0)
    idx_f = idx.astype(jnp.float32)
    dq = jnp.exp((idx_f + 1.0)[None, None, :] * log_gamma[:, :, None])
    dkk = jnp.exp((RET_CHUNK - 1.0 - idx_f)[None, None, :] * log_gamma[:, :, None])
    dq_t = jnp.swapaxes(dq, 1, 2)[:, None, :, :, None]
    dk_t = jnp.swapaxes(dkk, 1, 2)[:, None, :, :, None]
    dchunk = jnp.exp(RET_CHUNK * log_gamma)[:, None, :, None, None]

    def to_chunks(t):
        return jnp.moveaxis(t.reshape(nd, bsz, n_chunks, RET_CHUNK, nh, t.shape[-1]), 2, 0)

    def step(state, inp):
        qc, kc, vc = inp
        s = jnp.einsum('zbihd,zbjhd->zbhij', qc, kc) * intra[:, None]
        y = (jnp.einsum('zbhij,zbjhe->zbihe', s, vc)
             + jnp.einsum('zbihd,zbhde->zbihe', qc * dq_t, state))
        state = dchunk * state + jnp.einsum('zbjhd,zbjhe->zbhde', kc * dk_t, vc)
        return state, y

    state, ys = lax.scan(step, state0, (to_chunks(q), to_chunks(k), to_chunks(v)))
    y = jnp.moveaxis(ys, 0, 2).reshape(nd, bsz, length, nh, v.shape[-1])
    return y, state


def retention_segment(q, k, v, log_gamma, state0):
    both = lambda t: jnp.stack([t, jnp.flip(t, 1)])
    y, state = retention_chunks(both(q), both(k), both(v), log_gamma, state0)
    return y[0] + jnp.flip(y[1], 1), state


def retention_readout(y, g_raw):
    bsz, length = y.shape[:2]
    return jax.nn.silu(g_raw.astype(jnp.float32)) * head_norm(y, RET_GN_EPS).reshape(bsz, length, RET_WIDTH)


def rwkv_prepare(u, pr, pk, pv, mu_rkv, mu_x, w0, w1, w2, a0, a1, a2, k_k, k_a):
    f32 = jnp.float32
    u, pr, pk, pv = (t.astype(f32) for t in (u, pr, pk, pv))
    r = pr + mu_rkv[0] * (centred_shift(pr) - pr)
    k = pk + mu_rkv[1] * (centred_shift(pk) - pk)
    v = pv + mu_rkv[2] * (centred_shift(pv) - pv)
    du = centred_shift(u) - u
    xw = u + mu_x[0] * du
    xa = u + mu_x[1] * du
    xg = u + mu_x[2] * du
    w_pre = w0[:, None, None, :] + jnp.einsum('zblr,zrc->zblc', jnp.tanh(jnp.einsum('bld,zdr->zblr', xw, w1)), w2)
    decay = jnp.exp(-jnp.exp(-jax.nn.softplus(-w_pre) - 0.5))
    a = jax.nn.sigmoid(a0[:, None, None, :] + jnp.einsum('zblr,zrc->zblc', jnp.einsum('bld,zdr->zblr', xa, a1), a2))
    kk = split_heads(k * k_k, RWKV_HEADS)
    kk = (kk / jnp.maximum(jnp.sqrt(jnp.sum(kk * kk, axis=-1, keepdims=True)), 1e-12)).reshape(k.shape)
    k_eff = k[None] * (1.0 + (a - 1.0) * k_a)
    b_vec = kk[None] * a
    per_dir = lambda t: split_heads(jnp.stack([t[0], jnp.flip(t[1], 1)]), RWKV_HEADS)
    shared = lambda t: split_heads(jnp.stack([t, jnp.flip(t, 1)]), RWKV_HEADS)
    scan_in = (shared(r), per_dir(decay), per_dir(k_eff), shared(v), shared(-kk), per_dir(b_vec))
    return scan_in, r, k_eff[0], v, xg


def rwkv7_scan(r, w, k, v, a, b, state0):
    is_fwd = (jnp.arange(N_DIR) == 0)[:, None, None, None]

    def step(s, inp):
        rt, wt, kt, vt, at, bt = inp
        sa = jnp.einsum('zbhvk,zbhk->zbhv', s, at)
        s_new = s * wt[..., None, :] + sa[..., :, None] * bt[..., None, :] + vt[..., :, None] * kt[..., None, :]
        y = jnp.where(is_fwd, jnp.einsum('zbhvk,zbhk->zbhv', s_new, rt), jnp.einsum('zbhvk,zbhk->zbhv', s, rt))
        return s_new, y

    xs = tuple(jnp.moveaxis(t, 2, 0) for t in (r, w, k, v, a, b))
    state, ys = lax.scan(step, state0, xs)
    y = jnp.moveaxis(ys, 0, 2)
    return y[0] + jnp.flip(y[1], 1), state


def rwkv_readout(y, r, k, v, xg, g1, g2, r_k, ln_w, ln_b):
    bsz, length = y.shape[:2]
    yn = head_norm(y, RWKV_GN_EPS).reshape(bsz, length, RWKV_WIDTH) * ln_w + ln_b
    bonus = jnp.sum(split_heads(r * k, RWKV_HEADS) * r_k, axis=-1, keepdims=True) * split_heads(v, RWKV_HEADS)
    g = jax.nn.sigmoid(xg @ g1) @ g2
    return (yn + bonus.reshape(bsz, length, RWKV_WIDTH)) * g


def parallel_mixer(uc, ul, rows, cols, w_in, ret_decay_logit, w_ret_o, mu_rkv, mu_x, w0, w1, w2, a0, a1, a2,
                   g1, g2, k_k, k_a, r_k, ln_w, ln_b, w_rwkv_o, w_out, with_ctx_out):
    f32 = jnp.float32
    bsz = ul.shape[0]
    dt = ul.dtype
    c_q, c_k, c_v, c_g, c_r, c_rk, c_rv, c_gret, c_grw = jnp.split(uc @ w_in, IN_SPLITS, axis=-1)
    l_q, l_k, l_v, l_g, l_r, l_rk, l_rv, l_gret, l_grw = jnp.split(ul @ w_in, IN_SPLITS, axis=-1)

    log_gamma = jax.nn.log_sigmoid(ret_decay_logit.astype(f32))
    k_scale = RET_DK ** -0.5
    hd = lambda t: split_heads(t.astype(f32), RET_HEADS)
    ret_state0 = jnp.zeros((N_DIR, bsz, RET_HEADS, RET_DK, RET_DV), f32)
    y_ret_c, ret_state_c = retention_segment(hd(c_q), hd(c_k) * k_scale, hd(c_v), log_gamma, ret_state0)
    y_ret_l, _ = retention_segment(axial_rope(hd(l_q), rows, cols), axial_rope(hd(l_k), rows, cols) * k_scale,
                                   hd(l_v), log_gamma, ret_state_c)

    lora = (mu_rkv, mu_x, w0, w1, w2, a0, a1, a2, k_k, k_a)
    scan_c, r_c, k_c, v_c, xg_c = rwkv_prepare(uc, c_r, c_rk, c_rv, *lora)
    scan_l, r_l, k_l, v_l, xg_l = rwkv_prepare(ul, l_r, l_rk, l_rv, *lora)
    rw_state0 = jnp.zeros((N_DIR, bsz, RWKV_HEADS, RWKV_N, RWKV_N), f32)
    y_rw_c, rw_state_c = rwkv7_scan(*scan_c, rw_state0)
    y_rw_l, _ = rwkv7_scan(*scan_l, rw_state_c)

    def merge(y_ret, g_ret, y_rw, r, k, v, xg, gate_ret, gate_rw):
        ret_out = retention_readout(y_ret, g_ret).astype(dt) @ w_ret_o
        rw_out = rwkv_readout(y_rw, r, k, v, xg, g1, g2, r_k, ln_w, ln_b).astype(dt) @ w_rwkv_o
        return (jax.nn.sigmoid(gate_ret) * ret_out + jax.nn.sigmoid(gate_rw) * rw_out) @ w_out

    out_l = merge(y_ret_l, l_g, y_rw_l, r_l, k_l, v_l, xg_l, l_gret, l_grw)
    if with_ctx_out:
        return out_l, merge(y_ret_c, c_g, y_rw_c, r_c, k_c, v_c, xg_c, c_gret, c_grw)
    return out_l, None


def setup_inputs(seed: int = 0) -> dict:
    key = jax.random.key(seed)
    keys = iter(jax.random.split(key, 48))
    f32 = jnp.float32
    nrm = lambda shape, scale: scale * jax.random.normal(next(keys), shape, f32)
    uni = lambda shape, lo, hi: jax.random.uniform(next(keys), shape, f32, lo, hi)
    L, D = DEPTH, D_MODEL
    p = 2.0 ** (-5.0 - jnp.arange(RET_HEADS, dtype=f32))
    return {
        'x': nrm((BATCH, SEQ, D), 1.0),
        'c': nrm((BATCH, D), 1.0),
        'ctx': nrm((BATCH, CTX_LEN, D), 1.0),
        'c_ctx': nrm((D,), 1.0),
        'w_mod': nrm((L, D, N_MOD * D), 0.5 * D ** -0.5),
        'b_mod': nrm((L, N_MOD * D), 0.02),
        'g_ffn1': 1.0 + nrm((L, D), 0.02),
        'ffn1_w_gate': nrm((L, D, D_FF), D ** -0.5),
        'ffn1_w_up': nrm((L, D, D_FF), D ** -0.5),
        'ffn1_w_down': nrm((L, D_FF, D), D_FF ** -0.5),
        'g_mix': 1.0 + nrm((L, D), 0.02),
        'w_in': nrm((L, D, IN_WIDTH), D ** -0.5),
        'ret_decay_logit': jnp.log((1.0 - p) / p)[None, None, :] + nrm((L, N_DIR, RET_HEADS), 0.1),
        'w_ret_o': nrm((L, RET_WIDTH, D), RET_WIDTH ** -0.5),
        'rwkv_mu_rkv': uni((L, 3, RWKV_WIDTH), 0.0, 1.0),
        'rwkv_mu_x': uni((L, 3, D), 0.0, 1.0),
        'rwkv_w0': uni((L, N_DIR, RWKV_WIDTH), -6.0, 1.0),
        'rwkv_w1': nrm((L, N_DIR, D, DECAY_LORA), D ** -0.5),
        'rwkv_w2': nrm((L, N_DIR, DECAY_LORA, RWKV_WIDTH), 0.5 * DECAY_LORA ** -0.5),
        'rwkv_a0': nrm((L, N_DIR, RWKV_WIDTH), 0.5),
        'rwkv_a1': nrm((L, N_DIR, D, AAA_LORA), D ** -0.5),
        'rwkv_a2': nrm((L, N_DIR, AAA_LORA, RWKV_WIDTH), 0.5 * AAA_LORA ** -0.5),
        'rwkv_g1': nrm((L, D, GATE_LORA), D ** -0.5),
        'rwkv_g2': nrm((L, GATE_LORA, RWKV_WIDTH), GATE_LORA ** -0.5),
        'rwkv_k_k': 0.85 + nrm((L, RWKV_WIDTH), 0.05),
        'rwkv_k_a': 1.0 + nrm((L, RWKV_WIDTH), 0.05),
        'rwkv_r_k': nrm((L, RWKV_HEADS, RWKV_N), 0.1),
        'rwkv_ln_w': 1.0 + nrm((L, RWKV_WIDTH), 0.02),
        'rwkv_ln_b': nrm((L, RWKV_WIDTH), 0.02),
        'w_rwkv_o': nrm((L, RWKV_WIDTH, D), RWKV_WIDTH ** -0.5),
        'w_out': nrm((L, D, D), D ** -0.5),
        'g_ffn2': 1.0 + nrm((L, D), 0.02),
        'ffn2_w_gate': nrm((L, D, D_FF), D ** -0.5),
        'ffn2_w_up': nrm((L, D, D_FF), D ** -0.5),
        'ffn2_w_down': nrm((L, D_FF, D), D_FF ** -0.5),
        'g_final': 1.0 + nrm((D,), 0.02),
    }


def reference(x, c, ctx, c_ctx, w_mod, b_mod, g_ffn1, ffn1_w_gate, ffn1_w_up, ffn1_w_down, g_mix, w_in,
              ret_decay_logit, w_ret_o, rwkv_mu_rkv, rwkv_mu_x, rwkv_w0, rwkv_w1, rwkv_w2, rwkv_a0, rwkv_a1,
              rwkv_a2, rwkv_g1, rwkv_g2, rwkv_k_k, rwkv_k_a, rwkv_r_k, rwkv_ln_w, rwkv_ln_b, w_rwkv_o, w_out,
              g_ffn2, ffn2_w_gate, ffn2_w_up, ffn2_w_down, g_final):
    n_rows = x.shape[1] // GRID_W
    rows = jnp.repeat(jnp.arange(n_rows), GRID_W)
    cols = jnp.tile(jnp.arange(GRID_W), n_rows)
    h, hc = x, ctx
    for layer in range(DEPTH):
        last = layer == DEPTH - 1
        mod_l = jnp.split((jax.nn.silu(c) @ w_mod[layer] + b_mod[layer])[:, None, :], N_MOD, axis=-1)
        mod_c = jnp.split(jax.nn.silu(c_ctx) @ w_mod[layer] + b_mod[layer], N_MOD, axis=-1)
        ffn1 = (ffn1_w_gate[layer], ffn1_w_up[layer], ffn1_w_down[layer])
        ffn2 = (ffn2_w_gate[layer], ffn2_w_up[layer], ffn2_w_down[layer])
        h = h + 0.5 * mod_l[2] * swiglu(modulate(rms_norm(h, g_ffn1[layer]), mod_l[0], mod_l[1]), *ffn1)
        hc = hc + 0.5 * mod_c[2] * swiglu(modulate(rms_norm(hc, g_ffn1[layer]), mod_c[0], mod_c[1]), *ffn1)
        ul = modulate(rms_norm(h, g_mix[layer]), mod_l[3], mod_l[4])
        uc = modulate(rms_norm(hc, g_mix[layer]), mod_c[3], mod_c[4])
        mix_l, mix_c = parallel_mixer(
            uc, ul, rows, cols, w_in[layer], ret_decay_logit[layer], w_ret_o[layer],
            rwkv_mu_rkv[layer], rwkv_mu_x[layer], rwkv_w0[layer], rwkv_w1[layer], rwkv_w2[layer],
            rwkv_a0[layer], rwkv_a1[layer], rwkv_a2[layer], rwkv_g1[layer], rwkv_g2[layer],
            rwkv_k_k[layer], rwkv_k_a[layer], rwkv_r_k[layer], rwkv_ln_w[layer], rwkv_ln_b[layer],
            w_rwkv_o[layer], w_out[layer], not last)
        h = h + mod_l[5] * mix_l
        h = h + 0.5 * mod_l[8] * swiglu(modulate(rms_norm(h, g_ffn2[layer]), mod_l[6], mod_l[7]), *ffn2)
        if not last:
            hc = hc + mod_c[5] * mix_c
            hc = hc + 0.5 * mod_c[8] * swiglu(modulate(rms_norm(hc, g_ffn2[layer]), mod_c[6], mod_c[7]), *ffn2)
    return rms_norm(h, g_final)
```

```cpp
#include <hip/hip_runtime.h>
#include <hip/hip_cooperative_groups.h>
#include <cstdio>
#include <cstdint>
namespace cg = cooperative_groups;


namespace pg8 {
#define PG8_LAS __attribute__((address_space(3)))
typedef unsigned short bf16_t;
typedef short bf16x8 __attribute__((ext_vector_type(8)));
typedef float f32x4 __attribute__((ext_vector_type(4)));
typedef unsigned u32x4 __attribute__((ext_vector_type(4)));
constexpr int BM = 256, BK = 64, HALF = 128, HTB = HALF * BK * 2  , STAGE_BYTES = 8 * HTB, NXCD = 8, WGM = 8;

__host__ __device__ __forceinline__ int lds_byte(int r, int c) { const int st = (r >> 4) * 2 + (c >> 5), rr = r & 15, cc = c & 31, ob = rr * 64 + cc * 2; return st * 1024 + (ob ^ (((ob >> 9) & 1) << 5)); }
__host__ __device__ __forceinline__ void stage_rc(int b, int& R, int& C) { const int st = b / 1024, sb = b % 1024, swz = sb ^ (((sb >> 9) & 1) << 5); R = (st >> 1) * 16 + swz / 64; C = (st & 1) * 32 + (swz % 64) / 2; }
__host__ __device__ __forceinline__ int perm32(int rho) { const int n = rho >> 4, i = rho & 15; return 8 * (i >> 2) + 4 * n + (i & 3); }

struct Unit { int pm, pn; };
struct Gemm { const bf16_t* A; const bf16_t* Bt; int M, N, K, lda; };

struct StaticOrder {
    int nM, nN, nwg, G, c;
    __host__ __device__ void init(int M, int N, int G_, int c_) { nM = M / BM; nN = N / BM; nwg = nM * nN; G = G_; c = c_; }
    __host__ __device__ bool next(int i, Unit& u) const {
        const long L = (long)i * G + c; if (L >= nwg) return false;
        int wgid = (int)L; { const int q = nwg / NXCD, r = nwg % NXCD, xcd = wgid % NXCD, off = wgid / NXCD; wgid = (xcd < r ? xcd * (q + 1) : r * (q + 1) + (xcd - r) * q) + off; }
        const int nig = WGM * nN, gid = wgid / nig, fm = gid * WGM, gsz = (nM - fm) < WGM ? (nM - fm) : WGM;
        u.pm = fm + ((wgid % nig) % gsz); u.pn = (wgid % nig) / gsz; return true;
    }
    __device__ __forceinline__ void a_ready(const Unit&) const {}
    __device__ __forceinline__ void done(const Unit&) const {}
};

__device__ __forceinline__ unsigned cvt_pk_bf16(float lo, float hi) { unsigned r; asm volatile("v_cvt_pk_bf16_f32 %0, %1, %2" : "=v"(r) : "v"(lo), "v"(hi)); return r; }
template <class Epi, class Sched, bool ALIGN_EPI = false, bool SP2 = false>
__device__ __forceinline__ void gemm_phase(PG8_LAS unsigned char* lds, const Gemm g, const Sched& S, const Epi& E) {
    const int tid = threadIdx.x, wid = __builtin_amdgcn_readfirstlane(tid >> 6), lane = tid & 63, wr = wid >> 2, wc = wid & 3, fr = lane & 15, fq = lane >> 4;
    const int K = g.K, nt = K / BK;
    unsigned voffA[2], voffB[2];
#pragma unroll
    for (int i = 0; i < 2; ++i) { int R, C; stage_rc(tid * 16 + i * 8192, R, C); const int Rb = Epi::PERM ? ((R & ~31) + perm32(R & 31)) : R;
        voffA[i] = (unsigned)(R * g.lda + C) * 2u; voffB[i] = (unsigned)(Rb * K + C) * 2u; }
    const size_t kstep = (size_t)(BK * 2);
    const size_t hstepA = (size_t)HALF * g.lda * 2, hstepB = (size_t)HALF * K * 2;
    const size_t tstepA = 2 * hstepA, tstepB = 2 * hstepB;
    const unsigned ldsw = (unsigned)wid * 1024u;
    const int aoff = lds_byte(wr * 64 + fr, fq * 8), boff = lds_byte(wc * 32 + fr, fq * 8);
#define PG8_SA(b, h) (((b) * 2 + (h)) * HTB)
#define PG8_SB(b, h) ((4 + (b) * 2 + (h)) * HTB)
#define PG8_STAGE(bufoff, gbase, voff) do { _Pragma("unroll") for (int _i = 0; _i < 2; ++_i) \
        __builtin_amdgcn_global_load_lds((const unsigned*)((const char*)(gbase) + (voff)[_i]), (PG8_LAS unsigned*)(lds + (bufoff) + ldsw + _i * 8192), 16, 0, 0); } while (0)
#define PG8_LDA(dst, b, h) do { _Pragma("unroll") for (int m = 0; m < 4; ++m) _Pragma("unroll") for (int k = 0; k < 2; ++k) dst[m][k] = *(const PG8_LAS bf16x8*)(lds + PG8_SA(b, h) + aoff + m * 2048 + k * 1024); } while (0)
#define PG8_LDB(dst, b, h) do { _Pragma("unroll") for (int n = 0; n < 2; ++n) _Pragma("unroll") for (int k = 0; k < 2; ++k) dst[n][k] = *(const PG8_LAS bf16x8*)(lds + PG8_SB(b, h) + boff + n * 2048 + k * 1024); } while (0)
#define PG8_MMA(ai, bj, At, Bt) do { __builtin_amdgcn_s_setprio(1); _Pragma("unroll") for (int m = 0; m < 4; ++m) _Pragma("unroll") for (int n = 0; n < 2; ++n) _Pragma("unroll") for (int k = 0; k < 2; ++k) \
        acc[ai][bj][m][n] = __builtin_amdgcn_mfma_f32_16x16x32_bf16(Bt[n][k], At[m][k], acc[ai][bj][m][n], 0, 0, 0); __builtin_amdgcn_s_setprio(0); } while (0)
#define PG8_WAIT_V(n) asm volatile("s_waitcnt vmcnt(" #n ")" ::: "memory")
#define PG8_WAIT_L(n) asm volatile("s_waitcnt lgkmcnt(" #n ")" ::: "memory")
#define PG8_BAR __builtin_amdgcn_s_barrier()
#define PG8_SCHED __builtin_amdgcn_sched_barrier(0)
    Unit cur, nxt; int ui = 0;
    if (!S.next(0, cur)) return;
    f32x4 acc[2][2][4][2];
#pragma unroll
    for (int a = 0; a < 2; ++a)
#pragma unroll
        for (int b = 0; b < 2; ++b)
#pragma unroll
            for (int m = 0; m < 4; ++m)
#pragma unroll
                for (int n = 0; n < 2; ++n) acc[a][b][m][n] = (f32x4){0.f, 0.f, 0.f, 0.f};
    bf16x8 At[4][2], B0[2][2], B1[2][2];
    const char* cA = (const char*)g.A + (size_t)cur.pm * tstepA; const char* cB = (const char*)g.Bt + (size_t)cur.pn * tstepB;
    S.a_ready(cur);
    if constexpr (SP2) {
        PG8_STAGE(PG8_SB(0, 0), cB, voffB); PG8_STAGE(PG8_SB(0, 1), cB + hstepB, voffB); PG8_STAGE(PG8_SA(0, 0), cA, voffA); PG8_STAGE(PG8_SA(0, 1), cA + hstepA, voffA);
        if (wr == 1) PG8_BAR;
        PG8_WAIT_V(2); PG8_BAR;
        PG8_STAGE(PG8_SB(1, 0), cB + kstep, voffB); PG8_STAGE(PG8_SA(1, 0), cA + kstep, voffA); PG8_STAGE(PG8_SB(1, 1), cB + hstepB + kstep, voffB);
        PG8_WAIT_V(6); PG8_BAR;
    } else {
        PG8_STAGE(PG8_SB(0, 0), cB, voffB); PG8_STAGE(PG8_SA(0, 0), cA, voffA); PG8_STAGE(PG8_SB(0, 1), cB + hstepB, voffB); PG8_STAGE(PG8_SA(0, 1), cA + hstepA, voffA);
        if (wr == 1) PG8_BAR;
        PG8_WAIT_V(4); PG8_BAR;
        PG8_STAGE(PG8_SB(1, 0), cB + kstep, voffB); PG8_STAGE(PG8_SA(1, 0), cA + kstep, voffA); PG8_STAGE(PG8_SB(1, 1), cB + hstepB + kstep, voffB);
        PG8_WAIT_V(6); PG8_BAR;
    }
    for (;;) {
        const bool has_next = S.next(ui + 1, nxt);
        const char* nA = has_next ? (const char*)g.A + (size_t)nxt.pm * tstepA : cA; const char* nB = has_next ? (const char*)g.Bt + (size_t)nxt.pn * tstepB : cB;
        for (int t = 0; t < nt; t += 2) {
            const bool last = (t == nt - 2);
            const char* a1 = cA + (size_t)(t + 1) * kstep;
            const char* a2 = last ? nA : cA + (size_t)(t + 2) * kstep; const char* b2 = last ? nB : cB + (size_t)(t + 2) * kstep;
            const char* a3 = a2 + kstep; const char* b3 = b2 + kstep;
            if (last && has_next) S.a_ready(nxt);
            if constexpr (SP2) {
            PG8_LDB(B0, 0, 0); PG8_LDB(B1, 0, 1); PG8_SCHED; PG8_LDA(At, 0, 0); PG8_STAGE(PG8_SA(1, 1), a1 + hstepA, voffA);
            PG8_WAIT_V(8); PG8_WAIT_L(0); PG8_BAR; PG8_MMA(0, 0, At, B0); PG8_MMA(0, 1, At, B1); PG8_BAR; PG8_SCHED;
            PG8_LDA(At, 0, 1); PG8_STAGE(PG8_SB(0, 0), b2, voffB); PG8_STAGE(PG8_SB(0, 1), b2 + hstepB, voffB); PG8_STAGE(PG8_SA(0, 0), a2, voffA);
            PG8_WAIT_V(8); PG8_WAIT_L(0); PG8_BAR; PG8_MMA(1, 0, At, B0); PG8_MMA(1, 1, At, B1); PG8_BAR; PG8_SCHED;
            PG8_LDB(B0, 1, 0); PG8_LDB(B1, 1, 1); PG8_SCHED; PG8_LDA(At, 1, 0); PG8_STAGE(PG8_SA(0, 1), a2 + hstepA, voffA);
            PG8_WAIT_V(8); PG8_WAIT_L(0); PG8_BAR; PG8_MMA(0, 0, At, B0); PG8_MMA(0, 1, At, B1); PG8_BAR; PG8_SCHED;
            PG8_LDA(At, 1, 1); PG8_STAGE(PG8_SB(1, 0), b3, voffB); PG8_STAGE(PG8_SB(1, 1), b3 + hstepB, voffB); PG8_STAGE(PG8_SA(1, 0), a3, voffA);
            PG8_WAIT_V(8); PG8_WAIT_L(0); PG8_BAR; PG8_MMA(1, 0, At, B0); PG8_MMA(1, 1, At, B1); PG8_BAR; PG8_SCHED;
            } else {
            PG8_LDB(B0, 0, 0); PG8_SCHED; PG8_LDA(At, 0, 0); PG8_STAGE(PG8_SA(1, 1), a1 + hstepA, voffA);
            PG8_WAIT_L(8); PG8_BAR; PG8_WAIT_L(0); PG8_MMA(0, 0, At, B0); PG8_BAR; PG8_SCHED;
            PG8_LDB(B1, 0, 1); PG8_STAGE(PG8_SB(0, 0), b2, voffB);
            PG8_BAR; PG8_WAIT_L(0); PG8_MMA(0, 1, At, B1); PG8_BAR;
            PG8_LDA(At, 0, 1); PG8_STAGE(PG8_SA(0, 0), a2, voffA);
            PG8_BAR; PG8_WAIT_L(0); PG8_MMA(1, 0, At, B0); PG8_BAR; PG8_SCHED;
            PG8_STAGE(PG8_SB(0, 1), b2 + hstepB, voffB);
            PG8_WAIT_V(6); PG8_BAR; PG8_MMA(1, 1, At, B1); PG8_BAR;
            PG8_LDB(B0, 1, 0); PG8_SCHED; PG8_LDA(At, 1, 0); PG8_STAGE(PG8_SA(0, 1), a2 + hstepA, voffA);
            PG8_WAIT_L(8); PG8_BAR; PG8_WAIT_L(0); PG8_MMA(0, 0, At, B0); PG8_BAR; PG8_SCHED;
            PG8_LDB(B1, 1, 1); PG8_STAGE(PG8_SB(1, 0), b3, voffB);
            PG8_BAR; PG8_WAIT_L(0); PG8_MMA(0, 1, At, B1); PG8_BAR;
            PG8_LDA(At, 1, 1); PG8_STAGE(PG8_SA(1, 0), a3, voffA);
            PG8_BAR; PG8_WAIT_L(0); PG8_MMA(1, 0, At, B0); PG8_BAR; PG8_SCHED;
            PG8_STAGE(PG8_SB(1, 1), b3 + hstepB, voffB);
            PG8_WAIT_V(6); PG8_BAR; PG8_MMA(1, 1, At, B1); PG8_BAR;
            }
        }
        if constexpr (ALIGN_EPI) { if (wr == 0) PG8_BAR; }
        if constexpr (!Epi::AFTER_DRAIN) { E(acc, cur, wr, wc, fr, fq); S.done(cur); }
        if (!has_next) break;
#pragma unroll
        for (int a = 0; a < 2; ++a)
#pragma unroll
            for (int b = 0; b < 2; ++b)
#pragma unroll
                for (int m = 0; m < 4; ++m)
#pragma unroll
                    for (int n = 0; n < 2; ++n) acc[a][b][m][n] = (f32x4){0.f, 0.f, 0.f, 0.f};
        cur = nxt; cA = nA; cB = nB; ++ui;
        if constexpr (ALIGN_EPI) { if (wr == 1) PG8_BAR; }
    }
    PG8_WAIT_V(0);
    if constexpr (!ALIGN_EPI) { if (wr == 0) PG8_BAR; }
    PG8_BAR;
    if constexpr (Epi::AFTER_DRAIN) { E.fused(acc, cur, wr, wc, fr, fq, lds, wid, lane); S.done(cur); }
#undef PG8_SA
#undef PG8_SB
#undef PG8_STAGE
#undef PG8_LDA
#undef PG8_LDB
#undef PG8_MMA
#undef PG8_WAIT_V
#undef PG8_WAIT_L
#undef PG8_BAR
#undef PG8_SCHED
}
}

#define LAS __attribute__((address_space(3)))
typedef unsigned short bf16;
typedef float f32x4 __attribute__((ext_vector_type(4)));
typedef float f32x2 __attribute__((ext_vector_type(2)));
typedef unsigned u32x4 __attribute__((ext_vector_type(4)));
typedef unsigned u32x2 __attribute__((ext_vector_type(2)));
typedef short bf16x8 __attribute__((ext_vector_type(8)));
typedef short s16x4 __attribute__((ext_vector_type(4)));

constexpr int NTHR = 512, NWAVES = 8;
constexpr int DM = 1024, BATCH = 2, SEQ = 8192, CTXL = 256;
constexpr int ML = BATCH * SEQ, MC = BATCH * CTXL, MT = ML + MC;
constexpr int DFF = 2816, NMODV = 9 * DM, INW = 5632;
constexpr int PLD = 2048;
constexpr int RW_LA = 1536, RW_LB = 1760, RW_Y = 1536;
constexpr int NCH_RET = 66;
constexpr size_t MiB = 1u << 20;
constexpr size_t WS_MODV = 0;
constexpr size_t WS_GU1 = 12 * MiB, WS_D1 = 23 * MiB, WS_WIN = WS_D1 + 11 * MiB / 2, WS_WG = WS_WIN + 8 * MiB, WS_RO = WS_WG + 4 * MiB, WS_RWO = WS_RO + MiB,
                 WS_WOUT = WS_RWO + MiB, WS_GU2 = WS_WOUT + 2 * MiB, WS_D2 = WS_GU2 + 11 * MiB, WS_U = WS_D2 + 11 * MiB / 2;
static_assert(WS_U == 61 * MiB, "ws map");
constexpr size_t WS_HC = WS_U + 33 * MiB, WS_BIG = WS_HC + 2 * MiB;
constexpr size_t WS_ACT = WS_BIG, WS_PRET = WS_BIG, WS_PRW = WS_BIG + 66 * MiB, WS_Y1 = WS_BIG + 132 * MiB;
constexpr size_t WS_RETKV = WS_U;
constexpr size_t WS_INVN = WS_GU1, WS_HW = WS_INVN + 3 * MiB / 4, WS_HA = WS_HW + 17 * MiB / 4, WS_HG = WS_HA + 17 * MiB / 4;
static_assert(WS_HG + (size_t)MT * 96 * 4 <= WS_WIN, "small arrays");
static_assert(WS_Y1 + (size_t)ML * 512 * 2 <= 256 * MiB, "ws end");

struct Params { const float* in[36]; float* out; unsigned char* ws; int ph_lo, ph_hi; };

__device__ __forceinline__ unsigned f2bf(float f) { unsigned u = __float_as_uint(f); return (u + 0x7fffu + ((u >> 16) & 1u)) >> 16; }
__device__ __forceinline__ unsigned pk2(float lo, float hi) { return f2bf(lo) | (f2bf(hi) << 16); }
__device__ __forceinline__ float bflo(unsigned w) { return __uint_as_float(w << 16); }
__device__ __forceinline__ float bfhi(unsigned w) { return __uint_as_float(w & 0xffff0000u); }
__device__ __forceinline__ float bf1(bf16 h) { return __uint_as_float((unsigned)h << 16); }
__device__ __forceinline__ float sigmoidf_(float x) { return __builtin_amdgcn_rcpf(1.0f + __expf(-x)); }
__device__ __forceinline__ float wave_sum(float v) {
#pragma unroll
    for (int o = 1; o < 64; o <<= 1) v += __shfl_xor(v, o);
    return v;
}
template <int CTRL> __device__ __forceinline__ float dpp_add(float v) { return v + __int_as_float(__builtin_amdgcn_update_dpp(0, __float_as_int(v), CTRL, 0xF, 0xF, true)); }
__device__ __forceinline__ float sum4(float v) { v = dpp_add<0xB1>(v); v = dpp_add<0x4E>(v); return v; }
__device__ __forceinline__ float sum8(float v) { v = sum4(v); v = dpp_add<0x141>(v); return v; }
__device__ __forceinline__ float sum16(float v) { v = sum8(v); v = dpp_add<0x140>(v); return v; }
__device__ __forceinline__ int mod_set(int R) { return R < SEQ ? 0 : (R < ML ? 1 : 2); }
__device__ __forceinline__ bool has_prev(int R) { return R < ML ? (R & (SEQ - 1)) != 0 : ((R - ML) & (CTXL - 1)) != 0; }
__device__ __forceinline__ bool has_next(int R) { return R < ML ? (R & (SEQ - 1)) != SEQ - 1 : ((R - ML) & (CTXL - 1)) != CTXL - 1; }

using pg8::Unit;
struct EpiSwiGLU {
    static constexpr bool PERM = true, AFTER_DRAIN = false;
    bf16* O; int ldo;
    __device__ __forceinline__ void operator()(const f32x4 (&acc)[2][2][4][2], const Unit& u, int wr, int wc, int fr, int fq) const {
        const int row0 = u.pm * 256 + wr * 64 + fr, col0 = u.pn * 128 + wc * 32 + 8 * fq;
#pragma unroll
        for (int ai = 0; ai < 2; ++ai)
#pragma unroll
            for (int m = 0; m < 4; ++m) {
                bf16* rowp = O + (size_t)(row0 + ai * 128 + m * 16) * ldo + col0;
                float v[8];
#pragma unroll
                for (int n = 0; n < 2; ++n)
#pragma unroll
                    for (int i = 0; i < 4; ++i) { const float g = acc[ai][0][m][n][i], up = acc[ai][1][m][n][i]; v[4 * n + i] = g * sigmoidf_(g) * up; }
                u32x4 w; w.x = pg8::cvt_pk_bf16(v[0], v[1]); w.y = pg8::cvt_pk_bf16(v[2], v[3]); w.z = pg8::cvt_pk_bf16(v[4], v[5]); w.w = pg8::cvt_pk_bf16(v[6], v[7]);
                *(u32x4*)rowp = w;
            }
    }
};
struct EpiResid {
    static constexpr bool PERM = false, AFTER_DRAIN = false;
    const float* base_lat; const float* base_ctx; float* out_lat; float* out_ctx; const float* modv; int modoff; float sc;
    __device__ __forceinline__ void operator()(const f32x4 (&acc)[2][2][4][2], const Unit& u, int wr, int wc, int fr, int fq) const {
        const bool isc = u.pm >= 64; const int pml = isc ? u.pm - 64 : u.pm;
        const float* base = isc ? base_ctx : base_lat; float* out = isc ? out_ctx : out_lat;
        const float* gate = modv + (isc ? 2 : (u.pm >= 32 ? 1 : 0)) * NMODV + modoff;
        const int col0 = u.pn * 256 + wc * 32 + 4 * fq;
        f32x4 gv[2][2];
#pragma unroll
        for (int bj = 0; bj < 2; ++bj)
#pragma unroll
            for (int n = 0; n < 2; ++n) gv[bj][n] = *(const f32x4*)(gate + col0 + bj * 128 + n * 16) * sc;
#pragma unroll
        for (int ai = 0; ai < 2; ++ai)
#pragma unroll
            for (int m = 0; m < 4; ++m) {
                const size_t off = (size_t)(pml * 256 + ai * 128 + wr * 64 + m * 16 + fr) * DM + col0;
#pragma unroll
                for (int bj = 0; bj < 2; ++bj)
#pragma unroll
                    for (int n = 0; n < 2; ++n) { const f32x4 b = *(const f32x4*)(base + off + bj * 128 + n * 16); *(f32x4*)(out + off + bj * 128 + n * 16) = b + gv[bj][n] * acc[ai][bj][m][n]; }
                asm volatile("" ::: "memory");
            }
    }
};
template <int MODE, bool SPLIT> struct EpiB {
    static constexpr bool PERM = true, AFTER_DRAIN = false;
    bf16* O; bf16* O2; const bf16* X; int ld;
    __device__ __forceinline__ void operator()(const f32x4 (&acc)[2][2][4][2], const Unit& u, int wr, int wc, int fr, int fq) const {
        int pn = u.pn; bf16* Ob = O; if (SPLIT && pn >= 8) { pn -= 8; Ob = O2; }
        const int row0 = u.pm * 256 + wr * 64 + fr, col0 = pn * 256 + wc * 32 + 8 * fq;
#pragma unroll
        for (int ai = 0; ai < 2; ++ai)
#pragma unroll
            for (int m = 0; m < 4; ++m) {
                const size_t off = (size_t)(row0 + ai * 128 + m * 16) * ld + col0;
#pragma unroll
                for (int bj = 0; bj < 2; ++bj) {
                    float v[8];
#pragma unroll
                    for (int n = 0; n < 2; ++n)
#pragma unroll
                        for (int i = 0; i < 4; ++i) v[4 * n + i] = acc[ai][bj][m][n][i];
                    if (MODE == 1) { const u32x4 o = *(const u32x4*)(Ob + off + bj * 128);
                        const unsigned ow[4] = {o.x, o.y, o.z, o.w};
#pragma unroll
                        for (int i = 0; i < 4; ++i) { v[2 * i] = sigmoidf_(v[2 * i]) * bflo(ow[i]); v[2 * i + 1] = sigmoidf_(v[2 * i + 1]) * bfhi(ow[i]); } }
                    if (MODE == 2) { const u32x4 o = *(const u32x4*)(Ob + off + bj * 128); const u32x4 x = *(const u32x4*)(X + off + bj * 128);
                        const unsigned ow[4] = {o.x, o.y, o.z, o.w}, xw[4] = {x.x, x.y, x.z, x.w};
#pragma unroll
                        for (int i = 0; i < 4; ++i) { v[2 * i] = bflo(ow[i]) + sigmoidf_(v[2 * i]) * bflo(xw[i]); v[2 * i + 1] = bfhi(ow[i]) + sigmoidf_(v[2 * i + 1]) * bfhi(xw[i]); } }
                    u32x4 w; w.x = pg8::cvt_pk_bf16(v[0], v[1]); w.y = pg8::cvt_pk_bf16(v[2], v[3]); w.z = pg8::cvt_pk_bf16(v[4], v[5]); w.w = pg8::cvt_pk_bf16(v[6], v[7]);
                    *(u32x4*)(Ob + off + bj * 128) = w;
                }
                asm volatile("" ::: "memory");
            }
    }
};

__device__ __forceinline__ void tr_item(const float* W, int ldw, int K, int c0, int kb, bf16* WT, int drow, const float* mu, float sa, float sb, LAS float* scr, int lane) {
    const int k0 = 64 * kb;
#pragma unroll 8
    for (int i = 0; i < 32; ++i) { const int kk = 2 * i + (lane >> 5); float v = W[(size_t)(k0 + kk) * ldw + c0 + (lane & 31)]; if (mu) v *= sa + sb * mu[k0 + kk]; scr[kk * 33 + (lane & 31)] = v; }
    asm volatile("s_waitcnt lgkmcnt(0)" ::: "memory");
    const int c = lane & 7;
#pragma unroll
    for (int j = 0; j < 4; ++j) { const int n = (lane >> 3) + 8 * j; const LAS float* s = scr + (8 * c) * 33 + n;
        u32x4 o; o.x = pk2(s[0 * 33], s[1 * 33]); o.y = pk2(s[2 * 33], s[3 * 33]); o.z = pk2(s[4 * 33], s[5 * 33]); o.w = pk2(s[6 * 33], s[7 * 33]);
        *(u32x4*)(WT + (size_t)(drow + n) * K + k0 + 8 * c) = o; }
    asm volatile("s_waitcnt lgkmcnt(0)" ::: "memory");
}
struct TrJob { const float* W; int ldw, K, c0, nc; bf16* WT; int mode, r0; const float* mu; float sa, sb; };
constexpr int NTRJOB = 21;
__device__ __forceinline__ TrJob tr_job(int j, const Params& p) {
    unsigned char* ws = p.ws; TrJob J; J.mu = nullptr; J.sa = 1.f; J.sb = 0.f; J.mode = 0; J.r0 = 0; J.c0 = 0;
    const float* mux = p.in[15];
    switch (j) {
    case 0: J.W = p.in[7]; J.ldw = DFF; J.K = DM; J.nc = DFF; J.WT = (bf16*)(ws + WS_GU1); J.mode = 1; break;
    case 1: J.W = p.in[8]; J.ldw = DFF; J.K = DM; J.nc = DFF; J.WT = (bf16*)(ws + WS_GU1); J.mode = 2; break;
    case 2: J.W = p.in[9]; J.ldw = DM; J.K = DFF; J.nc = DM; J.WT = (bf16*)(ws + WS_D1); break;
    case 3: J.W = p.in[11]; J.ldw = INW; J.K = DM; J.nc = 3584; J.WT = (bf16*)(ws + WS_WIN); break;
    case 4: J.W = p.in[11]; J.ldw = INW; J.K = DM; J.c0 = 3584; J.nc = 2048; J.WT = (bf16*)(ws + WS_WG); break;
    case 5: J.W = p.in[17]; J.ldw = 32; J.K = DM; J.nc = 32; J.WT = (bf16*)(ws + WS_WIN); J.r0 = 3584; J.mu = mux; J.sa = 1.f; J.sb = -1.f; break;
    case 6: J.W = p.in[17] + DM * 32; J.ldw = 32; J.K = DM; J.nc = 32; J.WT = (bf16*)(ws + WS_WIN); J.r0 = 3616; J.mu = mux; J.sa = 1.f; J.sb = -1.f; break;
    case 7: J.W = p.in[20]; J.ldw = 32; J.K = DM; J.nc = 32; J.WT = (bf16*)(ws + WS_WIN); J.r0 = 3648; J.mu = mux + DM; J.sa = 1.f; J.sb = -1.f; break;
    case 8: J.W = p.in[20] + DM * 32; J.ldw = 32; J.K = DM; J.nc = 32; J.WT = (bf16*)(ws + WS_WIN); J.r0 = 3680; J.mu = mux + DM; J.sa = 1.f; J.sb = -1.f; break;
    case 9: J.W = p.in[22]; J.ldw = 96; J.K = DM; J.nc = 96; J.WT = (bf16*)(ws + WS_WIN); J.r0 = 3712; J.mu = mux + 2 * DM; J.sa = 1.f; J.sb = -1.f; break;
    case 10: J.W = p.in[17]; J.ldw = 32; J.K = DM; J.nc = 32; J.WT = (bf16*)(ws + WS_WIN); J.r0 = 3808; J.mu = mux; J.sa = 0.f; J.sb = 1.f; break;
    case 11: J.W = p.in[17] + DM * 32; J.ldw = 32; J.K = DM; J.nc = 32; J.WT = (bf16*)(ws + WS_WIN); J.r0 = 3840; J.mu = mux; J.sa = 0.f; J.sb = 1.f; break;
    case 12: J.W = p.in[20]; J.ldw = 32; J.K = DM; J.nc = 32; J.WT = (bf16*)(ws + WS_WIN); J.r0 = 3872; J.mu = mux + DM; J.sa = 0.f; J.sb = 1.f; break;
    case 13: J.W = p.in[20] + DM * 32; J.ldw = 32; J.K = DM; J.nc = 32; J.WT = (bf16*)(ws + WS_WIN); J.r0 = 3904; J.mu = mux + DM; J.sa = 0.f; J.sb = 1.f; break;
    case 14: J.W = p.in[22]; J.ldw = 96; J.K = DM; J.nc = 96; J.WT = (bf16*)(ws + WS_WIN); J.r0 = 3936; J.mu = mux + 2 * DM; J.sa = 0.f; J.sb = 1.f; break;
    case 15: J.W = p.in[13]; J.ldw = DM; J.K = 512; J.nc = DM; J.WT = (bf16*)(ws + WS_RO); break;
    case 16: J.W = p.in[29]; J.ldw = DM; J.K = 512; J.nc = DM; J.WT = (bf16*)(ws + WS_RWO); break;
    case 17: J.W = p.in[30]; J.ldw = DM; J.K = DM; J.nc = DM; J.WT = (bf16*)(ws + WS_WOUT); break;
    case 18: J.W = p.in[32]; J.ldw = DFF; J.K = DM; J.nc = DFF; J.WT = (bf16*)(ws + WS_GU2); J.mode = 1; break;
    case 19: J.W = p.in[33]; J.ldw = DFF; J.K = DM; J.nc = DFF; J.WT = (bf16*)(ws + WS_GU2); J.mode = 2; break;
    default: J.W = p.in[34]; J.ldw = DM; J.K = DFF; J.nc = DM; J.WT = (bf16*)(ws + WS_D2); break;
    }
    return J;
}
__device__ __forceinline__ void p0_weights(const Params& p, LAS unsigned char* lds, int wave, int lane) {
    LAS float* scr = (LAS float*)(lds + wave * 16384);
    const int gw = blockIdx.x * NWAVES + wave, NGW = gridDim.x * NWAVES;
    int base = 0;
    for (int j = 0; j < NTRJOB; ++j) {
        const TrJob J = tr_job(j, p);
        const int nnb = J.nc / 32, nit = (J.K / 64) * nnb;
        int it = gw - (base % NGW); if (it < 0) it += NGW;
        for (; it < nit; it += NGW) {
            const int kb = it / nnb, nb = it % nnb, n0 = 32 * nb;
            const int drow = J.mode == 0 ? J.r0 + n0 : ((n0 >> 7) * 256 + (n0 & 127) + (J.mode == 2 ? 128 : 0));
            tr_item(J.W, J.ldw, J.K, J.c0 + n0, kb, J.WT, drow, J.mu, J.sa, J.sb, scr, lane);
        }
        base += nit;
    }
    { u32x4* z = (u32x4*)((bf16*)(p.ws + WS_WIN) + (size_t)4032 * DM); const int n16 = 64 * DM * 2 / 16;
      for (int i = blockIdx.x * NTHR + threadIdx.x; i < n16; i += gridDim.x * NTHR) z[i] = (u32x4){0u, 0u, 0u, 0u}; }
}
__device__ __forceinline__ void p0_modv(const Params& p, LAS unsigned char* lds) {
    const float* c = p.in[1]; const float* cc = p.in[3]; const float* wm = p.in[4]; const float* bm = p.in[5];
    float* modv = (float*)(p.ws + WS_MODV);
    LAS float* red = (LAS float*)lds;
    const int tid = threadIdx.x, cl = tid & 15, kg = tid >> 4;
    for (int it = blockIdx.x; it < NMODV / 64; it += gridDim.x) {
        const int n0 = it * 64 + 4 * cl;
        f32x4 a0 = {0.f, 0.f, 0.f, 0.f}, a1 = a0, a2 = a0;
#pragma unroll 4
        for (int i = 0; i < 32; ++i) { const int k = kg * 32 + i; const f32x4 w = *(const f32x4*)(wm + (size_t)k * NMODV + n0);
            const float x0 = c[k], x1 = c[DM + k], x2 = cc[k];
            a0 += w * (x0 * sigmoidf_(x0)); a1 += w * (x1 * sigmoidf_(x1)); a2 += w * (x2 * sigmoidf_(x2)); }
        *(LAS f32x4*)(red + (kg * 3 + 0) * 64 + 4 * cl) = a0; *(LAS f32x4*)(red + (kg * 3 + 1) * 64 + 4 * cl) = a1; *(LAS f32x4*)(red + (kg * 3 + 2) * 64 + 4 * cl) = a2;
        __syncthreads();
        if (tid < 192) { const int s = tid >> 6, col = tid & 63; float v = bm[it * 64 + col];
            for (int g = 0; g < 32; ++g) v += red[(g * 3 + s) * 64 + col];
            modv[s * NMODV + it * 64 + col] = v; }
        __syncthreads();
    }
}
__device__ __forceinline__ void norm_rows(const float* hl, const float* hc, const float* g, const float* modv, int shift_off, int scale_off, bf16* U, int nrows, int wave, int lane) {
    const int gw = blockIdx.x * NWAVES + wave, NGW = gridDim.x * NWAVES;
    for (int R = gw; R < nrows; R += NGW) {
        const float* xr = (R < ML ? hl + (size_t)R * DM : hc + (size_t)(R - ML) * DM) + 4 * lane;
        f32x4 v[4]; float s = 0.f;
#pragma unroll
        for (int j = 0; j < 4; ++j) { v[j] = *(const f32x4*)(xr + 256 * j); s += (v[j].x * v[j].x + v[j].y * v[j].y) + (v[j].z * v[j].z + v[j].w * v[j].w); }
        const float rstd = 1.0f / sqrtf(wave_sum(s) * (1.0f / DM) + 1e-6f);
        const float* mv = modv + mod_set(R) * NMODV;
        u32x2* o = (u32x2*)(U + (size_t)R * DM + 4 * lane);
#pragma unroll
        for (int j = 0; j < 4; ++j) { const int col = 4 * lane + 256 * j; const f32x4 gg = *(const f32x4*)(g + col), sh = *(const f32x4*)(mv + shift_off + col), sc = *(const f32x4*)(mv + scale_off + col);
            const f32x4 y = (v[j] * rstd) * gg * (sc + 1.0f) + sh; u32x2 w; w.x = pk2(y.x, y.y); w.y = pk2(y.z, y.w); o[64 * j] = w; }
    }
}

__device__ __forceinline__ void p6_token_prep(const Params& p, int wave, int lane) {
    bf16* pret = (bf16*)(p.ws + WS_PRET); const bf16* prw = (const bf16*)(p.ws + WS_PRW);
    float* INVN = (float*)(p.ws + WS_INVN); float* HW = (float*)(p.ws + WS_HW); float* HA = (float*)(p.ws + WS_HA); float* HG = (float*)(p.ws + WS_HG);
    const float* mu_k = p.in[14] + 512; const float* k_k = p.in[24];
    const int gw = blockIdx.x * NWAVES + wave, NGW = gridDim.x * NWAVES;
    for (int R = gw; R < MT; R += NGW) {
        {
            const int P0 = 8 * lane, T = P0 >> 8, hd = (P0 >> 6) & 3, s = (P0 >> 5) & 1, i0 = P0 & 31;
            bf16* z1p = pret + (size_t)R * PLD + T * 512 + hd * 128 + s * 64 + i0;
            const u32x4 a = *(const u32x4*)z1p, b = *(const u32x4*)(z1p + 32);
            const unsigned aw[4] = {a.x, a.y, a.z, a.w}, bw[4] = {b.x, b.y, b.z, b.w};
            float z1[8], z2[8], o1[8], o2[8];
#pragma unroll
            for (int e = 0; e < 4; ++e) { z1[2 * e] = bflo(aw[e]); z1[2 * e + 1] = bfhi(aw[e]); z2[2 * e] = bflo(bw[e]); z2[2 * e + 1] = bfhi(bw[e]); }
            const bool lat = R < ML; const int t = R & (SEQ - 1); const float pos = (float)(s == 0 ? (t >> 6) : (t & 63));
            const float ksc = T == 1 ? 0.08838834764831845f : 1.0f;
#pragma unroll
            for (int e = 0; e < 8; ++e) {
                float cs = 1.f, sn = 0.f;
                if (lat) { const float inv = exp2f(-(float)(i0 + e) * 0.4152410118609203f); const float rev = pos * inv * 0.15915494309189535f; sn = __builtin_amdgcn_sinf(rev); cs = __builtin_amdgcn_cosf(rev); }
                o1[e] = (z1[e] * cs - z2[e] * sn) * ksc; o2[e] = (z1[e] * sn + z2[e] * cs) * ksc;
            }
            u32x4 w1, w2; w1.x = pk2(o1[0], o1[1]); w1.y = pk2(o1[2], o1[3]); w1.z = pk2(o1[4], o1[5]); w1.w = pk2(o1[6], o1[7]);
            w2.x = pk2(o2[0], o2[1]); w2.y = pk2(o2[2], o2[3]); w2.z = pk2(o2[4], o2[5]); w2.w = pk2(o2[6], o2[7]);
            *(u32x4*)z1p = w1; *(u32x4*)(z1p + 32) = w2;
        }
        const bool hp = has_prev(R), hn = has_next(R);
        const bf16* row = prw + (size_t)R * PLD; const bf16* rowp = row - PLD; const bf16* rown = row + PLD;
#pragma unroll
        for (int jj = 0; jj < 4; ++jj) { const int j = lane + 64 * jj;
            if (j < 224) { const float la = bf1(row[RW_LA + j]); const float lp = hp ? bf1(rowp[RW_LB + j]) : 0.f, ln = hn ? bf1(rown[RW_LB + j]) : 0.f;
                const float hv = la + 0.5f * (lp + ln);
                if (j < 64) HW[((size_t)(j >> 5) * MT + R) * 32 + (j & 31)] = 1.0f - 2.0f * __builtin_amdgcn_rcpf(__expf(2.0f * hv) + 1.0f);
                else if (j < 128) HA[((size_t)((j - 64) >> 5) * MT + R) * 32 + ((j - 64) & 31)] = hv;
                else HG[(size_t)R * 96 + (j - 128)] = sigmoidf_(hv); } }
        {
            const u32x4 kc = *(const u32x4*)(row + 512 + 8 * lane); u32x4 kp = {0u, 0u, 0u, 0u}, kn = {0u, 0u, 0u, 0u};
            if (hp) kp = *(const u32x4*)(rowp + 512 + 8 * lane); if (hn) kn = *(const u32x4*)(rown + 512 + 8 * lane);
            const unsigned cw[4] = {kc.x, kc.y, kc.z, kc.w}, pw[4] = {kp.x, kp.y, kp.z, kp.w}, nw[4] = {kn.x, kn.y, kn.z, kn.w};
            float ss = 0.f;
#pragma unroll
            for (int e = 0; e < 8; ++e) { const int c = 8 * lane + e; const float kcv = (e & 1) ? bfhi(cw[e >> 1]) : bflo(cw[e >> 1]), kpv = (e & 1) ? bfhi(pw[e >> 1]) : bflo(pw[e >> 1]), knv = (e & 1) ? bfhi(nw[e >> 1]) : bflo(nw[e >> 1]);
                const float k = kcv + mu_k[c] * (0.5f * (kpv + knv) - kcv); const float kr = k * k_k[c]; ss += kr * kr; }
            ss = sum8(ss);
            if ((lane & 7) == 0) INVN[(size_t)R * 8 + (lane >> 3)] = 1.0f / fmaxf(sqrtf(ss), 1e-12f);
        }
    }
}

__device__ __forceinline__ float ret_loggamma(const Params& p, int d, int h) { const float x = p.in[12][d * 4 + h]; return -log1pf(expf(-x)); }
__device__ __forceinline__ bf16x8 ld8(const bf16* ptr) { return *(const bf16x8*)ptr; }
__device__ __forceinline__ void ret_kv_local(const Params& p, LAS unsigned char* lds, int wave, int lane) {
    const bf16* pret = (const bf16*)(p.ws + WS_PRET); bf16* KV = (bf16*)(p.ws + WS_RETKV);
    LAS bf16* KT = (LAS bf16*)lds; LAS bf16* VT0 = KT + 128 * 136; LAS bf16* VT1 = VT0 + 128 * 136;
    const int tid = threadIdx.x, i16 = lane & 15, q = lane >> 4;
    for (int it = blockIdx.x; it < 2 * 4 * NCH_RET; it += gridDim.x) {
        const int cc = it % NCH_RET, h = (it / NCH_RET) & 3, b = it / (NCH_RET * 4);
        const int R0 = cc < 2 ? ML + b * CTXL + cc * 128 : b * SEQ + (cc - 2) * 128;
        const float l0 = ret_loggamma(p, 0, h) * 1.4426950408889634f, l1 = ret_loggamma(p, 1, h) * 1.4426950408889634f;
        __syncthreads();
#pragma unroll
        for (int i = 0; i < 4; ++i) { const int idx = tid + NTHR * i, tok = idx & 127, c8 = idx >> 7;
            const bf16* rp = pret + (size_t)(R0 + tok) * PLD + h * 128 + 8 * c8;
            const u32x4 kk = *(const u32x4*)(rp + 512), vv = *(const u32x4*)(rp + 1024);
            const unsigned kw[4] = {kk.x, kk.y, kk.z, kk.w}, vw[4] = {vv.x, vv.y, vv.z, vv.w};
            const float w0 = exp2f(l0 * (float)(127 - tok)), w1 = exp2f(l1 * (float)tok);
#pragma unroll
            for (int e = 0; e < 8; ++e) { const unsigned ke = (e & 1) ? (kw[e >> 1] >> 16) : (kw[e >> 1] & 0xffffu); const float ve = (e & 1) ? bfhi(vw[e >> 1]) : bflo(vw[e >> 1]);
                KT[(8 * c8 + e) * 136 + tok] = (bf16)ke; VT0[(8 * c8 + e) * 136 + tok] = (bf16)f2bf(ve * w0); VT1[(8 * c8 + e) * 136 + tok] = (bf16)f2bf(ve * w1); } }
        __syncthreads();
#pragma unroll
        for (int d = 0; d < 2; ++d) {
            const LAS bf16* VT = d ? VT1 : VT0;
            f32x4 acc[8];
#pragma unroll
            for (int ct = 0; ct < 8; ++ct) acc[ct] = (f32x4){0.f, 0.f, 0.f, 0.f};
#pragma unroll
            for (int ks = 0; ks < 4; ++ks) {
                const bf16x8 af = *(const LAS bf16x8*)(VT + (16 * wave + i16) * 136 + 32 * ks + 8 * q);
#pragma unroll
                for (int ct = 0; ct < 8; ++ct) { const bf16x8 bfr = *(const LAS bf16x8*)(KT + (16 * ct + i16) * 136 + 32 * ks + 8 * q);
                    acc[ct] = __builtin_amdgcn_mfma_f32_16x16x32_bf16(bfr, af, acc[ct], 0, 0, 0); }
            }
            bf16* o = KV + ((size_t)(((b * 4 + h) * 2 + d) * NCH_RET + cc) * 128 + 16 * wave + i16) * 128 + 4 * q;
#pragma unroll
            for (int ct = 0; ct < 8; ++ct) { u32x2 w; w.x = pk2(acc[ct][0], acc[ct][1]); w.y = pk2(acc[ct][2], acc[ct][3]); *(u32x2*)(o + 16 * ct) = w; }
        }
    }
}
__device__ __forceinline__ void ret_scan(const Params& p) {
    bf16* KV = (bf16*)(p.ws + WS_RETKV);
    for (int idx = blockIdx.x * NTHR + threadIdx.x; idx < 2 * 4 * 2 * 16384; idx += gridDim.x * NTHR) {
        const int e = idx & 16383, d = (idx >> 14) & 1, h = (idx >> 15) & 3, b = idx >> 17;
        const float dec = expf(128.0f * ret_loggamma(p, d, h));
        bf16* base = KV + (size_t)(((b * 4 + h) * 2 + d) * NCH_RET) * 16384 + e;
        float st = 0.f;
        for (int s = 0; s < NCH_RET; ++s) {
            const int cc = d == 0 ? s : (s < 2 ? 1 - s : NCH_RET + 1 - s);
            bf16* ptr = base + (size_t)cc * 16384; const float t = bf1(*ptr); *ptr = (bf16)f2bf(st); st = dec * st + t;
        }
    }
}
__device__ __forceinline__ void ret_out(const Params& p, LAS unsigned char* lds, int wave, int lane, int first, int nblk) {
    bf16* pret = (bf16*)(p.ws + WS_PRET); const bf16* KV = (const bf16*)(p.ws + WS_RETKV);
    LAS bf16* VT = (LAS bf16*)lds;
    const int tid = threadIdx.x, i16 = lane & 15, q = lane >> 4;
    for (int it = (int)blockIdx.x - first; it < 2 * 4 * 64; it += nblk) {
        const int c = it & 63, h = (it >> 6) & 3, b = it >> 8;
        const int R0 = b * SEQ + c * 128;
        const float l0 = ret_loggamma(p, 0, h) * 1.4426950408889634f, l1 = ret_loggamma(p, 1, h) * 1.4426950408889634f;
        __syncthreads();
#pragma unroll
        for (int i = 0; i < 4; ++i) { const int idx = tid + NTHR * i, tok = idx & 127, c8 = idx >> 7;
            const u32x4 vv = *(const u32x4*)(pret + (size_t)(R0 + tok) * PLD + 1024 + h * 128 + 8 * c8);
            const unsigned vw[4] = {vv.x, vv.y, vv.z, vv.w};
#pragma unroll
            for (int e = 0; e < 8; ++e) VT[(8 * c8 + e) * 136 + tok] = (bf16)((e & 1) ? (vw[e >> 1] >> 16) : (vw[e >> 1] & 0xffffu)); }
        __syncthreads();
        const int tk = 16 * wave + i16;
        bf16* qrow = pret + (size_t)(R0 + tk) * PLD + h * 128;
        bf16x8 aq[4];
#pragma unroll
        for (int ks = 0; ks < 4; ++ks) aq[ks] = ld8(qrow + 32 * ks + 8 * q);
        bf16x8 pf[4];
        {
            f32x4 sacc[8];
#pragma unroll
            for (int ct = 0; ct < 8; ++ct) { sacc[ct] = (f32x4){0.f, 0.f, 0.f, 0.f};
                const bf16* krow = pret + (size_t)(R0 + 16 * ct + i16) * PLD + 512 + h * 128 + 8 * q;
#pragma unroll
                for (int ks = 0; ks < 4; ++ks) sacc[ct] = __builtin_amdgcn_mfma_f32_16x16x32_bf16(ld8(krow + 32 * ks), aq[ks], sacc[ct], 0, 0, 0); }
#pragma unroll
            for (int ct = 0; ct < 8; ++ct)
#pragma unroll
                for (int r = 0; r < 4; ++r) { const int s = 16 * ct + 4 * q + r; const int df = tk - s; sacc[ct][r] *= df >= 0 ? exp2f(l0 * (float)df) : exp2f(l1 * (float)(-df)); }
#pragma unroll
            for (int ks = 0; ks < 4; ++ks) { u32x4 w; w.x = pk2(sacc[2 * ks][0], sacc[2 * ks][1]); w.y = pk2(sacc[2 * ks][2], sacc[2 * ks][3]); w.z = pk2(sacc[2 * ks + 1][0], sacc[2 * ks + 1][1]); w.w = pk2(sacc[2 * ks + 1][2], sacc[2 * ks + 1][3]);
                pf[ks] = __builtin_bit_cast(bf16x8, w); }
        }
        const bf16* F = KV + (size_t)(((b * 4 + h) * 2 + 0) * NCH_RET + c + 2) * 16384; const bf16* G = KV + (size_t)(((b * 4 + h) * 2 + 1) * NCH_RET + c + 2) * 16384;
        const float s0 = exp2f(l0 * (float)(tk + 1)), s1 = exp2f(l1 * (float)(128 - tk));
        f32x4 y[8]; float sum = 0.f;
#pragma unroll
        for (int vt = 0; vt < 8; ++vt) {
            f32x4 ay = {0.f, 0.f, 0.f, 0.f}, a0 = ay, a1 = ay;
#pragma unroll
            for (int ks = 0; ks < 4; ++ks) {
                const LAS bf16* vp = VT + (16 * vt + i16) * 136 + 32 * ks + 4 * q;
                const u32x2 lo = *(const LAS u32x2*)vp, hi = *(const LAS u32x2*)(vp + 16);
                u32x4 w; w.x = lo.x; w.y = lo.y; w.z = hi.x; w.w = hi.y;
                ay = __builtin_amdgcn_mfma_f32_16x16x32_bf16(__builtin_bit_cast(bf16x8, w), pf[ks], ay, 0, 0, 0);
                a0 = __builtin_amdgcn_mfma_f32_16x16x32_bf16(ld8(F + (size_t)(16 * vt + i16) * 128 + 32 * ks + 8 * q), aq[ks], a0, 0, 0, 0);
                a1 = __builtin_amdgcn_mfma_f32_16x16x32_bf16(ld8(G + (size_t)(16 * vt + i16) * 128 + 32 * ks + 8 * q), aq[ks], a1, 0, 0, 0);
            }
            y[vt] = ay + a0 * s0 + a1 * s1; sum += (y[vt][0] + y[vt][1]) + (y[vt][2] + y[vt][3]);
        }
        sum += __shfl_xor(sum, 16); sum += __shfl_xor(sum, 32);
        const float mu = sum * (1.0f / 128.0f); float sq = 0.f;
#pragma unroll
        for (int vt = 0; vt < 8; ++vt) { y[vt] = y[vt] - mu; sq += (y[vt][0] * y[vt][0] + y[vt][1] * y[vt][1]) + (y[vt][2] * y[vt][2] + y[vt][3] * y[vt][3]); }
        sq += __shfl_xor(sq, 16); sq += __shfl_xor(sq, 32);
        const float rstd = 1.0f / sqrtf(sq * (1.0f / 128.0f) + 1e-5f);
#pragma unroll
        for (int vt = 0; vt < 8; ++vt) {
            const u32x2 gw = *(const u32x2*)(qrow + 1536 + 16 * vt + 4 * q);
            const float g0 = bflo(gw.x), g1 = bfhi(gw.x), g2 = bflo(gw.y), g3 = bfhi(gw.y);
            u32x2 w; w.x = pk2(y[vt][0] * rstd * g0 * sigmoidf_(g0), y[vt][1] * rstd * g1 * sigmoidf_(g1)); w.y = pk2(y[vt][2] * rstd * g2 * sigmoidf_(g2), y[vt][3] * rstd * g3 * sigmoidf_(g3));
            *(u32x2*)(qrow + 16 * vt + 4 * q) = w;
        }
    }
}

__device__ __forceinline__ int rw_row(int z, int b, int pp) {
    if (pp < CTXL) return ML + b * CTXL + (z ? CTXL - 1 - pp : pp);
    const int t = pp - CTXL; return b * SEQ + (z ? SEQ - 1 - t : t);
}
__device__ __forceinline__ void rwkv_scan(const Params& p, LAS unsigned char* lds, int wave, int lane) {
    const int blk = blockIdx.x, z = blk >> 4, b = (blk >> 3) & 1, h = blk & 7, tid = threadIdx.x;
    const bf16* prw = (const bf16*)(p.ws + WS_PRW);
    const float* INVN = (const float*)(p.ws + WS_INVN); const float* HW = (const float*)(p.ws + WS_HW) + (size_t)z * MT * 32; const float* HA = (const float*)(p.ws + WS_HA) + (size_t)z * MT * 32;
    LAS float* feat = (LAS float*)lds; LAS float* ybuf = feat + 32 * 6 * 64;
    const int hc = h * 64 + lane;
    const float mu_r = p.in[14][hc], mu_k = p.in[14][512 + hc], mu_v = p.in[14][1024 + hc], k_k = p.in[24][hc], k_a = p.in[25][hc];
    const float w0 = p.in[16][z * 512 + hc], a0 = p.in[19][z * 512 + hc];
    float w2c[32], a2c[32];
#pragma unroll
    for (int j = 0; j < 32; ++j) { w2c[j] = p.in[18][(size_t)(z * 32 + j) * 512 + hc]; a2c[j] = p.in[21][(size_t)(z * 32 + j) * 512 + hc]; }
    const int kg = tid & 15, rg = tid >> 4;
    float x[2][4];
#pragma unroll
    for (int r = 0; r < 2; ++r)
#pragma unroll
        for (int j = 0; j < 4; ++j) x[r][j] = 0.f;
    for (int p0 = 0; p0 < CTXL + SEQ; p0 += 32) {
#pragma unroll 1
        for (int sl = wave; sl < 32; sl += NWAVES) {
            const int R = rw_row(z, b, p0 + sl); const bool hp = has_prev(R), hn = has_next(R);
            const bf16* row = prw + (size_t)R * PLD + hc;
            const float prc = bf1(row[0]), pkc = bf1(row[512]), pvc = bf1(row[1024]);
            const float prp = hp ? bf1(row[-PLD]) : 0.f, pkp = hp ? bf1(row[512 - PLD]) : 0.f, pvp = hp ? bf1(row[1024 - PLD]) : 0.f;
            const float prn = hn ? bf1(row[PLD]) : 0.f, pkn = hn ? bf1(row[512 + PLD]) : 0.f, pvn = hn ? bf1(row[1024 + PLD]) : 0.f;
            const float r = prc + mu_r * (0.5f * (prp + prn) - prc), k = pkc + mu_k * (0.5f * (pkp + pkn) - pkc), v = pvc + mu_v * (0.5f * (pvp + pvn) - pvc);
            const float invn = INVN[(size_t)R * 8 + h];
            const float hwv = HW[(size_t)R * 32 + (lane & 31)], hav = HA[(size_t)R * 32 + (lane & 31)];
            float wp = w0, ap = a0;
#pragma unroll
            for (int j = 0; j < 32; ++j) { wp += __int_as_float(__builtin_amdgcn_readlane(__float_as_int(hwv), j)) * w2c[j]; ap += __int_as_float(__builtin_amdgcn_readlane(__float_as_int(hav), j)) * a2c[j]; }
            const float w = __expf(-0.6065306597126334f * sigmoidf_(wp)), asig = sigmoidf_(ap);
            const float kk = k * k_k * invn, keff = k * (1.0f + (asig - 1.0f) * k_a);
            LAS float* f = feat + sl * 6 * 64 + lane;
            f[0] = -kk; f[64] = kk * asig; f[128] = w; f[192] = keff; f[256] = r; f[320] = v;
        }
        __syncthreads();
#pragma unroll 2
        for (int s = 0; s < 32; ++s) {
            const LAS float* f = feat + s * 6 * 64;
            const f32x4 fa = *(const LAS f32x4*)(f + 4 * kg), fb = *(const LAS f32x4*)(f + 64 + 4 * kg), fw = *(const LAS f32x4*)(f + 128 + 4 * kg), fk = *(const LAS f32x4*)(f + 192 + 4 * kg), fr = *(const LAS f32x4*)(f + 256 + 4 * kg);
            const f32x2 fv = *(const LAS f32x2*)(f + 320 + 2 * rg);
#pragma unroll
            for (int r = 0; r < 2; ++r) {
                float d = (x[r][0] * fa[0] + x[r][1] * fa[1]) + (x[r][2] * fa[2] + x[r][3] * fa[3]);
                const float sa = sum16(d);
                float yd = 0.f;
                if (z == 1) yd = (x[r][0] * fr[0] + x[r][1] * fr[1]) + (x[r][2] * fr[2] + x[r][3] * fr[3]);
#pragma unroll
                for (int j = 0; j < 4; ++j) x[r][j] = x[r][j] * fw[j] + sa * fb[j] + fv[r] * fk[j];
                if (z == 0) yd = (x[r][0] * fr[0] + x[r][1] * fr[1]) + (x[r][2] * fr[2] + x[r][3] * fr[3]);
                yd = sum16(yd);
                if (kg == 0) ybuf[s * 64 + 2 * rg + r] = yd;
            }
        }
        __syncthreads();
        if (p0 >= CTXL) {
            const int sl = tid >> 4, c4 = 4 * (tid & 15); const int R = rw_row(z, b, p0 + sl);
            const f32x4 yv = *(const LAS f32x4*)(ybuf + sl * 64 + c4);
            u32x2 w; w.x = pk2(yv[0], yv[1]); w.y = pk2(yv[2], yv[3]);
            if (z == 0) *(u32x2*)((bf16*)(p.ws + WS_PRW) + (size_t)R * PLD + RW_Y + h * 64 + c4) = w;
            else *(u32x2*)((bf16*)(p.ws + WS_Y1) + (size_t)R * 512 + h * 64 + c4) = w;
        }
    }
}
__device__ __forceinline__ void rwkv_readout(const Params& p, LAS unsigned char* lds, int wave, int lane) {
    LAS bf16* g2s = (LAS bf16*)lds; LAS bf16* a2s = g2s + 96 * 512;
    for (int i = threadIdx.x; i < 96 * 512; i += NTHR) g2s[i] = (bf16)f2bf(p.in[23][i]);
    for (int i = threadIdx.x; i < 32 * 512; i += NTHR) a2s[i] = (bf16)f2bf(p.in[21][i]);
    __syncthreads();
    bf16* prw = (bf16*)(p.ws + WS_PRW); const bf16* Y1 = (const bf16*)(p.ws + WS_Y1);
    const float* HA = (const float*)(p.ws + WS_HA); const float* HG = (const float*)(p.ws + WS_HG);
    const int gw = blockIdx.x * NWAVES + wave, NGW = gridDim.x * NWAVES;
    const int c0 = 8 * lane;
    float mur[8], muk[8], muv[8], kav[8], rkv[8], lnw[8], lnb[8], a0v[8];
#pragma unroll
    for (int e = 0; e < 8; ++e) { mur[e] = p.in[14][c0 + e]; muk[e] = p.in[14][512 + c0 + e]; muv[e] = p.in[14][1024 + c0 + e]; kav[e] = p.in[25][c0 + e]; rkv[e] = p.in[26][c0 + e];
        lnw[e] = p.in[27][c0 + e]; lnb[e] = p.in[28][c0 + e]; a0v[e] = p.in[19][c0 + e]; }
    for (int R = gw; R < ML; R += NGW) {
        bf16* row = prw + (size_t)R * PLD; const bool hp = has_prev(R), hn = has_next(R);
        float y[8], r[8], k[8], v[8];
        { const u32x4 a = *(const u32x4*)(row + RW_Y + c0), bb = *(const u32x4*)(Y1 + (size_t)R * 512 + c0); const unsigned aw[4] = {a.x, a.y, a.z, a.w}, bw[4] = {bb.x, bb.y, bb.z, bb.w};
#pragma unroll
          for (int e = 0; e < 4; ++e) { y[2 * e] = bflo(aw[e]) + bflo(bw[e]); y[2 * e + 1] = bfhi(aw[e]) + bfhi(bw[e]); } }
#pragma unroll
        for (int tns = 0; tns < 3; ++tns) {
            const u32x4 cc = *(const u32x4*)(row + 512 * tns + c0); u32x4 pp = {0u, 0u, 0u, 0u}, nn = {0u, 0u, 0u, 0u};
            if (hp) pp = *(const u32x4*)(row - PLD + 512 * tns + c0); if (hn) nn = *(const u32x4*)(row + PLD + 512 * tns + c0);
            const unsigned cw[4] = {cc.x, cc.y, cc.z, cc.w}, pw[4] = {pp.x, pp.y, pp.z, pp.w}, nw[4] = {nn.x, nn.y, nn.z, nn.w};
#pragma unroll
            for (int e = 0; e < 8; ++e) { const float cv = (e & 1) ? bfhi(cw[e >> 1]) : bflo(cw[e >> 1]), pv = (e & 1) ? bfhi(pw[e >> 1]) : bflo(pw[e >> 1]), nv = (e & 1) ? bfhi(nw[e >> 1]) : bflo(nw[e >> 1]);
                const float mu = tns == 0 ? mur[e] : (tns == 1 ? muk[e] : muv[e]); const float o = cv + mu * (0.5f * (pv + nv) - cv);
                if (tns == 0) r[e] = o; else if (tns == 1) k[e] = o; else v[e] = o; }
        }
        float s = 0.f;
#pragma unroll
        for (int e = 0; e < 8; ++e) s += y[e];
        const float mu = sum8(s) * (1.0f / 64.0f); float sq = 0.f;
#pragma unroll
        for (int e = 0; e < 8; ++e) { y[e] -= mu; sq += y[e] * y[e]; }
        const float rstd = 1.0f / sqrtf(sum8(sq) * (1.0f / 64.0f) + 64e-5f);
        float ap[8], g[8];
#pragma unroll
        for (int e = 0; e < 8; ++e) { ap[e] = a0v[e]; g[e] = 0.f; }
        const float hav = HA[(size_t)R * 32 + (lane & 31)];
#pragma unroll 4
        for (int j = 0; j < 32; ++j) { const float hv = __shfl(hav, j); const u32x4 w = *(const LAS u32x4*)(a2s + j * 512 + c0); const unsigned ww[4] = {w.x, w.y, w.z, w.w};
#pragma unroll
            for (int e = 0; e < 4; ++e) { ap[2 * e] += hv * bflo(ww[e]); ap[2 * e + 1] += hv * bfhi(ww[e]); } }
        const float hg0 = HG[(size_t)R * 96 + lane], hg1 = HG[(size_t)R * 96 + 64 + (lane & 31)];
#pragma unroll 4
        for (int j = 0; j < 96; ++j) { const float hv = j < 64 ? __shfl(hg0, j) : __shfl(hg1, j - 64); const u32x4 w = *(const LAS u32x4*)(g2s + j * 512 + c0); const unsigned ww[4] = {w.x, w.y, w.z, w.w};
#pragma unroll
            for (int e = 0; e < 4; ++e) { g[2 * e] += hv * bflo(ww[e]); g[2 * e + 1] += hv * bfhi(ww[e]); } }
        float bs = 0.f;
#pragma unroll
        for (int e = 0; e < 8; ++e) { const float asig = sigmoidf_(ap[e]); const float keff = k[e] * (1.0f + (asig - 1.0f) * kav[e]); bs += r[e] * keff * rkv[e]; }
        bs = sum8(bs);
        float o[8];
#pragma unroll
        for (int e = 0; e < 8; ++e) o[e] = (y[e] * rstd * lnw[e] + lnb[e] + bs * v[e]) * g[e];
        u32x4 w; w.x = pk2(o[0], o[1]); w.y = pk2(o[2], o[3]); w.z = pk2(o[4], o[5]); w.w = pk2(o[6], o[7]);
        *(u32x4*)(row + RW_Y + c0) = w;
    }
}

constexpr int LDS_BYTES = 147456;
constexpr int NPHASE = 17;
__global__ void __launch_bounds__(NTHR, 2) fwd_megakernel(Params p) {
    extern __shared__ __attribute__((aligned(16))) unsigned char lds_raw[];
    LAS unsigned char* lds = (LAS unsigned char*)lds_raw;
    cg::grid_group grid = cg::this_grid();
    const int tid = threadIdx.x, lane = tid & 63, wave = __builtin_amdgcn_readfirstlane(tid >> 6);
    unsigned char* ws = p.ws;
    const float* x = p.in[0]; const float* ctx = p.in[2];
    float* Hl = p.out; float* Hc = (float*)(ws + WS_HC);
    const float* modv = (const float*)(ws + WS_MODV);
    bf16* U = (bf16*)(ws + WS_U); bf16* ACT = (bf16*)(ws + WS_ACT); bf16* PRET = (bf16*)(ws + WS_PRET); bf16* PRW = (bf16*)(ws + WS_PRW);
    const int lo = p.ph_lo, hi = p.ph_hi, G = gridDim.x, bx = blockIdx.x;
#define IN(k) (lo <= (k) && (k) < hi)
#define SEAM(k) do { if (IN(k) && IN((k) + 1)) grid.sync(); } while (0)

    if (IN(0)) { p0_modv(p, lds); p0_weights(p, lds, wave, lane); } SEAM(0);
    if (IN(1)) norm_rows(x, ctx, p.in[6], modv, 0 * DM, 1 * DM, U, MT, wave, lane); SEAM(1);
    if (IN(2)) { pg8::Gemm g{U, (const bf16*)(ws + WS_GU1), MT, 2 * DFF, DM, DM}; pg8::StaticOrder S; S.init(MT, 2 * DFF, G, bx); EpiSwiGLU E{ACT, DFF};
        pg8::gemm_phase<EpiSwiGLU, pg8::StaticOrder, true, true>(lds, g, S, E); } SEAM(2);
    if (IN(3)) { pg8::Gemm g{ACT, (const bf16*)(ws + WS_D1), MT, DM, DFF, DFF}; pg8::StaticOrder S; S.init(MT, DM, G, bx); EpiResid E{x, ctx, Hl, Hc, modv, 2 * DM, 0.5f};
        pg8::gemm_phase<EpiResid, pg8::StaticOrder, true, true>(lds, g, S, E); } SEAM(3);
    if (IN(4)) norm_rows(Hl, Hc, p.in[10], modv, 3 * DM, 4 * DM, U, MT, wave, lane); SEAM(4);
    if (IN(5)) { pg8::Gemm g{U, (const bf16*)(ws + WS_WIN), MT, 4096, DM, DM}; pg8::StaticOrder S; S.init(MT, 4096, G, bx); EpiB<0, true> E{PRET, PRW, nullptr, PLD};
        pg8::gemm_phase<EpiB<0, true>, pg8::StaticOrder, true, true>(lds, g, S, E); } SEAM(5);
    if (IN(6)) p6_token_prep(p, wave, lane); SEAM(6);
    if (IN(7)) ret_kv_local(p, lds, wave, lane); SEAM(7);
    if (IN(8)) ret_scan(p); SEAM(8);
    if (IN(9)) { if (bx < 32) rwkv_scan(p, lds, wave, lane); else ret_out(p, lds, wave, lane, 32, G - 32); } SEAM(9);
    if (IN(10)) { rwkv_readout(p, lds, wave, lane); norm_rows(Hl, Hc, p.in[10], modv, 3 * DM, 4 * DM, U, ML, wave, lane); } SEAM(10);
    if (IN(11)) {
        pg8::StaticOrder S; S.init(ML, DM, G, bx);
        { pg8::Gemm g{PRET, (const bf16*)(ws + WS_RO), ML, DM, 512, PLD}; EpiB<0, false> E{PRET + 1024, nullptr, nullptr, PLD}; pg8::gemm_phase<EpiB<0, false>, pg8::StaticOrder, false, true>(lds, g, S, E); }
        { pg8::Gemm g{U, (const bf16*)(ws + WS_WG), ML, DM, DM, DM}; EpiB<1, false> E{PRET + 1024, nullptr, nullptr, PLD}; pg8::gemm_phase<EpiB<1, false>, pg8::StaticOrder, false, true>(lds, g, S, E); }
        { pg8::Gemm g{PRW + RW_Y, (const bf16*)(ws + WS_RWO), ML, DM, 512, PLD}; EpiB<0, false> E{PRW, nullptr, nullptr, PLD}; pg8::gemm_phase<EpiB<0, false>, pg8::StaticOrder, false, true>(lds, g, S, E); }
        { pg8::Gemm g{U, (const bf16*)(ws + WS_WG) + (size_t)DM * DM, ML, DM, DM, DM}; EpiB<2, false> E{PRET + 1024, nullptr, PRW, PLD}; pg8::gemm_phase<EpiB<2, false>, pg8::StaticOrder, false, true>(lds, g, S, E); }
    } SEAM(11);
    if (IN(12)) { pg8::Gemm g{PRET + 1024, (const bf16*)(ws + WS_WOUT), ML, DM, DM, PLD}; pg8::StaticOrder S; S.init(ML, DM, G, bx); EpiResid E{Hl, Hc, Hl, Hc, modv, 5 * DM, 1.0f};
        pg8::gemm_phase<EpiResid, pg8::StaticOrder, false, true>(lds, g, S, E); } SEAM(12);
    if (IN(13)) norm_rows(Hl, Hc, p.in[31], modv, 6 * DM, 7 * DM, U, ML, wave, lane); SEAM(13);
    if (IN(14)) { pg8::Gemm g{U, (const bf16*)(ws + WS_GU2), ML, 2 * DFF, DM, DM}; pg8::StaticOrder S; S.init(ML, 2 * DFF, G, bx); EpiSwiGLU E{ACT, DFF};
        pg8::gemm_phase<EpiSwiGLU, pg8::StaticOrder, true, true>(lds, g, S, E); } SEAM(14);
    if (IN(15)) { pg8::Gemm g{ACT, (const bf16*)(ws + WS_D2), ML, DM, DFF, DFF}; pg8::StaticOrder S; S.init(ML, DM, G, bx); EpiResid E{Hl, Hc, Hl, Hc, modv, 8 * DM, 0.5f};
        pg8::gemm_phase<EpiResid, pg8::StaticOrder, false, true>(lds, g, S, E); } SEAM(15);
    if (IN(16)) {
        const int gw = bx * NWAVES + wave, NGW = G * NWAVES; const float* gf = p.in[35];
        for (int R = gw; R < ML; R += NGW) { float* xr = Hl + (size_t)R * DM + 4 * lane; f32x4 v[4]; float s = 0.f;
#pragma unroll
            for (int j = 0; j < 4; ++j) { v[j] = *(const f32x4*)(xr + 256 * j); s += (v[j].x * v[j].x + v[j].y * v[j].y) + (v[j].z * v[j].z + v[j].w * v[j].w); }
            const float rstd = 1.0f / sqrtf(wave_sum(s) * (1.0f / DM) + 1e-6f);
#pragma unroll
            for (int j = 0; j < 4; ++j) *(f32x4*)(xr + 256 * j) = (v[j] * rstd) * *(const f32x4*)(gf + 4 * lane + 256 * j); }
    }
#undef IN
#undef SEAM
}

extern "C" void kernel_launch(void* const* d_in, const int* in_sizes, int n_in, void* d_out, int out_size, void* d_ws, size_t ws_size, hipStream_t stream) {
    static int grid = 0;
    if (grid == 0) {
        if (n_in != 36 || out_size != ML * DM || ws_size < 256 * MiB) { fprintf(stderr, "kernel_launch: unexpected problem (n_in %d out %d ws %zu)\n", n_in, out_size, ws_size); grid = -1; return; }
        int dev = 0, cus = 0, per_cu = 0;
        (void)hipGetDevice(&dev); (void)hipDeviceGetAttribute(&cus, hipDeviceAttributeMultiprocessorCount, dev);
        if (hipFuncSetAttribute((const void*)fwd_megakernel, hipFuncAttributeMaxDynamicSharedMemorySize, LDS_BYTES) != hipSuccess) { fprintf(stderr, "kernel_launch: hipFuncSetAttribute failed\n"); grid = -1; return; }
        if (hipOccupancyMaxActiveBlocksPerMultiprocessor(&per_cu, (const void*)fwd_megakernel, NTHR, LDS_BYTES) != hipSuccess || per_cu < 1) { fprintf(stderr, "kernel_launch: occupancy query says %d\n", per_cu); per_cu = 1; }
        (void)hipGetLastError();
        grid = cus * (per_cu > 1 ? 1 : per_cu);
        fprintf(stderr, "kernel_launch: cus %d per_cu %d grid %d\n", cus, per_cu, grid);
    }
    if (grid < 0) return;
    Params p{};
    for (int i = 0; i < 36; ++i) p.in[i] = (const float*)d_in[i];
    p.out = (float*)d_out; p.ws = (unsigned char*)d_ws; p.ph_lo = 0; p.ph_hi = NPHASE;
    void* args[] = {&p};
    hipError_t e = hipLaunchCooperativeKernel((const void*)fwd_megakernel, dim3(grid), dim3(NTHR), args, LDS_BYTES, stream);
    if (e != hipSuccess) fprintf(stderr, "kernel_launch: cooperative launch failed: %s (grid %d)\n", hipGetErrorString(e), grid);
}
```

```cpp
#include <hip/hip_runtime.h>
#include <hip/hip_cooperative_groups.h>
#include <cstdio>
#include <cstdint>
namespace cg = cooperative_groups;


namespace pg8 {
#define PG8_LAS __attribute__((address_space(3)))
typedef unsigned short bf16_t;
typedef short bf16x8 __attribute__((ext_vector_type(8)));
typedef float f32x4 __attribute__((ext_vector_type(4)));
typedef unsigned u32x4 __attribute__((ext_vector_type(4)));
constexpr int BM = 256, BK = 64, HALF = 128, HTB = HALF * BK * 2  , STAGE_BYTES = 8 * HTB, NXCD = 8, WGM = 8;

__host__ __device__ __forceinline__ int lds_byte(int r, int c) { const int st = (r >> 4) * 2 + (c >> 5), rr = r & 15, cc = c & 31, ob = rr * 64 + cc * 2; return st * 1024 + (ob ^ (((ob >> 9) & 1) << 5)); }
__host__ __device__ __forceinline__ void stage_rc(int b, int& R, int& C) { const int st = b / 1024, sb = b % 1024, swz = sb ^ (((sb >> 9) & 1) << 5); R = (st >> 1) * 16 + swz / 64; C = (st & 1) * 32 + (swz % 64) / 2; }
__host__ __device__ __forceinline__ int perm32(int rho) { const int n = rho >> 4, i = rho & 15; return 8 * (i >> 2) + 4 * n + (i & 3); }

struct Unit { int pm, pn; };
struct Gemm { const bf16_t* A; const bf16_t* Bt; int M, N, K, lda; };

struct StaticOrder {
    int nM, nN, nwg, G, c;
    __host__ __device__ void init(int M, int N, int G_, int c_) { nM = M / BM; nN = N / BM; nwg = nM * nN; G = G_; c = c_; }
    __host__ __device__ bool next(int i, Unit& u) const {
        const long L = (long)i * G + c; if (L >= nwg) return false;
        int wgid = (int)L; { const int q = nwg / NXCD, r = nwg % NXCD, xcd = wgid % NXCD, off = wgid / NXCD; wgid = (xcd < r ? xcd * (q + 1) : r * (q + 1) + (xcd - r) * q) + off; }
        const int nig = WGM * nN, gid = wgid / nig, fm = gid * WGM, gsz = (nM - fm) < WGM ? (nM - fm) : WGM;
        u.pm = fm + ((wgid % nig) % gsz); u.pn = (wgid % nig) / gsz; return true;
    }
    __device__ __forceinline__ void a_ready(const Unit&) const {}
    __device__ __forceinline__ void done(const Unit&) const {}
};

__device__ __forceinline__ unsigned cvt_pk_bf16(float lo, float hi) { unsigned r; asm volatile("v_cvt_pk_bf16_f32 %0, %1, %2" : "=v"(r) : "v"(lo), "v"(hi)); return r; }
template <class Epi, class Sched, bool ALIGN_EPI = false, bool SP2 = false>
__device__ __forceinline__ void gemm_phase(PG8_LAS unsigned char* lds, const Gemm g, const Sched& S, const Epi& E) {
    const int tid = threadIdx.x, wid = __builtin_amdgcn_readfirstlane(tid >> 6), lane = tid & 63, wr = wid >> 2, wc = wid & 3, fr = lane & 15, fq = lane >> 4;
    const int K = g.K, nt = K / BK;
    unsigned voffA[2], voffB[2];
#pragma unroll
    for (int i = 0; i < 2; ++i) { int R, C; stage_rc(tid * 16 + i * 8192, R, C); const int Rb = Epi::PERM ? ((R & ~31) + perm32(R & 31)) : R;
        voffA[i] = (unsigned)(R * g.lda + C) * 2u; voffB[i] = (unsigned)(Rb * K + C) * 2u; }
    const size_t kstep = (size_t)(BK * 2);
    const size_t hstepA = (size_t)HALF * g.lda * 2, hstepB = (size_t)HALF * K * 2;
    const size_t tstepA = 2 * hstepA, tstepB = 2 * hstepB;
    const unsigned ldsw = (unsigned)wid * 1024u;
    const int aoff = lds_byte(wr * 64 + fr, fq * 8), boff = lds_byte(wc * 32 + fr, fq * 8);
#define PG8_SA(b, h) (((b) * 2 + (h)) * HTB)
#define PG8_SB(b, h) ((4 + (b) * 2 + (h)) * HTB)
#define PG8_STAGE(bufoff, gbase, voff) do { _Pragma("unroll") for (int _i = 0; _i < 2; ++_i) \
        __builtin_amdgcn_global_load_lds((const unsigned*)((const char*)(gbase) + (voff)[_i]), (PG8_LAS unsigned*)(lds + (bufoff) + ldsw + _i * 8192), 16, 0, 0); } while (0)
#define PG8_LDA(dst, b, h) do { _Pragma("unroll") for (int m = 0; m < 4; ++m) _Pragma("unroll") for (int k = 0; k < 2; ++k) dst[m][k] = *(const PG8_LAS bf16x8*)(lds + PG8_SA(b, h) + aoff + m * 2048 + k * 1024); } while (0)
#define PG8_LDB(dst, b, h) do { _Pragma("unroll") for (int n = 0; n < 2; ++n) _Pragma("unroll") for (int k = 0; k < 2; ++k) dst[n][k] = *(const PG8_LAS bf16x8*)(lds + PG8_SB(b, h) + boff + n * 2048 + k * 1024); } while (0)
#define PG8_MMA(ai, bj, At, Bt) do { __builtin_amdgcn_s_setprio(1); _Pragma("unroll") for (int m = 0; m < 4; ++m) _Pragma("unroll") for (int n = 0; n < 2; ++n) _Pragma("unroll") for (int k = 0; k < 2; ++k) \
        acc[ai][bj][m][n] = __builtin_amdgcn_mfma_f32_16x16x32_bf16(Bt[n][k], At[m][k], acc[ai][bj][m][n], 0, 0, 0); __builtin_amdgcn_s_setprio(0); } while (0)
#define PG8_WAIT_V(n) asm volatile("s_waitcnt vmcnt(" #n ")" ::: "memory")
#define PG8_WAIT_L(n) asm volatile("s_waitcnt lgkmcnt(" #n ")" ::: "memory")
#define PG8_BAR __builtin_amdgcn_s_barrier()
#define PG8_SCHED __builtin_amdgcn_sched_barrier(0)
    Unit cur, nxt; int ui = 0;
    if (!S.next(0, cur)) return;
    f32x4 acc[2][2][4][2];
#pragma unroll
    for (int a = 0; a < 2; ++a)
#pragma unroll
        for (int b = 0; b < 2; ++b)
#pragma unroll
            for (int m = 0; m < 4; ++m)
#pragma unroll
                for (int n = 0; n < 2; ++n) acc[a][b][m][n] = (f32x4){0.f, 0.f, 0.f, 0.f};
    bf16x8 At[4][2], B0[2][2], B1[2][2];
    const char* cA = (const char*)g.A + (size_t)cur.pm * tstepA; const char* cB = (const char*)g.Bt + (size_t)cur.pn * tstepB;
    S.a_ready(cur);
    if constexpr (SP2) {
        PG8_STAGE(PG8_SB(0, 0), cB, voffB); PG8_STAGE(PG8_SB(0, 1), cB + hstepB, voffB); PG8_STAGE(PG8_SA(0, 0), cA, voffA); PG8_STAGE(PG8_SA(0, 1), cA + hstepA, voffA);
        if (wr == 1) PG8_BAR;
        PG8_WAIT_V(2); PG8_BAR;
        PG8_STAGE(PG8_SB(1, 0), cB + kstep, voffB); PG8_STAGE(PG8_SA(1, 0), cA + kstep, voffA); PG8_STAGE(PG8_SB(1, 1), cB + hstepB + kstep, voffB);
        PG8_WAIT_V(6); PG8_BAR;
    } else {
        PG8_STAGE(PG8_SB(0, 0), cB, voffB); PG8_STAGE(PG8_SA(0, 0), cA, voffA); PG8_STAGE(PG8_SB(0, 1), cB + hstepB, voffB); PG8_STAGE(PG8_SA(0, 1), cA + hstepA, voffA);
        if (wr == 1) PG8_BAR;
        PG8_WAIT_V(4); PG8_BAR;
        PG8_STAGE(PG8_SB(1, 0), cB + kstep, voffB); PG8_STAGE(PG8_SA(1, 0), cA + kstep, voffA); PG8_STAGE(PG8_SB(1, 1), cB + hstepB + kstep, voffB);
        PG8_WAIT_V(6); PG8_BAR;
    }
    for (;;) {
        const bool has_next = S.next(ui + 1, nxt);
        const char* nA = has_next ? (const char*)g.A + (size_t)nxt.pm * tstepA : cA; const char* nB = has_next ? (const char*)g.Bt + (size_t)nxt.pn * tstepB : cB;
        for (int t = 0; t < nt; t += 2) {
            const bool last = (t == nt - 2);
            const char* a1 = cA + (size_t)(t + 1) * kstep;
            const char* a2 = last ? nA : cA + (size_t)(t + 2) * kstep; const char* b2 = last ? nB : cB + (size_t)(t + 2) * kstep;
            const char* a3 = a2 + kstep; const char* b3 = b2 + kstep;
            if (last && has_next) S.a_ready(nxt);
            if constexpr (SP2) {
            PG8_LDB(B0, 0, 0); PG8_LDB(B1, 0, 1); PG8_SCHED; PG8_LDA(At, 0, 0); PG8_STAGE(PG8_SA(1, 1), a1 + hstepA, voffA);
            PG8_WAIT_V(8); PG8_WAIT_L(0); PG8_BAR; PG8_MMA(0, 0, At, B0); PG8_MMA(0, 1, At, B1); PG8_BAR; PG8_SCHED;
            PG8_LDA(At, 0, 1); PG8_STAGE(PG8_SB(0, 0), b2, voffB); PG8_STAGE(PG8_SB(0, 1), b2 + hstepB, voffB); PG8_STAGE(PG8_SA(0, 0), a2, voffA);
            PG8_WAIT_V(8); PG8_WAIT_L(0); PG8_BAR; PG8_MMA(1, 0, At, B0); PG8_MMA(1, 1, At, B1); PG8_BAR; PG8_SCHED;
            PG8_LDB(B0, 1, 0); PG8_LDB(B1, 1, 1); PG8_SCHED; PG8_LDA(At, 1, 0); PG8_STAGE(PG8_SA(0, 1), a2 + hstepA, voffA);
            PG8_WAIT_V(8); PG8_WAIT_L(0); PG8_BAR; PG8_MMA(0, 0, At, B0); PG8_MMA(0, 1, At, B1); PG8_BAR; PG8_SCHED;
            PG8_LDA(At, 1, 1); PG8_STAGE(PG8_SB(1, 0), b3, voffB); PG8_STAGE(PG8_SB(1, 1), b3 + hstepB, voffB); PG8_STAGE(PG8_SA(1, 0), a3, voffA);
            PG8_WAIT_V(8); PG8_WAIT_L(0); PG8_BAR; PG8_MMA(1, 0, At, B0); PG8_MMA(1, 1, At, B1); PG8_BAR; PG8_SCHED;
            } else {
            PG8_LDB(B0, 0, 0); PG8_SCHED; PG8_LDA(At, 0, 0); PG8_STAGE(PG8_SA(1, 1), a1 + hstepA, voffA);
            PG8_WAIT_L(8); PG8_BAR; PG8_WAIT_L(0); PG8_MMA(0, 0, At, B0); PG8_BAR; PG8_SCHED;
            PG8_LDB(B1, 0, 1); PG8_STAGE(PG8_SB(0, 0), b2, voffB);
            PG8_BAR; PG8_WAIT_L(0); PG8_MMA(0, 1, At, B1); PG8_BAR;
            PG8_LDA(At, 0, 1); PG8_STAGE(PG8_SA(0, 0), a2, voffA);
            PG8_BAR; PG8_WAIT_L(0); PG8_MMA(1, 0, At, B0); PG8_BAR; PG8_SCHED;
            PG8_STAGE(PG8_SB(0, 1), b2 + hstepB, voffB);
            PG8_WAIT_V(6); PG8_BAR; PG8_MMA(1, 1, At, B1); PG8_BAR;
            PG8_LDB(B0, 1, 0); PG8_SCHED; PG8_LDA(At, 1, 0); PG8_STAGE(PG8_SA(0, 1), a2 + hstepA, voffA);
            PG8_WAIT_L(8); PG8_BAR; PG8_WAIT_L(0); PG8_MMA(0, 0, At, B0); PG8_BAR; PG8_SCHED;
            PG8_LDB(B1, 1, 1); PG8_STAGE(PG8_SB(1, 0), b3, voffB);
            PG8_BAR; PG8_WAIT_L(0); PG8_MMA(0, 1, At, B1); PG8_BAR;
            PG8_LDA(At, 1, 1); PG8_STAGE(PG8_SA(1, 0), a3, voffA);
            PG8_BAR; PG8_WAIT_L(0); PG8_MMA(1, 0, At, B0); PG8_BAR; PG8_SCHED;
            PG8_STAGE(PG8_SB(1, 1), b3 + hstepB, voffB);
            PG8_WAIT_V(6); PG8_BAR; PG8_MMA(1, 1, At, B1); PG8_BAR;
            }
        }
        if constexpr (ALIGN_EPI) { if (wr == 0) PG8_BAR; }
        if constexpr (!Epi::AFTER_DRAIN) { E(acc, cur, wr, wc, fr, fq); S.done(cur); }
        if (!has_next) break;
#pragma unroll
        for (int a = 0; a < 2; ++a)
#pragma unroll
            for (int b = 0; b < 2; ++b)
#pragma unroll
                for (int m = 0; m < 4; ++m)
#pragma unroll
                    for (int n = 0; n < 2; ++n) acc[a][b][m][n] = (f32x4){0.f, 0.f, 0.f, 0.f};
        cur = nxt; cA = nA; cB = nB; ++ui;
        if constexpr (ALIGN_EPI) { if (wr == 1) PG8_BAR; }
    }
    PG8_WAIT_V(0);
    if constexpr (!ALIGN_EPI) { if (wr == 0) PG8_BAR; }
    PG8_BAR;
    if constexpr (Epi::AFTER_DRAIN) { E.fused(acc, cur, wr, wc, fr, fq, lds, wid, lane); S.done(cur); }
#undef PG8_SA
#undef PG8_SB
#undef PG8_STAGE
#undef PG8_LDA
#undef PG8_LDB
#undef PG8_MMA
#undef PG8_WAIT_V
#undef PG8_WAIT_L
#undef PG8_BAR
#undef PG8_SCHED
}
}

#define LAS __attribute__((address_space(3)))
typedef unsigned short bf16;
typedef float f32x4 __attribute__((ext_vector_type(4)));
typedef float f32x2 __attribute__((ext_vector_type(2)));
typedef unsigned u32x4 __attribute__((ext_vector_type(4)));
typedef unsigned u32x2 __attribute__((ext_vector_type(2)));
typedef short bf16x8 __attribute__((ext_vector_type(8)));
typedef short s16x4 __attribute__((ext_vector_type(4)));

constexpr int NTHR = 512, NWAVES = 8;
constexpr int DM = 1024, BATCH = 2, SEQ = 8192, CTXL = 256;
constexpr int ML = BATCH * SEQ, MC = BATCH * CTXL, MT = ML + MC;
constexpr int DFF = 2816, NMODV = 9 * DM, INW = 5632;
constexpr int PLD = 2048;
constexpr int RW_LA = 1536, RW_LB = 1760, RW_Y = 1536;
constexpr int NCH_RET = 66;
constexpr size_t MiB = 1u << 20;
constexpr size_t WS_MODV = 0;
constexpr size_t WS_GU1 = 12 * MiB, WS_D1 = 23 * MiB, WS_WIN = WS_D1 + 11 * MiB / 2, WS_WG = WS_WIN + 8 * MiB, WS_RO = WS_WG + 4 * MiB, WS_RWO = WS_RO + MiB,
                 WS_WOUT = WS_RWO + MiB, WS_GU2 = WS_WOUT + 2 * MiB, WS_D2 = WS_GU2 + 11 * MiB, WS_U = WS_D2 + 11 * MiB / 2;
static_assert(WS_U == 61 * MiB, "ws map");
constexpr size_t WS_HC = WS_U + 33 * MiB, WS_BIG = WS_HC + 2 * MiB;
constexpr size_t WS_ACT = WS_BIG, WS_PRET = WS_BIG, WS_PRW = WS_BIG + 66 * MiB, WS_Y1 = WS_BIG + 132 * MiB;
constexpr size_t WS_RETKV = WS_U;
constexpr size_t WS_INVN = WS_GU1, WS_HW = WS_INVN + 3 * MiB / 4, WS_HA = WS_HW + 17 * MiB / 4, WS_HG = WS_HA + 17 * MiB / 4;
static_assert(WS_HG + (size_t)MT * 96 * 4 <= WS_WIN, "small arrays");
static_assert(WS_Y1 + (size_t)ML * 512 * 2 <= 256 * MiB, "ws end");

struct Params { const float* in[36]; float* out; unsigned char* ws; int ph_lo, ph_hi; };

__device__ __forceinline__ unsigned f2bf(float f) { unsigned u = __float_as_uint(f); return (u + 0x7fffu + ((u >> 16) & 1u)) >> 16; }
__device__ __forceinline__ unsigned pk2(float lo, float hi) { return f2bf(lo) | (f2bf(hi) << 16); }
__device__ __forceinline__ float bflo(unsigned w) { return __uint_as_float(w << 16); }
__device__ __forceinline__ float bfhi(unsigned w) { return __uint_as_float(w & 0xffff0000u); }
__device__ __forceinline__ float bf1(bf16 h) { return __uint_as_float((unsigned)h << 16); }
__device__ __forceinline__ float sigmoidf_(float x) { return __builtin_amdgcn_rcpf(1.0f + __expf(-x)); }
__device__ __forceinline__ float wave_sum(float v) {
#pragma unroll
    for (int o = 1; o < 64; o <<= 1) v += __shfl_xor(v, o);
    return v;
}
template <int CTRL> __device__ __forceinline__ float dpp_add(float v) { return v + __int_as_float(__builtin_amdgcn_update_dpp(0, __float_as_int(v), CTRL, 0xF, 0xF, true)); }
__device__ __forceinline__ float sum4(float v) { v = dpp_add<0xB1>(v); v = dpp_add<0x4E>(v); return v; }
__device__ __forceinline__ float sum8(float v) { v = sum4(v); v = dpp_add<0x141>(v); return v; }
__device__ __forceinline__ float sum16(float v) { v = sum8(v); v = dpp_add<0x140>(v); return v; }
__device__ __forceinline__ int mod_set(int R) { return R < SEQ ? 0 : (R < ML ? 1 : 2); }
__device__ __forceinline__ bool has_prev(int R) { return R < ML ? (R & (SEQ - 1)) != 0 : ((R - ML) & (CTXL - 1)) != 0; }
__device__ __forceinline__ bool has_next(int R) { return R < ML ? (R & (SEQ - 1)) != SEQ - 1 : ((R - ML) & (CTXL - 1)) != CTXL - 1; }

using pg8::Unit;
struct EpiSwiGLU {
    static constexpr bool PERM = true, AFTER_DRAIN = false;
    bf16* O; int ldo;
    __device__ __forceinline__ void operator()(const f32x4 (&acc)[2][2][4][2], const Unit& u, int wr, int wc, int fr, int fq) const {
        const int row0 = u.pm * 256 + wr * 64 + fr, col0 = u.pn * 128 + wc * 32 + 8 * fq;
#pragma unroll
        for (int ai = 0; ai < 2; ++ai)
#pragma unroll
            for (int m = 0; m < 4; ++m) {
                bf16* rowp = O + (size_t)(row0 + ai * 128 + m * 16) * ldo + col0;
                float v[8];
#pragma unroll
                for (int n = 0; n < 2; ++n)
#pragma unroll
                    for (int i = 0; i < 4; ++i) { const float g = acc[ai][0][m][n][i], up = acc[ai][1][m][n][i]; v[4 * n + i] = g * sigmoidf_(g) * up; }
                u32x4 w; w.x = pg8::cvt_pk_bf16(v[0], v[1]); w.y = pg8::cvt_pk_bf16(v[2], v[3]); w.z = pg8::cvt_pk_bf16(v[4], v[5]); w.w = pg8::cvt_pk_bf16(v[6], v[7]);
                *(u32x4*)rowp = w;
            }
    }
};
struct EpiResid {
    static constexpr bool PERM = false, AFTER_DRAIN = false;
    const float* base_lat; const float* base_ctx; float* out_lat; float* out_ctx; const float* modv; int modoff; float sc;
    __device__ __forceinline__ void operator()(const f32x4 (&acc)[2][2][4][2], const Unit& u, int wr, int wc, int fr, int fq) const {
        const bool isc = u.pm >= 64; const int pml = isc ? u.pm - 64 : u.pm;
        const float* base = isc ? base_ctx : base_lat; float* out = isc ? out_ctx : out_lat;
        const float* gate = modv + (isc ? 2 : (u.pm >= 32 ? 1 : 0)) * NMODV + modoff;
        const int col0 = u.pn * 256 + wc * 32 + 4 * fq;
        f32x4 gv[2][2];
#pragma unroll
        for (int bj = 0; bj < 2; ++bj)
#pragma unroll
            for (int n = 0; n < 2; ++n) gv[bj][n] = *(const f32x4*)(gate + col0 + bj * 128 + n * 16) * sc;
#pragma unroll
        for (int ai = 0; ai < 2; ++ai)
#pragma unroll
            for (int m = 0; m < 4; ++m) {
                const size_t off = (size_t)(pml * 256 + ai * 128 + wr * 64 + m * 16 + fr) * DM + col0;
#pragma unroll
                for (int bj = 0; bj < 2; ++bj)
#pragma unroll
                    for (int n = 0; n < 2; ++n) { const f32x4 b = *(const f32x4*)(base + off + bj * 128 + n * 16); *(f32x4*)(out + off + bj * 128 + n * 16) = b + gv[bj][n] * acc[ai][bj][m][n]; }
                asm volatile("" ::: "memory");
            }
    }
};
template <int MODE, bool SPLIT> struct EpiB {
    static constexpr bool PERM = true, AFTER_DRAIN = false;
    bf16* O; bf16* O2; const bf16* X; int ld;
    __device__ __forceinline__ void operator()(const f32x4 (&acc)[2][2][4][2], const Unit& u, int wr, int wc, int fr, int fq) const {
        int pn = u.pn; bf16* Ob = O; if (SPLIT && pn >= 8) { pn -= 8; Ob = O2; }
        const int row0 = u.pm * 256 + wr * 64 + fr, col0 = pn * 256 + wc * 32 + 8 * fq;
#pragma unroll
        for (int ai = 0; ai < 2; ++ai)
#pragma unroll
            for (int m = 0; m < 4; ++m) {
                const size_t off = (size_t)(row0 + ai * 128 + m * 16) * ld + col0;
#pragma unroll
                for (int bj = 0; bj < 2; ++bj) {
                    float v[8];
#pragma unroll
                    for (int n = 0; n < 2; ++n)
#pragma unroll
                        for (int i = 0; i < 4; ++i) v[4 * n + i] = acc[ai][bj][m][n][i];
                    if (MODE == 1) { const u32x4 o = *(const u32x4*)(Ob + off + bj * 128);
                        const unsigned ow[4] = {o.x, o.y, o.z, o.w};
#pragma unroll
                        for (int i = 0; i < 4; ++i) { v[2 * i] = sigmoidf_(v[2 * i]) * bflo(ow[i]); v[2 * i + 1] = sigmoidf_(v[2 * i + 1]) * bfhi(ow[i]); } }
                    if (MODE == 2) { const u32x4 o = *(const u32x4*)(Ob + off + bj * 128); const u32x4 x = *(const u32x4*)(X + off + bj * 128);
                        const unsigned ow[4] = {o.x, o.y, o.z, o.w}, xw[4] = {x.x, x.y, x.z, x.w};
#pragma unroll
                        for (int i = 0; i < 4; ++i) { v[2 * i] = bflo(ow[i]) + sigmoidf_(v[2 * i]) * bflo(xw[i]); v[2 * i + 1] = bfhi(ow[i]) + sigmoidf_(v[2 * i + 1]) * bfhi(xw[i]); } }
                    u32x4 w; w.x = pg8::cvt_pk_bf16(v[0], v[1]); w.y = pg8::cvt_pk_bf16(v[2], v[3]); w.z = pg8::cvt_pk_bf16(v[4], v[5]); w.w = pg8::cvt_pk_bf16(v[6], v[7]);
                    *(u32x4*)(Ob + off + bj * 128) = w;
                }
                asm volatile("" ::: "memory");
            }
    }
};

__device__ __forceinline__ void tr_item(const float* W, int ldw, int K, int c0, int kb, bf16* WT, int drow, const float* mu, float sa, float sb, LAS float* scr, int lane) {
    const int k0 = 64 * kb;
#pragma unroll 8
    for (int i = 0; i < 32; ++i) { const int kk = 2 * i + (lane >> 5); float v = W[(size_t)(k0 + kk) * ldw + c0 + (lane & 31)]; if (mu) v *= sa + sb * mu[k0 + kk]; scr[kk * 33 + (lane & 31)] = v; }
    asm volatile("s_waitcnt lgkmcnt(0)" ::: "memory");
    const int c = lane & 7;
#pragma unroll
    for (int j = 0; j < 4; ++j) { const int n = (lane >> 3) + 8 * j; const LAS float* s = scr + (8 * c) * 33 + n;
        u32x4 o; o.x = pk2(s[0 * 33], s[1 * 33]); o.y = pk2(s[2 * 33], s[3 * 33]); o.z = pk2(s[4 * 33], s[5 * 33]); o.w = pk2(s[6 * 33], s[7 * 33]);
        *(u32x4*)(WT + (size_t)(drow + n) * K + k0 + 8 * c) = o; }
    asm volatile("s_waitcnt lgkmcnt(0)" ::: "memory");
}
struct TrJob { const float* W; int ldw, K, c0, nc; bf16* WT; int mode, r0; const float* mu; float sa, sb; };
constexpr int NTRJOB = 21;
__device__ __forceinline__ TrJob tr_job(int j, const Params& p) {
    unsigned char* ws = p.ws; TrJob J; J.mu = nullptr; J.sa = 1.f; J.sb = 0.f; J.mode = 0; J.r0 = 0; J.c0 = 0;
    const float* mux = p.in[15];
    switch (j) {
    case 0: J.W = p.in[7]; J.ldw = DFF; J.K = DM; J.nc = DFF; J.WT = (bf16*)(ws + WS_GU1); J.mode = 1; break;
    case 1: J.W = p.in[8]; J.ldw = DFF; J.K = DM; J.nc = DFF; J.WT = (bf16*)(ws + WS_GU1); J.mode = 2; break;
    case 2: J.W = p.in[9]; J.ldw = DM; J.K = DFF; J.nc = DM; J.WT = (bf16*)(ws + WS_D1); break;
    case 3: J.W = p.in[11]; J.ldw = INW; J.K = DM; J.nc = 3584; J.WT = (bf16*)(ws + WS_WIN); break;
    case 4: J.W = p.in[11]; J.ldw = INW; J.K = DM; J.c0 = 3584; J.nc = 2048; J.WT = (bf16*)(ws + WS_WG); break;
    case 5: J.W = p.in[17]; J.ldw = 32; J.K = DM; J.nc = 32; J.WT = (bf16*)(ws + WS_WIN); J.r0 = 3584; J.mu = mux; J.sa = 1.f; J.sb = -1.f; break;
    case 6: J.W = p.in[17] + DM * 32; J.ldw = 32; J.K = DM; J.nc = 32; J.WT = (bf16*)(ws + WS_WIN); J.r0 = 3616; J.mu = mux; J.sa = 1.f; J.sb = -1.f; break;
    case 7: J.W = p.in[20]; J.ldw = 32; J.K = DM; J.nc = 32; J.WT = (bf16*)(ws + WS_WIN); J.r0 = 3648; J.mu = mux + DM; J.sa = 1.f; J.sb = -1.f; break;
    case 8: J.W = p.in[20] + DM * 32; J.ldw = 32; J.K = DM; J.nc = 32; J.WT = (bf16*)(ws + WS_WIN); J.r0 = 3680; J.mu = mux + DM; J.sa = 1.f; J.sb = -1.f; break;
    case 9: J.W = p.in[22]; J.ldw = 96; J.K = DM; J.nc = 96; J.WT = (bf16*)(ws + WS_WIN); J.r0 = 3712; J.mu = mux + 2 * DM; J.sa = 1.f; J.sb = -1.f; break;
    case 10: J.W = p.in[17]; J.ldw = 32; J.K = DM; J.nc = 32; J.WT = (bf16*)(ws + WS_WIN); J.r0 = 3808; J.mu = mux; J.sa = 0.f; J.sb = 1.f; break;
    case 11: J.W = p.in[17] + DM * 32; J.ldw = 32; J.K = DM; J.nc = 32; J.WT = (bf16*)(ws + WS_WIN); J.r0 = 3840; J.mu = mux; J.sa = 0.f; J.sb = 1.f; break;
    case 12: J.W = p.in[20]; J.ldw = 32; J.K = DM; J.nc = 32; J.WT = (bf16*)(ws + WS_WIN); J.r0 = 3872; J.mu = mux + DM; J.sa = 0.f; J.sb = 1.f; break;
    case 13: J.W = p.in[20] + DM * 32; J.ldw = 32; J.K = DM; J.nc = 32; J.WT = (bf16*)(ws + WS_WIN); J.r0 = 3904; J.mu = mux + DM; J.sa = 0.f; J.sb = 1.f; break;
    case 14: J.W = p.in[22]; J.ldw = 96; J.K = DM; J.nc = 96; J.WT = (bf16*)(ws + WS_WIN); J.r0 = 3936; J.mu = mux + 2 * DM; J.sa = 0.f; J.sb = 1.f; break;
    case 15: J.W = p.in[13]; J.ldw = DM; J.K = 512; J.nc = DM; J.WT = (bf16*)(ws + WS_RO); break;
    case 16: J.W = p.in[29]; J.ldw = DM; J.K = 512; J.nc = DM; J.WT = (bf16*)(ws + WS_RWO); break;
    case 17: J.W = p.in[30]; J.ldw = DM; J.K = DM; J.nc = DM; J.WT = (bf16*)(ws + WS_WOUT); break;
    case 18: J.W = p.in[32]; J.ldw = DFF; J.K = DM; J.nc = DFF; J.WT = (bf16*)(ws + WS_GU2); J.mode = 1; break;
    case 19: J.W = p.in[33]; J.ldw = DFF; J.K = DM; J.nc = DFF; J.WT = (bf16*)(ws + WS_GU2); J.mode = 2; break;
    default: J.W = p.in[34]; J.ldw = DM; J.K = DFF; J.nc = DM; J.WT = (bf16*)(ws + WS_D2); break;
    }
    return J;
}
__device__ __forceinline__ void p0_weights(const Params& p, LAS unsigned char* lds, int wave, int lane, int j0, int j1) {
    LAS float* scr = (LAS float*)(lds + wave * 16384);
    const int gw = blockIdx.x * NWAVES + wave, NGW = gridDim.x * NWAVES;
    int base = 0;
    for (int j = j0; j < j1; ++j) {
        const TrJob J = tr_job(j, p);
        const int nnb = J.nc / 32, nit = (J.K / 64) * nnb;
        int it = gw - (base % NGW); if (it < 0) it += NGW;
        for (; it < nit; it += NGW) {
            const int kb = it / nnb, nb = it % nnb, n0 = 32 * nb;
            const int drow = J.mode == 0 ? J.r0 + n0 : ((n0 >> 7) * 256 + (n0 & 127) + (J.mode == 2 ? 128 : 0));
            tr_item(J.W, J.ldw, J.K, J.c0 + n0, kb, J.WT, drow, J.mu, J.sa, J.sb, scr, lane);
        }
        base += nit;
    }
    if (j0 == 0) { u32x4* z = (u32x4*)((bf16*)(p.ws + WS_WIN) + (size_t)4032 * DM); const int n16 = 64 * DM * 2 / 16;
      for (int i = blockIdx.x * NTHR + threadIdx.x; i < n16; i += gridDim.x * NTHR) z[i] = (u32x4){0u, 0u, 0u, 0u}; }
}
__device__ __forceinline__ void p0_modv(const Params& p, LAS unsigned char* lds) {
    const float* c = p.in[1]; const float* cc = p.in[3]; const float* wm = p.in[4]; const float* bm = p.in[5];
    float* modv = (float*)(p.ws + WS_MODV);
    LAS float* red = (LAS float*)lds;
    const int tid = threadIdx.x, cl = tid & 15, kg = tid >> 4;
    for (int it = blockIdx.x; it < NMODV / 64; it += gridDim.x) {
        const int n0 = it * 64 + 4 * cl;
        f32x4 a0 = {0.f, 0.f, 0.f, 0.f}, a1 = a0, a2 = a0;
#pragma unroll 4
        for (int i = 0; i < 32; ++i) { const int k = kg * 32 + i; const f32x4 w = *(const f32x4*)(wm + (size_t)k * NMODV + n0);
            const float x0 = c[k], x1 = c[DM + k], x2 = cc[k];
            a0 += w * (x0 * sigmoidf_(x0)); a1 += w * (x1 * sigmoidf_(x1)); a2 += w * (x2 * sigmoidf_(x2)); }
        *(LAS f32x4*)(red + (kg * 3 + 0) * 64 + 4 * cl) = a0; *(LAS f32x4*)(red + (kg * 3 + 1) * 64 + 4 * cl) = a1; *(LAS f32x4*)(red + (kg * 3 + 2) * 64 + 4 * cl) = a2;
        __syncthreads();
        if (tid < 192) { const int s = tid >> 6, col = tid & 63; float v = bm[it * 64 + col];
            for (int g = 0; g < 32; ++g) v += red[(g * 3 + s) * 64 + col];
            modv[s * NMODV + it * 64 + col] = v; }
        __syncthreads();
    }
}
__device__ __forceinline__ void norm_rows(const float* hl, const float* hc, const float* g, const float* modv, int shift_off, int scale_off, bf16* U, int nrows, int wave, int lane) {
    const int gw = blockIdx.x * NWAVES + wave, NGW = gridDim.x * NWAVES;
    for (int R = gw; R < nrows; R += NGW) {
        const float* xr = (R < ML ? hl + (size_t)R * DM : hc + (size_t)(R - ML) * DM) + 4 * lane;
        f32x4 v[4]; float s = 0.f;
#pragma unroll
        for (int j = 0; j < 4; ++j) { v[j] = *(const f32x4*)(xr + 256 * j); s += (v[j].x * v[j].x + v[j].y * v[j].y) + (v[j].z * v[j].z + v[j].w * v[j].w); }
        const float rstd = 1.0f / sqrtf(wave_sum(s) * (1.0f / DM) + 1e-6f);
        const float* mv = modv + mod_set(R) * NMODV;
        u32x2* o = (u32x2*)(U + (size_t)R * DM + 4 * lane);
#pragma unroll
        for (int j = 0; j < 4; ++j) { const int col = 4 * lane + 256 * j; const f32x4 gg = *(const f32x4*)(g + col), sh = *(const f32x4*)(mv + shift_off + col), sc = *(const f32x4*)(mv + scale_off + col);
            const f32x4 y = (v[j] * rstd) * gg * (sc + 1.0f) + sh; u32x2 w; w.x = pk2(y.x, y.y); w.y = pk2(y.z, y.w); o[64 * j] = w; }
    }
}

__device__ __forceinline__ void p6_token_prep(const Params& p, int wave, int lane) {
    bf16* pret = (bf16*)(p.ws + WS_PRET); const bf16* prw = (const bf16*)(p.ws + WS_PRW);
    float* INVN = (float*)(p.ws + WS_INVN); float* HW = (float*)(p.ws + WS_HW); float* HA = (float*)(p.ws + WS_HA); float* HG = (float*)(p.ws + WS_HG);
    const float* mu_k = p.in[14] + 512; const float* k_k = p.in[24];
    const int gw = blockIdx.x * NWAVES + wave, NGW = gridDim.x * NWAVES;
    for (int R = gw; R < MT; R += NGW) {
        {
            const int P0 = 8 * lane, T = P0 >> 8, hd = (P0 >> 6) & 3, s = (P0 >> 5) & 1, i0 = P0 & 31;
            bf16* z1p = pret + (size_t)R * PLD + T * 512 + hd * 128 + s * 64 + i0;
            const u32x4 a = *(const u32x4*)z1p, b = *(const u32x4*)(z1p + 32);
            const unsigned aw[4] = {a.x, a.y, a.z, a.w}, bw[4] = {b.x, b.y, b.z, b.w};
            float z1[8], z2[8], o1[8], o2[8];
#pragma unroll
            for (int e = 0; e < 4; ++e) { z1[2 * e] = bflo(aw[e]); z1[2 * e + 1] = bfhi(aw[e]); z2[2 * e] = bflo(bw[e]); z2[2 * e + 1] = bfhi(bw[e]); }
            const bool lat = R < ML; const int t = R & (SEQ - 1); const float pos = (float)(s == 0 ? (t >> 6) : (t & 63));
            const float ksc = T == 1 ? 0.08838834764831845f : 1.0f;
#pragma unroll
            for (int e = 0; e < 8; ++e) {
                float cs = 1.f, sn = 0.f;
                if (lat) { const float inv = exp2f(-(float)(i0 + e) * 0.4152410118609203f); const float rev = pos * inv * 0.15915494309189535f; sn = __builtin_amdgcn_sinf(rev); cs = __builtin_amdgcn_cosf(rev); }
                o1[e] = (z1[e] * cs - z2[e] * sn) * ksc; o2[e] = (z1[e] * sn + z2[e] * cs) * ksc;
            }
            u32x4 w1, w2; w1.x = pk2(o1[0], o1[1]); w1.y = pk2(o1[2], o1[3]); w1.z = pk2(o1[4], o1[5]); w1.w = pk2(o1[6], o1[7]);
            w2.x = pk2(o2[0], o2[1]); w2.y = pk2(o2[2], o2[3]); w2.z = pk2(o2[4], o2[5]); w2.w = pk2(o2[6], o2[7]);
            *(u32x4*)z1p = w1; *(u32x4*)(z1p + 32) = w2;
        }
        const bool hp = has_prev(R), hn = has_next(R);
        const bf16* row = prw + (size_t)R * PLD; const bf16* rowp = row - PLD; const bf16* rown = row + PLD;
#pragma unroll
        for (int jj = 0; jj < 4; ++jj) { const int j = lane + 64 * jj;
            if (j < 224) { const float la = bf1(row[RW_LA + j]); const float lp = hp ? bf1(rowp[RW_LB + j]) : 0.f, ln = hn ? bf1(rown[RW_LB + j]) : 0.f;
                const float hv = la + 0.5f * (lp + ln);
                if (j < 64) HW[((size_t)(j >> 5) * MT + R) * 32 + (j & 31)] = 1.0f - 2.0f * __builtin_amdgcn_rcpf(__expf(2.0f * hv) + 1.0f);
                else if (j < 128) HA[((size_t)((j - 64) >> 5) * MT + R) * 32 + ((j - 64) & 31)] = hv;
                else HG[(size_t)R * 96 + (j - 128)] = sigmoidf_(hv); } }
        {
            const u32x4 kc = *(const u32x4*)(row + 512 + 8 * lane); u32x4 kp = {0u, 0u, 0u, 0u}, kn = {0u, 0u, 0u, 0u};
            if (hp) kp = *(const u32x4*)(rowp + 512 + 8 * lane); if (hn) kn = *(const u32x4*)(rown + 512 + 8 * lane);
            const unsigned cw[4] = {kc.x, kc.y, kc.z, kc.w}, pw[4] = {kp.x, kp.y, kp.z, kp.w}, nw[4] = {kn.x, kn.y, kn.z, kn.w};
            float ss = 0.f;
#pragma unroll
            for (int e = 0; e < 8; ++e) { const int c = 8 * lane + e; const float kcv = (e & 1) ? bfhi(cw[e >> 1]) : bflo(cw[e >> 1]), kpv = (e & 1) ? bfhi(pw[e >> 1]) : bflo(pw[e >> 1]), knv = (e & 1) ? bfhi(nw[e >> 1]) : bflo(nw[e >> 1]);
                const float k = kcv + mu_k[c] * (0.5f * (kpv + knv) - kcv); const float kr = k * k_k[c]; ss += kr * kr; }
            ss = sum8(ss);
            if ((lane & 7) == 0) INVN[(size_t)R * 8 + (lane >> 3)] = 1.0f / fmaxf(sqrtf(ss), 1e-12f);
        }
    }
}

__device__ __forceinline__ float ret_loggamma(const Params& p, int d, int h) { const float x = p.in[12][d * 4 + h]; return -log1pf(expf(-x)); }
__device__ __forceinline__ bf16x8 ld8(const bf16* ptr) { return *(const bf16x8*)ptr; }
__device__ __forceinline__ void ret_kv_local(const Params& p, LAS unsigned char* lds, int wave, int lane) {
    const bf16* pret = (const bf16*)(p.ws + WS_PRET); bf16* KV = (bf16*)(p.ws + WS_RETKV);
    LAS bf16* KT = (LAS bf16*)lds; LAS bf16* VT0 = KT + 128 * 136; LAS bf16* VT1 = VT0 + 128 * 136;
    const int tid = threadIdx.x, i16 = lane & 15, q = lane >> 4;
    for (int it = blockIdx.x; it < 2 * 4 * NCH_RET; it += gridDim.x) {
        const int cc = it % NCH_RET, h = (it / NCH_RET) & 3, b = it / (NCH_RET * 4);
        const int R0 = cc < 2 ? ML + b * CTXL + cc * 128 : b * SEQ + (cc - 2) * 128;
        const float l0 = ret_loggamma(p, 0, h) * 1.4426950408889634f, l1 = ret_loggamma(p, 1, h) * 1.4426950408889634f;
        __syncthreads();
#pragma unroll
        for (int i = 0; i < 4; ++i) { const int idx = tid + NTHR * i, tok = idx & 127, c8 = idx >> 7;
            const bf16* rp = pret + (size_t)(R0 + tok) * PLD + h * 128 + 8 * c8;
            const u32x4 kk = *(const u32x4*)(rp + 512), vv = *(const u32x4*)(rp + 1024);
            const unsigned kw[4] = {kk.x, kk.y, kk.z, kk.w}, vw[4] = {vv.x, vv.y, vv.z, vv.w};
            const float w0 = exp2f(l0 * (float)(127 - tok)), w1 = exp2f(l1 * (float)tok);
#pragma unroll
            for (int e = 0; e < 8; ++e) { const unsigned ke = (e & 1) ? (kw[e >> 1] >> 16) : (kw[e >> 1] & 0xffffu); const float ve = (e & 1) ? bfhi(vw[e >> 1]) : bflo(vw[e >> 1]);
                KT[(8 * c8 + e) * 136 + tok] = (bf16)ke; VT0[(8 * c8 + e) * 136 + tok] = (bf16)f2bf(ve * w0); VT1[(8 * c8 + e) * 136 + tok] = (bf16)f2bf(ve * w1); } }
        __syncthreads();
#pragma unroll
        for (int d = 0; d < 2; ++d) {
            const LAS bf16* VT = d ? VT1 : VT0;
            f32x4 acc[8];
#pragma unroll
            for (int ct = 0; ct < 8; ++ct) acc[ct] = (f32x4){0.f, 0.f, 0.f, 0.f};
#pragma unroll
            for (int ks = 0; ks < 4; ++ks) {
                const bf16x8 af = *(const LAS bf16x8*)(VT + (16 * wave + i16) * 136 + 32 * ks + 8 * q);
#pragma unroll
                for (int ct = 0; ct < 8; ++ct) { const bf16x8 bfr = *(const LAS bf16x8*)(KT + (16 * ct + i16) * 136 + 32 * ks + 8 * q);
                    acc[ct] = __builtin_amdgcn_mfma_f32_16x16x32_bf16(bfr, af, acc[ct], 0, 0, 0); }
            }
            bf16* o = KV + ((size_t)(((b * 4 + h) * 2 + d) * NCH_RET + cc) * 128 + 16 * wave + i16) * 128 + 4 * q;
#pragma unroll
            for (int ct = 0; ct < 8; ++ct) { u32x2 w; w.x = pk2(acc[ct][0], acc[ct][1]); w.y = pk2(acc[ct][2], acc[ct][3]); *(u32x2*)(o + 16 * ct) = w; }
        }
    }
}
__device__ __forceinline__ void ret_scan(const Params& p) {
    bf16* KV = (bf16*)(p.ws + WS_RETKV);
    for (int idx = blockIdx.x * NTHR + threadIdx.x; idx < 2 * 4 * 2 * 16384; idx += gridDim.x * NTHR) {
        const int e = idx & 16383, d = (idx >> 14) & 1, h = (idx >> 15) & 3, b = idx >> 17;
        const float dec = expf(128.0f * ret_loggamma(p, d, h));
        bf16* base = KV + (size_t)(((b * 4 + h) * 2 + d) * NCH_RET) * 16384 + e;
        float st = 0.f;
        for (int s = 0; s < NCH_RET; ++s) {
            const int cc = d == 0 ? s : (s < 2 ? 1 - s : NCH_RET + 1 - s);
            bf16* ptr = base + (size_t)cc * 16384; const float t = bf1(*ptr); *ptr = (bf16)f2bf(st); st = dec * st + t;
        }
    }
}
__device__ __forceinline__ void ret_out(const Params& p, LAS unsigned char* lds, int wave, int lane, int first, int nblk) {
    bf16* pret = (bf16*)(p.ws + WS_PRET); const bf16* KV = (const bf16*)(p.ws + WS_RETKV);
    LAS bf16* VT = (LAS bf16*)lds;
    const int tid = threadIdx.x, i16 = lane & 15, q = lane >> 4;
    for (int it = (int)blockIdx.x - first; it < 2 * 4 * 64; it += nblk) {
        const int c = it & 63, h = (it >> 6) & 3, b = it >> 8;
        const int R0 = b * SEQ + c * 128;
        const float l0 = ret_loggamma(p, 0, h) * 1.4426950408889634f, l1 = ret_loggamma(p, 1, h) * 1.4426950408889634f;
        __syncthreads();
#pragma unroll
        for (int i = 0; i < 4; ++i) { const int idx = tid + NTHR * i, tok = idx & 127, c8 = idx >> 7;
            const u32x4 vv = *(const u32x4*)(pret + (size_t)(R0 + tok) * PLD + 1024 + h * 128 + 8 * c8);
            const unsigned vw[4] = {vv.x, vv.y, vv.z, vv.w};
#pragma unroll
            for (int e = 0; e < 8; ++e) VT[(8 * c8 + e) * 136 + tok] = (bf16)((e & 1) ? (vw[e >> 1] >> 16) : (vw[e >> 1] & 0xffffu)); }
        __syncthreads();
        const int tk = 16 * wave + i16;
        bf16* qrow = pret + (size_t)(R0 + tk) * PLD + h * 128;
        bf16x8 aq[4];
#pragma unroll
        for (int ks = 0; ks < 4; ++ks) aq[ks] = ld8(qrow + 32 * ks + 8 * q);
        bf16x8 pf[4];
        {
            f32x4 sacc[8];
#pragma unroll
            for (int ct = 0; ct < 8; ++ct) { sacc[ct] = (f32x4){0.f, 0.f, 0.f, 0.f};
                const bf16* krow = pret + (size_t)(R0 + 16 * ct + i16) * PLD + 512 + h * 128 + 8 * q;
#pragma unroll
                for (int ks = 0; ks < 4; ++ks) sacc[ct] = __builtin_amdgcn_mfma_f32_16x16x32_bf16(ld8(krow + 32 * ks), aq[ks], sacc[ct], 0, 0, 0); }
#pragma unroll
            for (int ct = 0; ct < 8; ++ct)
#pragma unroll
                for (int r = 0; r < 4; ++r) { const int s = 16 * ct + 4 * q + r; const int df = tk - s; sacc[ct][r] *= df >= 0 ? exp2f(l0 * (float)df) : exp2f(l1 * (float)(-df)); }
#pragma unroll
            for (int ks = 0; ks < 4; ++ks) { u32x4 w; w.x = pk2(sacc[2 * ks][0], sacc[2 * ks][1]); w.y = pk2(sacc[2 * ks][2], sacc[2 * ks][3]); w.z = pk2(sacc[2 * ks + 1][0], sacc[2 * ks + 1][1]); w.w = pk2(sacc[2 * ks + 1][2], sacc[2 * ks + 1][3]);
                pf[ks] = __builtin_bit_cast(bf16x8, w); }
        }
        const bf16* F = KV + (size_t)(((b * 4 + h) * 2 + 0) * NCH_RET + c + 2) * 16384; const bf16* G = KV + (size_t)(((b * 4 + h) * 2 + 1) * NCH_RET + c + 2) * 16384;
        const float s0 = exp2f(l0 * (float)(tk + 1)), s1 = exp2f(l1 * (float)(128 - tk));
        f32x4 y[8]; float sum = 0.f;
#pragma unroll
        for (int vt = 0; vt < 8; ++vt) {
            f32x4 ay = {0.f, 0.f, 0.f, 0.f}, a0 = ay, a1 = ay;
#pragma unroll
            for (int ks = 0; ks < 4; ++ks) {
                const LAS bf16* vp = VT + (16 * vt + i16) * 136 + 32 * ks + 4 * q;
                const u32x2 lo = *(const LAS u32x2*)vp, hi = *(const LAS u32x2*)(vp + 16);
                u32x4 w; w.x = lo.x; w.y = lo.y; w.z = hi.x; w.w = hi.y;
                ay = __builtin_amdgcn_mfma_f32_16x16x32_bf16(__builtin_bit_cast(bf16x8, w), pf[ks], ay, 0, 0, 0);
                a0 = __builtin_amdgcn_mfma_f32_16x16x32_bf16(ld8(F + (size_t)(16 * vt + i16) * 128 + 32 * ks + 8 * q), aq[ks], a0, 0, 0, 0);
                a1 = __builtin_amdgcn_mfma_f32_16x16x32_bf16(ld8(G + (size_t)(16 * vt + i16) * 128 + 32 * ks + 8 * q), aq[ks], a1, 0, 0, 0);
            }
            y[vt] = ay + a0 * s0 + a1 * s1; sum += (y[vt][0] + y[vt][1]) + (y[vt][2] + y[vt][3]);
        }
        sum += __shfl_xor(sum, 16); sum += __shfl_xor(sum, 32);
        const float mu = sum * (1.0f / 128.0f); float sq = 0.f;
#pragma unroll
        for (int vt = 0; vt < 8; ++vt) { y[vt] = y[vt] - mu; sq += (y[vt][0] * y[vt][0] + y[vt][1] * y[vt][1]) + (y[vt][2] * y[vt][2] + y[vt][3] * y[vt][3]); }
        sq += __shfl_xor(sq, 16); sq += __shfl_xor(sq, 32);
        const float rstd = 1.0f / sqrtf(sq * (1.0f / 128.0f) + 1e-5f);
#pragma unroll
        for (int vt = 0; vt < 8; ++vt) {
            const u32x2 gw = *(const u32x2*)(qrow + 1536 + 16 * vt + 4 * q);
            const float g0 = bflo(gw.x), g1 = bfhi(gw.x), g2 = bflo(gw.y), g3 = bfhi(gw.y);
            u32x2 w; w.x = pk2(y[vt][0] * rstd * g0 * sigmoidf_(g0), y[vt][1] * rstd * g1 * sigmoidf_(g1)); w.y = pk2(y[vt][2] * rstd * g2 * sigmoidf_(g2), y[vt][3] * rstd * g3 * sigmoidf_(g3));
            *(u32x2*)(qrow + 16 * vt + 4 * q) = w;
        }
    }
}

__device__ __forceinline__ int rw_row(int z, int b, int pp) {
    if (pp < CTXL) return ML + b * CTXL + (z ? CTXL - 1 - pp : pp);
    const int t = pp - CTXL; return b * SEQ + (z ? SEQ - 1 - t : t);
}

constexpr int RW_NSEG = 33, RW_WLDS = 18432;
constexpr size_t WS_SEGQ = WS_GU2;
constexpr size_t WS_SEGP0 = MiB / 4, WS_SEGP1 = WS_Y1 + 16 * MiB;
static_assert(WS_SEGQ + (size_t)32 * 32 * 16384 <= WS_U && WS_SEGP0 + (size_t)16 * 31 * 16384 <= WS_GU1 && WS_SEGP1 + (size_t)16 * 31 * 16384 <= 256 * MiB, "rwkv segment state map");
__device__ __forceinline__ float* segp_ptr(unsigned char* ws, int scan, int j) { return (float*)(ws + ((scan < 16) ? WS_SEGP0 : WS_SEGP1)) + ((size_t)(scan & 15) * 31 + (j - 1)) * 4096; }
typedef __bf16 bf16x2_ __attribute__((ext_vector_type(2)));
__device__ __forceinline__ unsigned cvtpk(float lo, float hi) { const f32x2 v = {lo, hi}; return __builtin_bit_cast(unsigned, __builtin_convertvector(v, bf16x2_)); }
__device__ __forceinline__ bf16x8 pack8(f32x4 a, f32x4 b) { u32x4 w; w.x = cvtpk(a[0], a[1]); w.y = cvtpk(a[2], a[3]); w.z = cvtpk(b[0], b[1]); w.w = cvtpk(b[2], b[3]); return __builtin_bit_cast(bf16x8, w); }
__device__ __forceinline__ bf16x8 ldperm(const LAS unsigned char* img, int l15, int q, int ks) {
    const LAS unsigned char* a = img + l15 * 144 + 64 * ks + 8 * q; const u32x2 lo = *(const LAS u32x2*)a, hi = *(const LAS u32x2*)(a + 32);
    u32x4 w; w.x = lo.x; w.y = lo.y; w.z = hi.x; w.w = hi.y; return __builtin_bit_cast(bf16x8, w);
}
constexpr size_t WS_W2P = 128 * 1024, WS_A2P = 192 * 1024;
#define MFMA16(a, b, c) __builtin_amdgcn_mfma_f32_16x16x32_bf16((a), (b), (c), 0, 0, 0)

template <int MODE>
__device__ __forceinline__ void rw_segment(const Params& p, LAS unsigned char* wl, int lane0, int scan, int seg, bool ident) {
    const int Z = scan >> 4, dir = Z ? -1 : 1; const int b = (scan >> 3) & 1, h = scan & 7;
    unsigned char* ws = p.ws;
    const bf16* prw = (const bf16*)(ws + WS_PRW);
    const float* INVN = (const float*)(ws + WS_INVN); const float* HW = (const float*)(ws + WS_HW) + (size_t)Z * MT * 32; const float* HA = (const float*)(ws + WS_HA) + (size_t)Z * MT * 32;
    const float mu_r = p.in[14][h * 64 + lane0], mu_k = p.in[14][512 + h * 64 + lane0], mu_v = p.in[14][1024 + h * 64 + lane0], k_k = p.in[24][h * 64 + lane0], k_a = p.in[25][h * 64 + lane0];
    LAS unsigned char* const IMG_A = wl, * const IMG_R = wl + 2304, * const IMG_B = wl + 4608, * const IMG_K = wl + 6912;
    LAS unsigned char* const T1 = wl, * const DV = wl + 4096;
    LAS unsigned char* const UT = wl + 9216, * const VT = wl + 11264, * const LWB = wl + 13312, * const LAB = wl + 15360;
    LAS unsigned char* const AAB = wl + 13312, * const AAK = wl + 14336, * const A2 = wl + 15360;
    f32x4 S[4][4];
    { const int l15 = lane0 & 15, q = lane0 >> 4;
    if (MODE == 2) { const float* sst = (const float*)(ws + WS_SEGQ) + ((size_t)scan * 32 + (seg - 1)) * 4096 + l15 * 64 + 4 * q;
#pragma unroll
        for (int vt = 0; vt < 4; ++vt)
#pragma unroll
            for (int ct = 0; ct < 4; ++ct) S[vt][ct] = *(const f32x4*)(sst + (16 * vt) * 64 + 16 * ct);
    } else {
#pragma unroll
        for (int vt = 0; vt < 4; ++vt)
#pragma unroll
            for (int ct = 0; ct < 4; ++ct)
#pragma unroll
                for (int r = 0; r < 4; ++r) S[vt][ct][r] = (ident && vt == ct && l15 == 4 * q + r) ? 1.0f : 0.0f;
    }
    }
    const int pp_start = seg * 256;
#pragma unroll 1
    for (int ci = 0; ci < 16; ++ci) {
        int lane_ = lane0; asm volatile("" : "+v"(lane_));
        const int lane = lane_, l15 = lane & 15, q = lane >> 4, hc = h * 64 + lane;
        const bf16x8* w2p = (const bf16x8*)(ws + WS_W2P) + (size_t)((Z * 8 + h) * 4) * 64 + lane; const bf16x8* a2p = (const bf16x8*)(ws + WS_A2P) + (size_t)((Z * 8 + h) * 4) * 64 + lane;
        const int R0 = rw_row(Z, b, pp_start + 16 * ci);
        {
            const int Rt = R0 + dir * l15;
            const float* hwp = HW + (size_t)Rt * 32 + 8 * q; const float* hap = HA + (size_t)Rt * 32 + 8 * q;
            const bf16x8 hwf = pack8(*(const f32x4*)hwp, *(const f32x4*)(hwp + 4)), haf = pack8(*(const f32x4*)hap, *(const f32x4*)(hap + 4));
#pragma unroll
            for (int ct = 0; ct < 4; ++ct) { const f32x4 z4 = {0.f, 0.f, 0.f, 0.f};
                const f32x4 d = MFMA16(hwf, w2p[64 * ct], z4), d2 = MFMA16(haf, a2p[64 * ct], z4);
                const float w0 = p.in[16][Z * 512 + h * 64 + 16 * ct + l15], a0 = p.in[19][Z * 512 + h * 64 + 16 * ct + l15];
                u32x2 w; w.x = cvtpk(-0.6065306597126334f * sigmoidf_(w0 + d[0]), -0.6065306597126334f * sigmoidf_(w0 + d[1]));
                w.y = cvtpk(-0.6065306597126334f * sigmoidf_(w0 + d[2]), -0.6065306597126334f * sigmoidf_(w0 + d[3]));
                *(LAS u32x2*)(LWB + (16 * ct + l15) * 32 + 8 * q) = w;
                w.x = cvtpk(sigmoidf_(a0 + d2[0]), sigmoidf_(a0 + d2[1])); w.y = cvtpk(sigmoidf_(a0 + d2[2]), sigmoidf_(a0 + d2[3]));
                *(LAS u32x2*)(LAB + (16 * ct + l15) * 32 + 8 * q) = w; }
        }
        const float invl = INVN[(size_t)(R0 + dir * l15) * 8 + h];
        const bool okp = Z ? has_next(R0) : has_prev(R0), okn = Z ? has_prev(R0 - 15) : has_next(R0 + 15);
        unsigned pkw[9], prw_[9], pvw[9];
#pragma unroll
        for (int m = 0; m < 9; ++m) { const bf16* r0 = prw + (size_t)(R0 + dir * (2 * m - 1)) * PLD + hc; const bf16* r1 = prw + (size_t)(R0 + dir * (2 * m)) * PLD + hc;
            const bool ok0 = m > 0 || okp, ok1 = m < 8 || okn;
            pkw[m] = (ok0 ? (unsigned)r0[512] : 0u) | ((ok1 ? (unsigned)r1[512] : 0u) << 16);
            if (MODE == 2) prw_[m] = (ok0 ? (unsigned)r0[0] : 0u) | ((ok1 ? (unsigned)r1[0] : 0u) << 16);
            pvw[m] = ident ? 0u : ((ok0 ? (unsigned)r0[1024] : 0u) | ((ok1 ? (unsigned)r1[1024] : 0u) << 16)); }
#define RWPOS(arr, j) (((j) & 1) ? bfhi(arr[(j) >> 1]) : bflo(arr[(j) >> 1]))
        asm volatile("" ::: "memory");
        unsigned lww[8], law[8];
        { const u32x4 a = *(const LAS u32x4*)(LWB + lane * 32), c = *(const LAS u32x4*)(LWB + lane * 32 + 16), d = *(const LAS u32x4*)(LAB + lane * 32), e = *(const LAS u32x4*)(LAB + lane * 32 + 16);
          lww[0] = a.x; lww[1] = a.y; lww[2] = a.z; lww[3] = a.w; lww[4] = c.x; lww[5] = c.y; lww[6] = c.z; lww[7] = c.w;
          law[0] = d.x; law[1] = d.y; law[2] = d.z; law[3] = d.w; law[4] = e.x; law[5] = e.y; law[6] = e.z; law[7] = e.w; }
        float cum = 0.f, Eprev = 1.f, Elast = 1.f;
        float ve = 0.f;
#pragma unroll
        for (int i = 0; i < 16; ++i) {
            const int idx = i + 1;
            const float lw = (i & 1) ? bfhi(lww[i >> 1]) : bflo(lww[i >> 1]); cum += lw;
            const float E = __expf(cum), Einv = __builtin_amdgcn_rcpf(E);
            const float asig = (i & 1) ? bfhi(law[i >> 1]) : bflo(law[i >> 1]);
            const float kc_ = RWPOS(pkw, idx); const float k = kc_ + mu_k * (0.5f * (RWPOS(pkw, idx - 1) + RWPOS(pkw, idx + 1)) - kc_);
            const float invn = __int_as_float(__builtin_amdgcn_readlane(__float_as_int(invl), i));
            const float kk = k * k_k * invn, keff = k * (1.0f + (asig - 1.0f) * k_a);
            const float at = -kk * Eprev, bh = kk * asig * Einv, kh = keff * Einv;
            const unsigned wab = cvtpk(at, bh);
            *(LAS unsigned short*)(IMG_A + i * 144 + lane * 2) = (unsigned short)(wab & 0xffffu); *(LAS unsigned short*)(IMG_B + i * 144 + lane * 2) = (unsigned short)(wab >> 16);
            float rt = 0.f;
            if (MODE == 2) { const float rc_ = RWPOS(prw_, idx); const float r = rc_ + mu_r * (0.5f * (RWPOS(prw_, idx - 1) + RWPOS(prw_, idx + 1)) - rc_); rt = r * (Z == 0 ? E : Eprev); }
            const unsigned wkr = cvtpk(kh, rt);
            *(LAS unsigned short*)(IMG_K + i * 144 + lane * 2) = (unsigned short)(wkr & 0xffffu); if (MODE == 2) *(LAS unsigned short*)(IMG_R + i * 144 + lane * 2) = (unsigned short)(wkr >> 16);
            float v = 0.f;
            { const float vc_ = RWPOS(pvw, idx); v = vc_ + mu_v * (0.5f * (RWPOS(pvw, idx - 1) + RWPOS(pvw, idx + 1)) - vc_);
                if (i & 1) *(LAS unsigned*)(VT + lane * 32 + 2 * (i - 1)) = cvtpk(ve, v); else ve = v; }
            Eprev = E; Elast = E;
        }
        asm volatile("" ::: "memory");
        bf16x8 fA[2], fB[2], fK[2], fR[2];
#pragma unroll
        for (int ks = 0; ks < 2; ++ks) { fA[ks] = ldperm(IMG_A, l15, q, ks); fB[ks] = ldperm(IMG_B, l15, q, ks); fK[ks] = ldperm(IMG_K, l15, q, ks); if (MODE == 2) fR[ks] = ldperm(IMG_R, l15, q, ks); }
        bf16x8 bkf[4];
        { const unsigned ta = (unsigned)(size_t)(q < 2 ? IMG_B : IMG_K) + (unsigned)((8 * (q & 1) + (l15 >> 2)) * 144 + 8 * (l15 & 3));
          u32x2 t0, t1, t2, t3, t4, t5, t6, t7;
          asm volatile("ds_read_b64_tr_b16 %0, %8\n\tds_read_b64_tr_b16 %1, %8 offset:576\n\tds_read_b64_tr_b16 %2, %8 offset:32\n\tds_read_b64_tr_b16 %3, %8 offset:608\n\t"
                       "ds_read_b64_tr_b16 %4, %8 offset:64\n\tds_read_b64_tr_b16 %5, %8 offset:640\n\tds_read_b64_tr_b16 %6, %8 offset:96\n\tds_read_b64_tr_b16 %7, %8 offset:672\n\ts_waitcnt lgkmcnt(0)"
                       : "=&v"(t0), "=&v"(t1), "=&v"(t2), "=&v"(t3), "=&v"(t4), "=&v"(t5), "=&v"(t6), "=&v"(t7) : "v"(ta) : "memory");
          bkf[0] = __builtin_bit_cast(bf16x8, (u32x4){t0.x, t0.y, t1.x, t1.y}); bkf[1] = __builtin_bit_cast(bf16x8, (u32x4){t2.x, t2.y, t3.x, t3.y});
          bkf[2] = __builtin_bit_cast(bf16x8, (u32x4){t4.x, t4.y, t5.x, t5.y}); bkf[3] = __builtin_bit_cast(bf16x8, (u32x4){t6.x, t6.y, t7.x, t7.y}); }
        asm volatile("" ::: "memory");
        {
            f32x4 gab = {0.f, 0.f, 0.f, 0.f}, gak = gab, grb = gab, grk = gab;
#pragma unroll
            for (int ks = 0; ks < 2; ++ks) { gab = MFMA16(fB[ks], fA[ks], gab); gak = MFMA16(fK[ks], fA[ks], gak); if (MODE == 2) { grb = MFMA16(fB[ks], fR[ks], grb); grk = MFMA16(fK[ks], fR[ks], grk); } }
#pragma unroll
            for (int r = 0; r < 4; ++r) { const int s = 4 * q + r; if (!(s < l15)) { gab[r] = 0.f; gak[r] = 0.f; } if (!(Z == 0 ? s <= l15 : s < l15)) { grb[r] = 0.f; grk[r] = 0.f; } }
            *(LAS f32x4*)(AAB + l15 * 64 + 16 * q) = gab; *(LAS f32x4*)(AAK + l15 * 64 + 16 * q) = gak;
            if (MODE == 2) { u32x2 w; w.x = cvtpk(grb[0], grb[1]); w.y = cvtpk(grb[2], grb[3]); *(LAS u32x2*)(A2 + l15 * 80 + 8 * q) = w;
                             w.x = cvtpk(grk[0], grk[1]); w.y = cvtpk(grk[2], grk[3]); *(LAS u32x2*)(A2 + l15 * 80 + 32 + 8 * q) = w; }
            *(LAS float*)(DV + lane * 4) = Elast;
        }
        f32x4 yp[4];
#pragma unroll
        for (int vt = 0; vt < 4; ++vt) { const bf16x8 sf0 = pack8(S[vt][0], S[vt][1]), sf1 = pack8(S[vt][2], S[vt][3]);
            f32x4 t1 = {0.f, 0.f, 0.f, 0.f}; t1 = MFMA16(fA[0], sf0, t1); t1 = MFMA16(fA[1], sf1, t1);
            *(LAS f32x4*)(T1 + (16 * vt + l15) * 64 + 16 * q) = t1;
            if (MODE == 2) { f32x4 y = {0.f, 0.f, 0.f, 0.f}; y = MFMA16(sf0, fR[0], y); y = MFMA16(sf1, fR[1], y); yp[vt] = y; } }
        asm volatile("" ::: "memory");
        float U[16]; unsigned vw_[8];
        { const u32x4 a = *(const LAS u32x4*)(VT + lane * 32), c = *(const LAS u32x4*)(VT + lane * 32 + 16); vw_[0] = a.x; vw_[1] = a.y; vw_[2] = a.z; vw_[3] = a.w; vw_[4] = c.x; vw_[5] = c.y; vw_[6] = c.z; vw_[7] = c.w; }
        { const f32x4 t0 = *(const LAS f32x4*)(T1 + lane * 64), t1 = *(const LAS f32x4*)(T1 + lane * 64 + 16), t2 = *(const LAS f32x4*)(T1 + lane * 64 + 32), t3 = *(const LAS f32x4*)(T1 + lane * 64 + 48);
#pragma unroll
          for (int r = 0; r < 4; ++r) { U[r] = t0[r]; U[4 + r] = t1[r]; U[8 + r] = t2[r]; U[12 + r] = t3[r]; } }
#pragma unroll
        for (int i = 1; i < 16; ++i) {
            float acc = U[i];
#pragma unroll
            for (int g = 0; g <= (i - 1) >> 2; ++g) { const f32x4 ab = *(const LAS f32x4*)(AAB + i * 64 + 16 * g);
#pragma unroll
                for (int r = 0; r < 4; ++r) if (4 * g + r < i) acc += ab[r] * U[4 * g + r];
                { const f32x4 ak = *(const LAS f32x4*)(AAK + i * 64 + 16 * g);
#pragma unroll
                    for (int r = 0; r < 4; ++r) if (4 * g + r < i) acc += ak[r] * ((r & 1) ? bfhi(vw_[(4 * g + r) >> 1]) : bflo(vw_[(4 * g + r) >> 1])); } }
            U[i] = acc;
        }
        { u32x4 w0_, w1_; w0_.x = cvtpk(U[0], U[1]); w0_.y = cvtpk(U[2], U[3]); w0_.z = cvtpk(U[4], U[5]); w0_.w = cvtpk(U[6], U[7]);
          w1_.x = cvtpk(U[8], U[9]); w1_.y = cvtpk(U[10], U[11]); w1_.z = cvtpk(U[12], U[13]); w1_.w = cvtpk(U[14], U[15]);
          *(LAS u32x4*)(UT + lane * 32) = w0_; *(LAS u32x4*)(UT + lane * 32 + 16) = w1_; }
        asm volatile("" ::: "memory");
        bf16x8 uvf[4];
#pragma unroll
        for (int t = 0; t < 4; ++t) uvf[t] = *(const LAS bf16x8*)((q < 2 ? UT : VT) + (16 * t + l15) * 32 + 16 * (q & 1));
        if (MODE == 2) {
            const bf16x8 a2f_ = *(const LAS bf16x8*)(A2 + l15 * 80 + 16 * q);
            const int Rt = R0 + dir * l15;
            bf16* yo = Z == 0 ? (bf16*)(ws + WS_PRW) + (size_t)Rt * PLD + RW_Y + h * 64 + 4 * q : (bf16*)(ws + WS_Y1) + (size_t)Rt * 512 + h * 64 + 4 * q;
#pragma unroll
            for (int vt = 0; vt < 4; ++vt) { const f32x4 y = MFMA16(uvf[vt], a2f_, yp[vt]);
                u32x2 w; w.x = cvtpk(y[0], y[1]); w.y = cvtpk(y[2], y[3]); *(u32x2*)(yo + 16 * vt) = w; }
        }
#pragma unroll
        for (int ct = 0; ct < 4; ++ct) { const f32x4 dv = *(const LAS f32x4*)(DV + (16 * ct + 4 * q) * 4);
#pragma unroll
            for (int vt = 0; vt < 4; ++vt) S[vt][ct] = MFMA16(bkf[ct], uvf[vt], S[vt][ct]) * dv; }
        asm volatile("s_waitcnt lgkmcnt(0)" ::: "memory");
    }
    const int l15 = lane0 & 15, q = lane0 >> 4;
    if (MODE == 0 && !ident) { float* o = (float*)(ws + WS_SEGQ) + ((size_t)scan * 32 + seg) * 4096 + l15 * 64 + 4 * q; asm volatile("" : "+v"(o));
#pragma unroll
        for (int vt = 0; vt < 4; ++vt)
#pragma unroll
            for (int ct = 0; ct < 4; ++ct) *(f32x4*)(o + (16 * vt) * 64 + 16 * ct) = S[vt][ct]; }
    if (MODE == 0 && ident) { float* o = segp_ptr(ws, scan, seg) + (4 * q) * 64 + l15;
        asm volatile("" : "+v"(o));
#pragma unroll
        for (int vt = 0; vt < 4; ++vt)
#pragma unroll
            for (int ct = 0; ct < 4; ++ct)
#pragma unroll
                for (int r = 0; r < 4; ++r) o[(16 * ct + r) * 64 + 16 * vt] = S[vt][ct][r]; }
}
__device__ __forceinline__ void rw_pass_a(const Params& p, LAS unsigned char* lds, int wave, int lane) {
    LAS unsigned char* wl = lds + wave * RW_WLDS;
#pragma unroll 1
    for (int it = blockIdx.x * NWAVES + wave; it < 1024 + 992; it += gridDim.x * NWAVES) {
        const bool ident = it >= 1024; const int t = it - 1024; const int scan = ident ? t / 31 : it >> 5, seg = ident ? 1 + t % 31 : it & 31;
        rw_segment<0>(p, wl, lane, scan, seg, ident);
    }
}
__device__ __forceinline__ void rw_pass_c(const Params& p, LAS unsigned char* lds, int wave, int lane) {
    LAS unsigned char* wl = lds + wave * RW_WLDS;
#pragma unroll 1
    for (int it = blockIdx.x * NWAVES + wave; it < 1024; it += gridDim.x * NWAVES) rw_segment<2>(p, wl, lane, it >> 5, 1 + (it & 31), false);
}
__device__ __forceinline__ void rw_pass_b(const Params& p, int wave, int lane) {
    const int l15 = lane & 15, q = lane >> 4;
    for (int it = blockIdx.x * NWAVES + wave; it < 128; it += gridDim.x * NWAVES) {
        const int scan = it >> 2, vt = it & 3;
        float* qb = (float*)(p.ws + WS_SEGQ) + (size_t)scan * 32 * 4096 + (16 * vt + l15) * 64 + 4 * q;
        f32x4 S[4];
#pragma unroll
        for (int ct = 0; ct < 4; ++ct) S[ct] = *(const f32x4*)(qb + 16 * ct);
#pragma unroll 1
        for (int m = 1; m < 32; ++m) {
            const float* pt = segp_ptr(p.ws, scan, m);
            bf16x8 shi[2], slo[2];
#pragma unroll
            for (int ks = 0; ks < 2; ++ks) { const f32x4 a = S[2 * ks], bq = S[2 * ks + 1]; shi[ks] = pack8(a, bq);
                const u32x4 hw = __builtin_bit_cast(u32x4, shi[ks]);
                const f32x4 ah = {bflo(hw.x), bfhi(hw.x), bflo(hw.y), bfhi(hw.y)}, bh = {bflo(hw.z), bfhi(hw.z), bflo(hw.w), bfhi(hw.w)};
                slo[ks] = pack8(a - ah, bq - bh); }
            f32x4 N[4];
#pragma unroll
            for (int ct = 0; ct < 4; ++ct) { f32x4 acc = *(const f32x4*)(qb + (size_t)m * 4096 + 16 * ct);
#pragma unroll
                for (int ks = 0; ks < 2; ++ks) { const float* pr_ = pt + (16 * ct + l15) * 64 + 32 * ks + 4 * q; const f32x4 a = *(const f32x4*)pr_, bq = *(const f32x4*)(pr_ + 16);
                    const bf16x8 phi = pack8(a, bq); const u32x4 hw = __builtin_bit_cast(u32x4, phi);
                    const f32x4 ah = {bflo(hw.x), bfhi(hw.x), bflo(hw.y), bfhi(hw.y)}, bh = {bflo(hw.z), bfhi(hw.z), bflo(hw.w), bfhi(hw.w)};
                    const bf16x8 plo = pack8(a - ah, bq - bh);
                    acc = MFMA16(phi, shi[ks], acc); acc = MFMA16(plo, shi[ks], acc); acc = MFMA16(phi, slo[ks], acc); }
                N[ct] = acc; }
#pragma unroll
            for (int ct = 0; ct < 4; ++ct) { S[ct] = N[ct]; *(f32x4*)(qb + (size_t)m * 4096 + 16 * ct) = N[ct]; }
        }
    }
}

__device__ __forceinline__ void p0_lora_frags(const Params& p) {
    for (int idx = blockIdx.x * NTHR + threadIdx.x; idx < 2 * 4096; idx += gridDim.x * NTHR) {
        const int which = idx >> 12, t = idx & 4095, lane = t & 63, ct = (t >> 6) & 3, h = (t >> 8) & 7, z = t >> 11, l15 = lane & 15, q = lane >> 4;
        const float* W = which ? p.in[21] : p.in[18]; float v[8];
#pragma unroll
        for (int e = 0; e < 8; ++e) v[e] = W[(size_t)(z * 32 + 8 * q + e) * 512 + h * 64 + 16 * ct + l15];
        u32x4 w; w.x = pk2(v[0], v[1]); w.y = pk2(v[2], v[3]); w.z = pk2(v[4], v[5]); w.w = pk2(v[6], v[7]);
        *(u32x4*)(p.ws + (which ? WS_A2P : WS_W2P) + (size_t)t * 16) = w;
    }
}

__device__ __forceinline__ void rwkv_readout(const Params& p, LAS unsigned char* lds, int wave, int lane) {
    LAS bf16* g2s = (LAS bf16*)lds; LAS bf16* a2s = g2s + 96 * 512;
    for (int i = threadIdx.x; i < 96 * 512; i += NTHR) g2s[i] = (bf16)f2bf(p.in[23][i]);
    for (int i = threadIdx.x; i < 32 * 512; i += NTHR) a2s[i] = (bf16)f2bf(p.in[21][i]);
    __syncthreads();
    bf16* prw = (bf16*)(p.ws + WS_PRW); const bf16* Y1 = (const bf16*)(p.ws + WS_Y1);
    const float* HA = (const float*)(p.ws + WS_HA); const float* HG = (const float*)(p.ws + WS_HG);
    const int gw = blockIdx.x * NWAVES + wave, NGW = gridDim.x * NWAVES;
    const int c0 = 8 * lane;
    float mur[8], muk[8], muv[8], kav[8], rkv[8], lnw[8], lnb[8], a0v[8];
#pragma unroll
    for (int e = 0; e < 8; ++e) { mur[e] = p.in[14][c0 + e]; muk[e] = p.in[14][512 + c0 + e]; muv[e] = p.in[14][1024 + c0 + e]; kav[e] = p.in[25][c0 + e]; rkv[e] = p.in[26][c0 + e];
        lnw[e] = p.in[27][c0 + e]; lnb[e] = p.in[28][c0 + e]; a0v[e] = p.in[19][c0 + e]; }
    for (int R = gw; R < ML; R += NGW) {
        bf16* row = prw + (size_t)R * PLD; const bool hp = has_prev(R), hn = has_next(R);
        float y[8], r[8], k[8], v[8];
        { const u32x4 a = *(const u32x4*)(row + RW_Y + c0), bb = *(const u32x4*)(Y1 + (size_t)R * 512 + c0); const unsigned aw[4] = {a.x, a.y, a.z, a.w}, bw[4] = {bb.x, bb.y, bb.z, bb.w};
#pragma unroll
          for (int e = 0; e < 4; ++e) { y[2 * e] = bflo(aw[e]) + bflo(bw[e]); y[2 * e + 1] = bfhi(aw[e]) + bfhi(bw[e]); } }
#pragma unroll
        for (int tns = 0; tns < 3; ++tns) {
            const u32x4 cc = *(const u32x4*)(row + 512 * tns + c0); u32x4 pp = {0u, 0u, 0u, 0u}, nn = {0u, 0u, 0u, 0u};
            if (hp) pp = *(const u32x4*)(row - PLD + 512 * tns + c0); if (hn) nn = *(const u32x4*)(row + PLD + 512 * tns + c0);
            const unsigned cw[4] = {cc.x, cc.y, cc.z, cc.w}, pw[4] = {pp.x, pp.y, pp.z, pp.w}, nw[4] = {nn.x, nn.y, nn.z, nn.w};
#pragma unroll
            for (int e = 0; e < 8; ++e) { const float cv = (e & 1) ? bfhi(cw[e >> 1]) : bflo(cw[e >> 1]), pv = (e & 1) ? bfhi(pw[e >> 1]) : bflo(pw[e >> 1]), nv = (e & 1) ? bfhi(nw[e >> 1]) : bflo(nw[e >> 1]);
                const float mu = tns == 0 ? mur[e] : (tns == 1 ? muk[e] : muv[e]); const float o = cv + mu * (0.5f * (pv + nv) - cv);
                if (tns == 0) r[e] = o; else if (tns == 1) k[e] = o; else v[e] = o; }
        }
        float s = 0.f;
#pragma unroll
        for (int e = 0; e < 8; ++e) s += y[e];
        const float mu = sum8(s) * (1.0f / 64.0f); float sq = 0.f;
#pragma unroll
        for (int e = 0; e < 8; ++e) { y[e] -= mu; sq += y[e] * y[e]; }
        const float rstd = 1.0f / sqrtf(sum8(sq) * (1.0f / 64.0f) + 64e-5f);
        float ap[8], g[8];
#pragma unroll
        for (int e = 0; e < 8; ++e) { ap[e] = a0v[e]; g[e] = 0.f; }
        const float hav = HA[(size_t)R * 32 + (lane & 31)];
#pragma unroll 4
        for (int j = 0; j < 32; ++j) { const float hv = __shfl(hav, j); const u32x4 w = *(const LAS u32x4*)(a2s + j * 512 + c0); const unsigned ww[4] = {w.x, w.y, w.z, w.w};
#pragma unroll
            for (int e = 0; e < 4; ++e) { ap[2 * e] += hv * bflo(ww[e]); ap[2 * e + 1] += hv * bfhi(ww[e]); } }
        const float hg0 = HG[(size_t)R * 96 + lane], hg1 = HG[(size_t)R * 96 + 64 + (lane & 31)];
#pragma unroll 4
        for (int j = 0; j < 96; ++j) { const float hv = j < 64 ? __shfl(hg0, j) : __shfl(hg1, j - 64); const u32x4 w = *(const LAS u32x4*)(g2s + j * 512 + c0); const unsigned ww[4] = {w.x, w.y, w.z, w.w};
#pragma unroll
            for (int e = 0; e < 4; ++e) { g[2 * e] += hv * bflo(ww[e]); g[2 * e + 1] += hv * bfhi(ww[e]); } }
        float bs = 0.f;
#pragma unroll
        for (int e = 0; e < 8; ++e) { const float asig = sigmoidf_(ap[e]); const float keff = k[e] * (1.0f + (asig - 1.0f) * kav[e]); bs += r[e] * keff * rkv[e]; }
        bs = sum8(bs);
        float o[8];
#pragma unroll
        for (int e = 0; e < 8; ++e) o[e] = (y[e] * rstd * lnw[e] + lnb[e] + bs * v[e]) * g[e];
        u32x4 w; w.x = pk2(o[0], o[1]); w.y = pk2(o[2], o[3]); w.z = pk2(o[4], o[5]); w.w = pk2(o[6], o[7]);
        *(u32x4*)(row + RW_Y + c0) = w;
    }
}

constexpr int LDS_BYTES = 147456;
constexpr int NPHASE = 17;
__global__ void __launch_bounds__(NTHR, 2) fwd_megakernel(Params p) {
    extern __shared__ __attribute__((aligned(16))) unsigned char lds_raw[];
    LAS unsigned char* lds = (LAS unsigned char*)lds_raw;
    cg::grid_group grid = cg::this_grid();
    const int tid = threadIdx.x, lane = tid & 63, wave = __builtin_amdgcn_readfirstlane(tid >> 6);
    unsigned char* ws = p.ws;
    const float* x = p.in[0]; const float* ctx = p.in[2];
    float* Hl = p.out; float* Hc = (float*)(ws + WS_HC);
    const float* modv = (const float*)(ws + WS_MODV);
    bf16* U = (bf16*)(ws + WS_U); bf16* ACT = (bf16*)(ws + WS_ACT); bf16* PRET = (bf16*)(ws + WS_PRET); bf16* PRW = (bf16*)(ws + WS_PRW);
    const int lo = p.ph_lo, hi = p.ph_hi, G = gridDim.x, bx = blockIdx.x;
#define IN(k) (lo <= (k) && (k) < hi)
#define SEAM(k) do { if (IN(k) && IN((k) + 1)) grid.sync(); } while (0)

    if (IN(0)) { p0_modv(p, lds); p0_lora_frags(p); p0_weights(p, lds, wave, lane, 0, 18); } SEAM(0);
    if (IN(1)) norm_rows(x, ctx, p.in[6], modv, 0 * DM, 1 * DM, U, MT, wave, lane); SEAM(1);
    if (IN(2)) { pg8::Gemm g{U, (const bf16*)(ws + WS_GU1), MT, 2 * DFF, DM, DM}; pg8::StaticOrder S; S.init(MT, 2 * DFF, G, bx); EpiSwiGLU E{ACT, DFF};
        pg8::gemm_phase<EpiSwiGLU, pg8::StaticOrder, true, true>(lds, g, S, E); } SEAM(2);
    if (IN(3)) { pg8::Gemm g{ACT, (const bf16*)(ws + WS_D1), MT, DM, DFF, DFF}; pg8::StaticOrder S; S.init(MT, DM, G, bx); EpiResid E{x, ctx, Hl, Hc, modv, 2 * DM, 0.5f};
        pg8::gemm_phase<EpiResid, pg8::StaticOrder, true, true>(lds, g, S, E); } SEAM(3);
    if (IN(4)) norm_rows(Hl, Hc, p.in[10], modv, 3 * DM, 4 * DM, U, MT, wave, lane); SEAM(4);
    if (IN(5)) { pg8::Gemm g{U, (const bf16*)(ws + WS_WIN), MT, 4096, DM, DM}; pg8::StaticOrder S; S.init(MT, 4096, G, bx); EpiB<0, true> E{PRET, PRW, nullptr, PLD};
        pg8::gemm_phase<EpiB<0, true>, pg8::StaticOrder, true, true>(lds, g, S, E); } SEAM(5);
    if (IN(6)) p6_token_prep(p, wave, lane); SEAM(6);
    if (IN(7)) { rw_pass_a(p, lds, wave, lane); __syncthreads(); ret_kv_local(p, lds, wave, lane); } SEAM(7);
    if (IN(8)) { rw_pass_b(p, wave, lane); ret_scan(p); } SEAM(8);
    if (IN(9)) { rw_pass_c(p, lds, wave, lane); __syncthreads(); ret_out(p, lds, wave, lane, 0, G); } SEAM(9);
    if (IN(10)) { rwkv_readout(p, lds, wave, lane); norm_rows(Hl, Hc, p.in[10], modv, 3 * DM, 4 * DM, U, ML, wave, lane); __syncthreads(); p0_weights(p, lds, wave, lane, 18, NTRJOB); } SEAM(10);
    if (IN(11)) {
        pg8::StaticOrder S; S.init(ML, DM, G, bx);
        { pg8::Gemm g{PRET, (const bf16*)(ws + WS_RO), ML, DM, 512, PLD}; EpiB<0, false> E{PRET + 1024, nullptr, nullptr, PLD}; pg8::gemm_phase<EpiB<0, false>, pg8::StaticOrder, false, true>(lds, g, S, E); }
        { pg8::Gemm g{U, (const bf16*)(ws + WS_WG), ML, DM, DM, DM}; EpiB<1, false> E{PRET + 1024, nullptr, nullptr, PLD}; pg8::gemm_phase<EpiB<1, false>, pg8::StaticOrder, false, true>(lds, g, S, E); }
        { pg8::Gemm g{PRW + RW_Y, (const bf16*)(ws + WS_RWO), ML, DM, 512, PLD}; EpiB<0, false> E{PRW, nullptr, nullptr, PLD}; pg8::gemm_phase<EpiB<0, false>, pg8::StaticOrder, false, true>(lds, g, S, E); }
        { pg8::Gemm g{U, (const bf16*)(ws + WS_WG) + (size_t)DM * DM, ML, DM, DM, DM}; EpiB<2, false> E{PRET + 1024, nullptr, PRW, PLD}; pg8::gemm_phase<EpiB<2, false>, pg8::StaticOrder, false, true>(lds, g, S, E); }
    } SEAM(11);
    if (IN(12)) { pg8::Gemm g{PRET + 1024, (const bf16*)(ws + WS_WOUT), ML, DM, DM, PLD}; pg8::StaticOrder S; S.init(ML, DM, G, bx); EpiResid E{Hl, Hc, Hl, Hc, modv, 5 * DM, 1.0f};
        pg8::gemm_phase<EpiResid, pg8::StaticOrder, false, true>(lds, g, S, E); } SEAM(12);
    if (IN(13)) norm_rows(Hl, Hc, p.in[31], modv, 6 * DM, 7 * DM, U, ML, wave, lane); SEAM(13);
    if (IN(14)) { pg8::Gemm g{U, (const bf16*)(ws + WS_GU2), ML, 2 * DFF, DM, DM}; pg8::StaticOrder S; S.init(ML, 2 * DFF, G, bx); EpiSwiGLU E{ACT, DFF};
        pg8::gemm_phase<EpiSwiGLU, pg8::StaticOrder, true, true>(lds, g, S, E); } SEAM(14);
    if (IN(15)) { pg8::Gemm g{ACT, (const bf16*)(ws + WS_D2), ML, DM, DFF, DFF}; pg8::StaticOrder S; S.init(ML, DM, G, bx); EpiResid E{Hl, Hc, Hl, Hc, modv, 8 * DM, 0.5f};
        pg8::gemm_phase<EpiResid, pg8::StaticOrder, false, true>(lds, g, S, E); } SEAM(15);
    if (IN(16)) {
        const int gw = bx * NWAVES + wave, NGW = G * NWAVES; const float* gf = p.in[35];
        for (int R = gw; R < ML; R += NGW) { float* xr = Hl + (size_t)R * DM + 4 * lane; f32x4 v[4]; float s = 0.f;
#pragma unroll
            for (int j = 0; j < 4; ++j) { v[j] = *(const f32x4*)(xr + 256 * j); s += (v[j].x * v[j].x + v[j].y * v[j].y) + (v[j].z * v[j].z + v[j].w * v[j].w); }
            const float rstd = 1.0f / sqrtf(wave_sum(s) * (1.0f / DM) + 1e-6f);
#pragma unroll
            for (int j = 0; j < 4; ++j) *(f32x4*)(xr + 256 * j) = (v[j] * rstd) * *(const f32x4*)(gf + 4 * lane + 256 * j); }
    }
#undef IN
#undef SEAM
}

extern "C" void kernel_launch(void* const* d_in, const int* in_sizes, int n_in, void* d_out, int out_size, void* d_ws, size_t ws_size, hipStream_t stream) {
    static int grid = 0;
    if (grid == 0) {
        if (n_in != 36 || out_size != ML * DM || ws_size < 256 * MiB) { fprintf(stderr, "kernel_launch: unexpected problem (n_in %d out %d ws %zu)\n", n_in, out_size, ws_size); grid = -1; return; }
        int dev = 0, cus = 0, per_cu = 0;
        (void)hipGetDevice(&dev); (void)hipDeviceGetAttribute(&cus, hipDeviceAttributeMultiprocessorCount, dev);
        if (hipFuncSetAttribute((const void*)fwd_megakernel, hipFuncAttributeMaxDynamicSharedMemorySize, LDS_BYTES) != hipSuccess) { fprintf(stderr, "kernel_launch: hipFuncSetAttribute failed\n"); grid = -1; return; }
        if (hipOccupancyMaxActiveBlocksPerMultiprocessor(&per_cu, (const void*)fwd_megakernel, NTHR, LDS_BYTES) != hipSuccess || per_cu < 1) { fprintf(stderr, "kernel_launch: occupancy query says %d\n", per_cu); per_cu = 1; }
        (void)hipGetLastError();
        grid = cus * (per_cu > 1 ? 1 : per_cu);
        fprintf(stderr, "kernel_launch: cus %d per_cu %d grid %d\n", cus, per_cu, grid);
    }
    if (grid < 0) return;
    Params p{};
    for (int i = 0; i < 36; ++i) p.in[i] = (const float*)d_in[i];
    p.out = (float*)d_out; p.ws = (unsigned char*)d_ws; p.ph_lo = 0; p.ph_hi = NPHASE;
    void* args[] = {&p};
    hipError_t e = hipLaunchCooperativeKernel((const void*)fwd_megakernel, dim3(grid), dim3(NTHR), args, LDS_BYTES, stream);
    if (e != hipSuccess) fprintf(stderr, "kernel_launch: cooperative launch failed: %s (grid %d)\n", hipGetErrorString(e), grid);
}
```

```cpp
#include <hip/hip_runtime.h>
#include <hip/hip_cooperative_groups.h>
#include <cstdio>
#include <cstdint>
namespace cg = cooperative_groups;


namespace pg8 {
#define PG8_LAS __attribute__((address_space(3)))
typedef unsigned short bf16_t;
typedef short bf16x8 __attribute__((ext_vector_type(8)));
typedef float f32x4 __attribute__((ext_vector_type(4)));
typedef unsigned u32x4 __attribute__((ext_vector_type(4)));
constexpr int BM = 256, BK = 64, HALF = 128, HTB = HALF * BK * 2  , STAGE_BYTES = 8 * HTB, NXCD = 8, WGM = 8;

__host__ __device__ __forceinline__ int lds_byte(int r, int c) { const int st = (r >> 4) * 2 + (c >> 5), rr = r & 15, cc = c & 31, ob = rr * 64 + cc * 2; return st * 1024 + (ob ^ (((ob >> 9) & 1) << 5)); }
__host__ __device__ __forceinline__ void stage_rc(int b, int& R, int& C) { const int st = b / 1024, sb = b % 1024, swz = sb ^ (((sb >> 9) & 1) << 5); R = (st >> 1) * 16 + swz / 64; C = (st & 1) * 32 + (swz % 64) / 2; }
__host__ __device__ __forceinline__ int perm32(int rho) { const int n = rho >> 4, i = rho & 15; return 8 * (i >> 2) + 4 * n + (i & 3); }

struct Unit { int pm, pn; };
struct Gemm { const bf16_t* A; const bf16_t* Bt; int M, N, K, lda; };

struct StaticOrder {
    int nM, nN, nwg, G, c;
    __host__ __device__ void init(int M, int N, int G_, int c_) { nM = M / BM; nN = N / BM; nwg = nM * nN; G = G_; c = c_; }
    __host__ __device__ bool next(int i, Unit& u) const {
        const long L = (long)i * G + c; if (L >= nwg) return false;
        int wgid = (int)L; { const int q = nwg / NXCD, r = nwg % NXCD, xcd = wgid % NXCD, off = wgid / NXCD; wgid = (xcd < r ? xcd * (q + 1) : r * (q + 1) + (xcd - r) * q) + off; }
        const int nig = WGM * nN, gid = wgid / nig, fm = gid * WGM, gsz = (nM - fm) < WGM ? (nM - fm) : WGM;
        u.pm = fm + ((wgid % nig) % gsz); u.pn = (wgid % nig) / gsz; return true;
    }
    __device__ __forceinline__ void a_ready(const Unit&) const {}
    __device__ __forceinline__ void done(const Unit&) const {}
};

__device__ __forceinline__ unsigned cvt_pk_bf16(float lo, float hi) { unsigned r; asm volatile("v_cvt_pk_bf16_f32 %0, %1, %2" : "=v"(r) : "v"(lo), "v"(hi)); return r; }
template <class Epi, class Sched, bool ALIGN_EPI = false, bool SP2 = false>
__device__ __forceinline__ void gemm_phase(PG8_LAS unsigned char* lds, const Gemm g, const Sched& S, const Epi& E) {
    const int tid = threadIdx.x, wid = __builtin_amdgcn_readfirstlane(tid >> 6), lane = tid & 63, wr = wid >> 2, wc = wid & 3, fr = lane & 15, fq = lane >> 4;
    const int K = g.K, nt = K / BK;
    unsigned voffA[2], voffB[2];
#pragma unroll
    for (int i = 0; i < 2; ++i) { int R, C; stage_rc(tid * 16 + i * 8192, R, C); const int Rb = Epi::PERM ? ((R & ~31) + perm32(R & 31)) : R;
        voffA[i] = (unsigned)(R * g.lda + C) * 2u; voffB[i] = (unsigned)(Rb * K + C) * 2u; }
    const size_t kstep = (size_t)(BK * 2);
    const size_t hstepA = (size_t)HALF * g.lda * 2, hstepB = (size_t)HALF * K * 2;
    const size_t tstepA = 2 * hstepA, tstepB = 2 * hstepB;
    const unsigned ldsw = (unsigned)wid * 1024u;
    const int aoff = lds_byte(wr * 64 + fr, fq * 8), boff = lds_byte(wc * 32 + fr, fq * 8);
#define PG8_SA(b, h) (((b) * 2 + (h)) * HTB)
#define PG8_SB(b, h) ((4 + (b) * 2 + (h)) * HTB)
#define PG8_STAGE(bufoff, gbase, voff) do { _Pragma("unroll") for (int _i = 0; _i < 2; ++_i) \
        __builtin_amdgcn_global_load_lds((const unsigned*)((const char*)(gbase) + (voff)[_i]), (PG8_LAS unsigned*)(lds + (bufoff) + ldsw + _i * 8192), 16, 0, 0); } while (0)
#define PG8_LDA(dst, b, h) do { _Pragma("unroll") for (int m = 0; m < 4; ++m) _Pragma("unroll") for (int k = 0; k < 2; ++k) dst[m][k] = *(const PG8_LAS bf16x8*)(lds + PG8_SA(b, h) + aoff + m * 2048 + k * 1024); } while (0)
#define PG8_LDB(dst, b, h) do { _Pragma("unroll") for (int n = 0; n < 2; ++n) _Pragma("unroll") for (int k = 0; k < 2; ++k) dst[n][k] = *(const PG8_LAS bf16x8*)(lds + PG8_SB(b, h) + boff + n * 2048 + k * 1024); } while (0)
#define PG8_MMA(ai, bj, At, Bt) do { __builtin_amdgcn_s_setprio(1); _Pragma("unroll") for (int m = 0; m < 4; ++m) _Pragma("unroll") for (int n = 0; n < 2; ++n) _Pragma("unroll") for (int k = 0; k < 2; ++k) \
        acc[ai][bj][m][n] = __builtin_amdgcn_mfma_f32_16x16x32_bf16(Bt[n][k], At[m][k], acc[ai][bj][m][n], 0, 0, 0); __builtin_amdgcn_s_setprio(0); } while (0)
#define PG8_WAIT_V(n) asm volatile("s_waitcnt vmcnt(" #n ")" ::: "memory")
#define PG8_WAIT_L(n) asm volatile("s_waitcnt lgkmcnt(" #n ")" ::: "memory")
#define PG8_BAR __builtin_amdgcn_s_barrier()
#define PG8_SCHED __builtin_amdgcn_sched_barrier(0)
    Unit cur, nxt; int ui = 0;
    if (!S.next(0, cur)) return;
    f32x4 acc[2][2][4][2];
#pragma unroll
    for (int a = 0; a < 2; ++a)
#pragma unroll
        for (int b = 0; b < 2; ++b)
#pragma unroll
            for (int m = 0; m < 4; ++m)
#pragma unroll
                for (int n = 0; n < 2; ++n) acc[a][b][m][n] = (f32x4){0.f, 0.f, 0.f, 0.f};
    bf16x8 At[4][2], B0[2][2], B1[2][2];
    const char* cA = (const char*)g.A + (size_t)cur.pm * tstepA; const char* cB = (const char*)g.Bt + (size_t)cur.pn * tstepB;
    S.a_ready(cur);
    if constexpr (SP2) {
        PG8_STAGE(PG8_SB(0, 0), cB, voffB); PG8_STAGE(PG8_SB(0, 1), cB + hstepB, voffB); PG8_STAGE(PG8_SA(0, 0), cA, voffA); PG8_STAGE(PG8_SA(0, 1), cA + hstepA, voffA);
        if (wr == 1) PG8_BAR;
        PG8_WAIT_V(2); PG8_BAR;
        PG8_STAGE(PG8_SB(1, 0), cB + kstep, voffB); PG8_STAGE(PG8_SA(1, 0), cA + kstep, voffA); PG8_STAGE(PG8_SB(1, 1), cB + hstepB + kstep, voffB);
        PG8_WAIT_V(6); PG8_BAR;
    } else {
        PG8_STAGE(PG8_SB(0, 0), cB, voffB); PG8_STAGE(PG8_SA(0, 0), cA, voffA); PG8_STAGE(PG8_SB(0, 1), cB + hstepB, voffB); PG8_STAGE(PG8_SA(0, 1), cA + hstepA, voffA);
        if (wr == 1) PG8_BAR;
        PG8_WAIT_V(4); PG8_BAR;
        PG8_STAGE(PG8_SB(1, 0), cB + kstep, voffB); PG8_STAGE(PG8_SA(1, 0), cA + kstep, voffA); PG8_STAGE(PG8_SB(1, 1), cB + hstepB + kstep, voffB);
        PG8_WAIT_V(6); PG8_BAR;
    }
    for (;;) {
        const bool has_next = S.next(ui + 1, nxt);
        const char* nA = has_next ? (const char*)g.A + (size_t)nxt.pm * tstepA : cA; const char* nB = has_next ? (const char*)g.Bt + (size_t)nxt.pn * tstepB : cB;
        for (int t = 0; t < nt; t += 2) {
            const bool last = (t == nt - 2);
            const char* a1 = cA + (size_t)(t + 1) * kstep;
            const char* a2 = last ? nA : cA + (size_t)(t + 2) * kstep; const char* b2 = last ? nB : cB + (size_t)(t + 2) * kstep;
            const char* a3 = a2 + kstep; const char* b3 = b2 + kstep;
            if (last && has_next) S.a_ready(nxt);
            if constexpr (SP2) {
            PG8_LDB(B0, 0, 0); PG8_LDB(B1, 0, 1); PG8_SCHED; PG8_LDA(At, 0, 0); PG8_STAGE(PG8_SA(1, 1), a1 + hstepA, voffA);
            PG8_WAIT_V(8); PG8_WAIT_L(0); PG8_BAR; PG8_MMA(0, 0, At, B0); PG8_MMA(0, 1, At, B1); PG8_BAR; PG8_SCHED;
            PG8_LDA(At, 0, 1); PG8_STAGE(PG8_SB(0, 0), b2, voffB); PG8_STAGE(PG8_SB(0, 1), b2 + hstepB, voffB); PG8_STAGE(PG8_SA(0, 0), a2, voffA);
            PG8_WAIT_V(8); PG8_WAIT_L(0); PG8_BAR; PG8_MMA(1, 0, At, B0); PG8_MMA(1, 1, At, B1); PG8_BAR; PG8_SCHED;
            PG8_LDB(B0, 1, 0); PG8_LDB(B1, 1, 1); PG8_SCHED; PG8_LDA(At, 1, 0); PG8_STAGE(PG8_SA(0, 1), a2 + hstepA, voffA);
            PG8_WAIT_V(8); PG8_WAIT_L(0); PG8_BAR; PG8_MMA(0, 0, At, B0); PG8_MMA(0, 1, At, B1); PG8_BAR; PG8_SCHED;
            PG8_LDA(At, 1, 1); PG8_STAGE(PG8_SB(1, 0), b3, voffB); PG8_STAGE(PG8_SB(1, 1), b3 + hstepB, voffB); PG8_STAGE(PG8_SA(1, 0), a3, voffA);
            PG8_WAIT_V(8); PG8_WAIT_L(0); PG8_BAR; PG8_MMA(1, 0, At, B0); PG8_MMA(1, 1, At, B1); PG8_BAR; PG8_SCHED;
            } else {
            PG8_LDB(B0, 0, 0); PG8_SCHED; PG8_LDA(At, 0, 0); PG8_STAGE(PG8_SA(1, 1), a1 + hstepA, voffA);
            PG8_WAIT_L(8); PG8_BAR; PG8_WAIT_L(0); PG8_MMA(0, 0, At, B0); PG8_BAR; PG8_SCHED;
            PG8_LDB(B1, 0, 1); PG8_STAGE(PG8_SB(0, 0), b2, voffB);
            PG8_BAR; PG8_WAIT_L(0); PG8_MMA(0, 1, At, B1); PG8_BAR;
            PG8_LDA(At, 0, 1); PG8_STAGE(PG8_SA(0, 0), a2, voffA);
            PG8_BAR; PG8_WAIT_L(0); PG8_MMA(1, 0, At, B0); PG8_BAR; PG8_SCHED;
            PG8_STAGE(PG8_SB(0, 1), b2 + hstepB, voffB);
            PG8_WAIT_V(6); PG8_BAR; PG8_MMA(1, 1, At, B1); PG8_BAR;
            PG8_LDB(B0, 1, 0); PG8_SCHED; PG8_LDA(At, 1, 0); PG8_STAGE(PG8_SA(0, 1), a2 + hstepA, voffA);
            PG8_WAIT_L(8); PG8_BAR; PG8_WAIT_L(0); PG8_MMA(0, 0, At, B0); PG8_BAR; PG8_SCHED;
            PG8_LDB(B1, 1, 1); PG8_STAGE(PG8_SB(1, 0), b3, voffB);
            PG8_BAR; PG8_WAIT_L(0); PG8_MMA(0, 1, At, B1); PG8_BAR;
            PG8_LDA(At, 1, 1); PG8_STAGE(PG8_SA(1, 0), a3, voffA);
            PG8_BAR; PG8_WAIT_L(0); PG8_MMA(1, 0, At, B0); PG8_BAR; PG8_SCHED;
            PG8_STAGE(PG8_SB(1, 1), b3 + hstepB, voffB);
            PG8_WAIT_V(6); PG8_BAR; PG8_MMA(1, 1, At, B1); PG8_BAR;
            }
        }
        if constexpr (ALIGN_EPI) { if (wr == 0) PG8_BAR; }
        if constexpr (!Epi::AFTER_DRAIN) { E(acc, cur, wr, wc, fr, fq); S.done(cur); }
        if (!has_next) break;
#pragma unroll
        for (int a = 0; a < 2; ++a)
#pragma unroll
            for (int b = 0; b < 2; ++b)
#pragma unroll
                for (int m = 0; m < 4; ++m)
#pragma unroll
                    for (int n = 0; n < 2; ++n) acc[a][b][m][n] = (f32x4){0.f, 0.f, 0.f, 0.f};
        cur = nxt; cA = nA; cB = nB; ++ui;
        if constexpr (ALIGN_EPI) { if (wr == 1) PG8_BAR; }
    }
    PG8_WAIT_V(0);
    if constexpr (!ALIGN_EPI) { if (wr == 0) PG8_BAR; }
    PG8_BAR;
    if constexpr (Epi::AFTER_DRAIN) { E.fused(acc, cur, wr, wc, fr, fq, lds, wid, lane); S.done(cur); }
#undef PG8_SA
#undef PG8_SB
#undef PG8_STAGE
#undef PG8_LDA
#undef PG8_LDB
#undef PG8_MMA
#undef PG8_WAIT_V
#undef PG8_WAIT_L
#undef PG8_BAR
#undef PG8_SCHED
}
}

#define LAS __attribute__((address_space(3)))
typedef unsigned short bf16;
typedef float f32x4 __attribute__((ext_vector_type(4)));
typedef float f32x2 __attribute__((ext_vector_type(2)));
typedef unsigned u32x4 __attribute__((ext_vector_type(4)));
typedef unsigned u32x2 __attribute__((ext_vector_type(2)));
typedef short bf16x8 __attribute__((ext_vector_type(8)));
typedef short s16x4 __attribute__((ext_vector_type(4)));

constexpr int NTHR = 512, NWAVES = 8;
constexpr int DM = 1024, BATCH = 2, SEQ = 8192, CTXL = 256;
constexpr int ML = BATCH * SEQ, MC = BATCH * CTXL, MT = ML + MC;
constexpr int DFF = 2816, NMODV = 9 * DM, INW = 5632;
constexpr int PLD = 2048;
constexpr int RW_LA = 1536, RW_LB = 1760, RW_Y = 1536;
constexpr int NCH_RET = 66;
constexpr size_t MiB = 1u << 20;
constexpr size_t WS_BAR = 112 * 1024;
constexpr size_t WS_MODV = 0;
constexpr size_t WS_GU1 = 12 * MiB, WS_D1 = 23 * MiB, WS_WIN = WS_D1 + 11 * MiB / 2, WS_WG = WS_WIN + 8 * MiB, WS_RO = WS_WG + 4 * MiB, WS_RWO = WS_RO + MiB,
                 WS_WOUT = WS_RWO + MiB, WS_GU2 = WS_WOUT + 2 * MiB, WS_D2 = WS_GU2 + 11 * MiB, WS_U = WS_D2 + 11 * MiB / 2;
static_assert(WS_U == 61 * MiB, "ws map");
constexpr size_t WS_HC = WS_U + 33 * MiB, WS_BIG = WS_HC + 2 * MiB;
constexpr size_t WS_ACT = WS_BIG, WS_PRET = WS_BIG, WS_PRW = WS_BIG + 66 * MiB, WS_Y1 = WS_BIG + 132 * MiB;
constexpr size_t WS_RETKV = WS_U;
constexpr size_t WS_INVN = WS_GU1, WS_HW = WS_INVN + 3 * MiB / 4, WS_HA = WS_HW + 17 * MiB / 4, WS_HG = WS_HA + 17 * MiB / 4;
static_assert(WS_HG + (size_t)MT * 96 * 4 <= WS_WIN, "small arrays");
static_assert(WS_Y1 + (size_t)ML * 512 * 2 <= 256 * MiB, "ws end");

struct Params { const float* in[36]; float* out; unsigned char* ws; int ph_lo, ph_hi; };

__device__ __forceinline__ unsigned f2bf(float f) { unsigned u = __float_as_uint(f); return (u + 0x7fffu + ((u >> 16) & 1u)) >> 16; }
__device__ __forceinline__ unsigned pk2(float lo, float hi) { return f2bf(lo) | (f2bf(hi) << 16); }
__device__ __forceinline__ float bflo(unsigned w) { return __uint_as_float(w << 16); }
__device__ __forceinline__ float bfhi(unsigned w) { return __uint_as_float(w & 0xffff0000u); }
__device__ __forceinline__ float bf1(bf16 h) { return __uint_as_float((unsigned)h << 16); }
__device__ __forceinline__ float sigmoidf_(float x) { return __builtin_amdgcn_rcpf(1.0f + __expf(-x)); }
__device__ __forceinline__ float wave_sum(float v) {
#pragma unroll
    for (int o = 1; o < 64; o <<= 1) v += __shfl_xor(v, o);
    return v;
}
template <int CTRL> __device__ __forceinline__ float dpp_add(float v) { return v + __int_as_float(__builtin_amdgcn_update_dpp(0, __float_as_int(v), CTRL, 0xF, 0xF, true)); }
__device__ __forceinline__ float sum4(float v) { v = dpp_add<0xB1>(v); v = dpp_add<0x4E>(v); return v; }
__device__ __forceinline__ float sum8(float v) { v = sum4(v); v = dpp_add<0x141>(v); return v; }
__device__ __forceinline__ float sum16(float v) { v = sum8(v); v = dpp_add<0x140>(v); return v; }
__device__ __forceinline__ int mod_set(int R) { return R < SEQ ? 0 : (R < ML ? 1 : 2); }
__device__ __forceinline__ bool has_prev(int R) { return R < ML ? (R & (SEQ - 1)) != 0 : ((R - ML) & (CTXL - 1)) != 0; }
__device__ __forceinline__ bool has_next(int R) { return R < ML ? (R & (SEQ - 1)) != SEQ - 1 : ((R - ML) & (CTXL - 1)) != CTXL - 1; }


#define GAS __attribute__((address_space(1)))
#define XB_TMO      128
#define XB_XCNT(j)  (256  + 64 * (j))
#define XB_XSUB(j)  (1280 + 64 * (j))
#define XB_XGEN(j)  (2304 + 64 * (j))
#define XB_TOP      3328
#define XB_TOPGEN   3392
#define XCD_BAR_WORDS 3456
#define XB_SPIN_CAP (1u << 18)

__device__ __forceinline__ unsigned xb_ld(unsigned* p)              { return __hip_atomic_load(p, __ATOMIC_RELAXED, __HIP_MEMORY_SCOPE_AGENT); }
__device__ __forceinline__ unsigned xb_add(unsigned* p, unsigned v) { return __hip_atomic_fetch_add(p, v, __ATOMIC_RELAXED, __HIP_MEMORY_SCOPE_AGENT); }
__device__ __forceinline__ unsigned xb_xcc_id() { return (unsigned)__builtin_amdgcn_s_getreg((3 << 11) | 20) & 0xFu; }
#define XB_SPIN(cond, bar) do { unsigned _sp = 0; while (cond) { __builtin_amdgcn_s_sleep(1); \
    if ((++_sp & 255u) == 0u) { if (xb_ld(&(bar)[XB_TMO])) break; if (_sp > XB_SPIN_CAP) { atomicAdd(&(bar)[XB_TMO], 1u); break; } } } } while (0)

struct XcdBarrier {
    unsigned* bar; unsigned x;
    volatile LAS unsigned* st;
};

__device__ __forceinline__ XcdBarrier xcd_barrier_post(unsigned* bar, volatile LAS unsigned* st) {
    XcdBarrier b; b.bar = bar; b.x = xb_xcc_id(); b.st = st;
    if (threadIdx.x == 0) (void)xb_add(&bar[XB_XCNT(b.x)], 1u);
    return b;
}
__device__ __forceinline__ void xcd_barrier_complete(unsigned* bar, unsigned x, unsigned& nloc, unsigned& nx) {
    const unsigned G = gridDim.x * gridDim.y * gridDim.z;
    unsigned sum, cnt, mine, sp = 0u;
    for (;;) {
        sum = 0u; cnt = 0u; mine = 0u;
#pragma unroll
        for (unsigned j = 0; j < 16; ++j) { const unsigned c = xb_ld(&bar[XB_XCNT(j)]); sum += c; cnt += (c > 0u) ? 1u : 0u; mine = (j == x) ? c : mine; }
        if (sum == G) break;
        __builtin_amdgcn_s_sleep(1);
        if ((++sp & 255u) == 0u) { if (xb_ld(&bar[XB_TMO])) break; if (sp > XB_SPIN_CAP) { atomicAdd(&bar[XB_TMO], 1u); break; } }
    }
    nloc = mine > 0u ? mine : 1u; nx = cnt > 0u ? cnt : 1u;
}

__device__ __forceinline__ void xcd_barrier(const XcdBarrier& b) {
    asm volatile("s_waitcnt vmcnt(0)" ::: "memory");
    __syncthreads();
    if (threadIdx.x == 0) {
        unsigned* bar = b.bar;
        __builtin_amdgcn_s_waitcnt(0);
        unsigned nloc = b.st[0], nx = b.st[1];
        if (nloc == 0u) { xcd_barrier_complete(bar, b.x, nloc, nx); b.st[0] = nloc; b.st[1] = nx; }
        const unsigned old = xb_add(&bar[XB_XSUB(b.x)], 1u);
        const unsigned gen = old / nloc;
        if (old + 1u == (gen + 1u) * nloc) {
            __builtin_amdgcn_fence(__ATOMIC_RELEASE, "agent");
            asm volatile("s_waitcnt vmcnt(0)" ::: "memory");
            const unsigned og = xb_add(&bar[XB_TOP], 1u);
            const unsigned tg = og / nx;
            if (og + 1u == (tg + 1u) * nx) xb_add(&bar[XB_TOPGEN], 1u);
            else XB_SPIN(xb_ld(&bar[XB_TOPGEN]) == tg, bar);
            __builtin_amdgcn_fence(__ATOMIC_ACQUIRE, "agent");
            xb_add(&bar[XB_XGEN(b.x)], 1u);
            asm volatile("s_waitcnt vmcnt(0)" ::: "memory");
        } else {
            XB_SPIN(xb_ld(&bar[XB_XGEN(b.x)]) == gen, bar);
            __builtin_amdgcn_fence(__ATOMIC_ACQUIRE, "agent");
            asm volatile("s_waitcnt vmcnt(0)" ::: "memory");
        }
    }
    __syncthreads();
}

using pg8::Unit;
struct EpiSwiGLU {
    static constexpr bool PERM = true, AFTER_DRAIN = false;
    bf16* O; int ldo;
    __device__ __forceinline__ void operator()(const f32x4 (&acc)[2][2][4][2], const Unit& u, int wr, int wc, int fr, int fq) const {
        const int row0 = u.pm * 256 + wr * 64 + fr, col0 = u.pn * 128 + wc * 32 + 8 * fq;
#pragma unroll
        for (int ai = 0; ai < 2; ++ai)
#pragma unroll
            for (int m = 0; m < 4; ++m) {
                bf16* rowp = O + (size_t)(row0 + ai * 128 + m * 16) * ldo + col0;
                float v[8];
#pragma unroll
                for (int n = 0; n < 2; ++n)
#pragma unroll
                    for (int i = 0; i < 4; ++i) { const float g = acc[ai][0][m][n][i], up = acc[ai][1][m][n][i]; v[4 * n + i] = g * sigmoidf_(g) * up; }
                u32x4 w; w.x = pg8::cvt_pk_bf16(v[0], v[1]); w.y = pg8::cvt_pk_bf16(v[2], v[3]); w.z = pg8::cvt_pk_bf16(v[4], v[5]); w.w = pg8::cvt_pk_bf16(v[6], v[7]);
                *(u32x4*)rowp = w;
            }
    }
};
struct EpiResid {
    static constexpr bool PERM = false, AFTER_DRAIN = false;
    const float* base_lat; const float* base_ctx; float* out_lat; float* out_ctx; const float* modv; int modoff; float sc;
    __device__ __forceinline__ void operator()(const f32x4 (&acc)[2][2][4][2], const Unit& u, int wr, int wc, int fr, int fq) const {
        const bool isc = u.pm >= 64; const int pml = isc ? u.pm - 64 : u.pm;
        const float* base = isc ? base_ctx : base_lat; float* out = isc ? out_ctx : out_lat;
        const float* gate = modv + (isc ? 2 : (u.pm >= 32 ? 1 : 0)) * NMODV + modoff;
        const int col0 = u.pn * 256 + wc * 32 + 4 * fq;
        f32x4 gv[2][2];
#pragma unroll
        for (int bj = 0; bj < 2; ++bj)
#pragma unroll
            for (int n = 0; n < 2; ++n) gv[bj][n] = *(const f32x4*)(gate + col0 + bj * 128 + n * 16) * sc;
#pragma unroll
        for (int ai = 0; ai < 2; ++ai)
#pragma unroll
            for (int m = 0; m < 4; ++m) {
                const size_t off = (size_t)(pml * 256 + ai * 128 + wr * 64 + m * 16 + fr) * DM + col0;
#pragma unroll
                for (int bj = 0; bj < 2; ++bj)
#pragma unroll
                    for (int n = 0; n < 2; ++n) { const f32x4 b = *(const f32x4*)(base + off + bj * 128 + n * 16); *(f32x4*)(out + off + bj * 128 + n * 16) = b + gv[bj][n] * acc[ai][bj][m][n]; }
                asm volatile("" ::: "memory");
            }
    }
};
template <int MODE, bool SPLIT> struct EpiB {
    static constexpr bool PERM = true, AFTER_DRAIN = false;
    bf16* O; bf16* O2; const bf16* X; int ld;
    __device__ __forceinline__ void operator()(const f32x4 (&acc)[2][2][4][2], const Unit& u, int wr, int wc, int fr, int fq) const {
        int pn = u.pn; bf16* Ob = O; if (SPLIT && pn >= 8) { pn -= 8; Ob = O2; }
        const int row0 = u.pm * 256 + wr * 64 + fr, col0 = pn * 256 + wc * 32 + 8 * fq;
#pragma unroll
        for (int ai = 0; ai < 2; ++ai)
#pragma unroll
            for (int m = 0; m < 4; ++m) {
                const size_t off = (size_t)(row0 + ai * 128 + m * 16) * ld + col0;
#pragma unroll
                for (int bj = 0; bj < 2; ++bj) {
                    float v[8];
#pragma unroll
                    for (int n = 0; n < 2; ++n)
#pragma unroll
                        for (int i = 0; i < 4; ++i) v[4 * n + i] = acc[ai][bj][m][n][i];
                    if (MODE == 1) { const u32x4 o = *(const u32x4*)(Ob + off + bj * 128);
                        const unsigned ow[4] = {o.x, o.y, o.z, o.w};
#pragma unroll
                        for (int i = 0; i < 4; ++i) { v[2 * i] = sigmoidf_(v[2 * i]) * bflo(ow[i]); v[2 * i + 1] = sigmoidf_(v[2 * i + 1]) * bfhi(ow[i]); } }
                    if (MODE == 2) { const u32x4 o = *(const u32x4*)(Ob + off + bj * 128); const u32x4 x = *(const u32x4*)(X + off + bj * 128);
                        const unsigned ow[4] = {o.x, o.y, o.z, o.w}, xw[4] = {x.x, x.y, x.z, x.w};
#pragma unroll
                        for (int i = 0; i < 4; ++i) { v[2 * i] = bflo(ow[i]) + sigmoidf_(v[2 * i]) * bflo(xw[i]); v[2 * i + 1] = bfhi(ow[i]) + sigmoidf_(v[2 * i + 1]) * bfhi(xw[i]); } }
                    u32x4 w; w.x = pg8::cvt_pk_bf16(v[0], v[1]); w.y = pg8::cvt_pk_bf16(v[2], v[3]); w.z = pg8::cvt_pk_bf16(v[4], v[5]); w.w = pg8::cvt_pk_bf16(v[6], v[7]);
                    *(u32x4*)(Ob + off + bj * 128) = w;
                }
                asm volatile("" ::: "memory");
            }
    }
};

__device__ __forceinline__ void tr_item(const float* W, int ldw, int K, int c0, int kb, bf16* WT, int drow, const float* mu, float sa, float sb, LAS float* scr, int lane) {
    const int k0 = 64 * kb;
#pragma unroll 8
    for (int i = 0; i < 32; ++i) { const int kk = 2 * i + (lane >> 5); float v = W[(size_t)(k0 + kk) * ldw + c0 + (lane & 31)]; if (mu) v *= sa + sb * mu[k0 + kk]; scr[kk * 33 + (lane & 31)] = v; }
    asm volatile("s_waitcnt lgkmcnt(0)" ::: "memory");
    const int c = lane & 7;
#pragma unroll
    for (int j = 0; j < 4; ++j) { const int n = (lane >> 3) + 8 * j; const LAS float* s = scr + (8 * c) * 33 + n;
        u32x4 o; o.x = pk2(s[0 * 33], s[1 * 33]); o.y = pk2(s[2 * 33], s[3 * 33]); o.z = pk2(s[4 * 33], s[5 * 33]); o.w = pk2(s[6 * 33], s[7 * 33]);
        *(u32x4*)(WT + (size_t)(drow + n) * K + k0 + 8 * c) = o; }
    asm volatile("s_waitcnt lgkmcnt(0)" ::: "memory");
}
struct TrJob { const float* W; int ldw, K, c0, nc; bf16* WT; int mode, r0; const float* mu; float sa, sb; };
constexpr int NTRJOB = 21;
__device__ __forceinline__ TrJob tr_job(int j, const Params& p) {
    unsigned char* ws = p.ws; TrJob J; J.mu = nullptr; J.sa = 1.f; J.sb = 0.f; J.mode = 0; J.r0 = 0; J.c0 = 0;
    const float* mux = p.in[15];
    switch (j) {
    case 0: J.W = p.in[7]; J.ldw = DFF; J.K = DM; J.nc = DFF; J.WT = (bf16*)(ws + WS_GU1); J.mode = 1; break;
    case 1: J.W = p.in[8]; J.ldw = DFF; J.K = DM; J.nc = DFF; J.WT = (bf16*)(ws + WS_GU1); J.mode = 2; break;
    case 2: J.W = p.in[9]; J.ldw = DM; J.K = DFF; J.nc = DM; J.WT = (bf16*)(ws + WS_D1); break;
    case 3: J.W = p.in[11]; J.ldw = INW; J.K = DM; J.nc = 3584; J.WT = (bf16*)(ws + WS_WIN); break;
    case 4: J.W = p.in[11]; J.ldw = INW; J.K = DM; J.c0 = 3584; J.nc = 2048; J.WT = (bf16*)(ws + WS_WG); break;
    case 5: J.W = p.in[17]; J.ldw = 32; J.K = DM; J.nc = 32; J.WT = (bf16*)(ws + WS_WIN); J.r0 = 3584; J.mu = mux; J.sa = 1.f; J.sb = -1.f; break;
    case 6: J.W = p.in[17] + DM * 32; J.ldw = 32; J.K = DM; J.nc = 32; J.WT = (bf16*)(ws + WS_WIN); J.r0 = 3616; J.mu = mux; J.sa = 1.f; J.sb = -1.f; break;
    case 7: J.W = p.in[20]; J.ldw = 32; J.K = DM; J.nc = 32; J.WT = (bf16*)(ws + WS_WIN); J.r0 = 3648; J.mu = mux + DM; J.sa = 1.f; J.sb = -1.f; break;
    case 8: J.W = p.in[20] + DM * 32; J.ldw = 32; J.K = DM; J.nc = 32; J.WT = (bf16*)(ws + WS_WIN); J.r0 = 3680; J.mu = mux + DM; J.sa = 1.f; J.sb = -1.f; break;
    case 9: J.W = p.in[22]; J.ldw = 96; J.K = DM; J.nc = 96; J.WT = (bf16*)(ws + WS_WIN); J.r0 = 3712; J.mu = mux + 2 * DM; J.sa = 1.f; J.sb = -1.f; break;
    case 10: J.W = p.in[17]; J.ldw = 32; J.K = DM; J.nc = 32; J.WT = (bf16*)(ws + WS_WIN); J.r0 = 3808; J.mu = mux; J.sa = 0.f; J.sb = 1.f; break;
    case 11: J.W = p.in[17] + DM * 32; J.ldw = 32; J.K = DM; J.nc = 32; J.WT = (bf16*)(ws + WS_WIN); J.r0 = 3840; J.mu = mux; J.sa = 0.f; J.sb = 1.f; break;
    case 12: J.W = p.in[20]; J.ldw = 32; J.K = DM; J.nc = 32; J.WT = (bf16*)(ws + WS_WIN); J.r0 = 3872; J.mu = mux + DM; J.sa = 0.f; J.sb = 1.f; break;
    case 13: J.W = p.in[20] + DM * 32; J.ldw = 32; J.K = DM; J.nc = 32; J.WT = (bf16*)(ws + WS_WIN); J.r0 = 3904; J.mu = mux + DM; J.sa = 0.f; J.sb = 1.f; break;
    case 14: J.W = p.in[22]; J.ldw = 96; J.K = DM; J.nc = 96; J.WT = (bf16*)(ws + WS_WIN); J.r0 = 3936; J.mu = mux + 2 * DM; J.sa = 0.f; J.sb = 1.f; break;
    case 15: J.W = p.in[13]; J.ldw = DM; J.K = 512; J.nc = DM; J.WT = (bf16*)(ws + WS_RO); break;
    case 16: J.W = p.in[29]; J.ldw = DM; J.K = 512; J.nc = DM; J.WT = (bf16*)(ws + WS_RWO); break;
    case 17: J.W = p.in[30]; J.ldw = DM; J.K = DM; J.nc = DM; J.WT = (bf16*)(ws + WS_WOUT); break;
    case 18: J.W = p.in[32]; J.ldw = DFF; J.K = DM; J.nc = DFF; J.WT = (bf16*)(ws + WS_GU2); J.mode = 1; break;
    case 19: J.W = p.in[33]; J.ldw = DFF; J.K = DM; J.nc = DFF; J.WT = (bf16*)(ws + WS_GU2); J.mode = 2; break;
    default: J.W = p.in[34]; J.ldw = DM; J.K = DFF; J.nc = DM; J.WT = (bf16*)(ws + WS_D2); break;
    }
    return J;
}
__device__ __forceinline__ void p0_weights(const Params& p, LAS unsigned char* lds, int wave, int lane, int j0, int j1) {
    LAS float* scr = (LAS float*)(lds + wave * 16384);
    const int gw = blockIdx.x * NWAVES + wave, NGW = gridDim.x * NWAVES;
    int base = 0;
    for (int j = j0; j < j1; ++j) {
        const TrJob J = tr_job(j, p);
        const int nnb = J.nc / 32, nit = (J.K / 64) * nnb;
        int it = gw - (base % NGW); if (it < 0) it += NGW;
        for (; it < nit; it += NGW) {
            const int kb = it / nnb, nb = it % nnb, n0 = 32 * nb;
            const int drow = J.mode == 0 ? J.r0 + n0 : ((n0 >> 7) * 256 + (n0 & 127) + (J.mode == 2 ? 128 : 0));
            tr_item(J.W, J.ldw, J.K, J.c0 + n0, kb, J.WT, drow, J.mu, J.sa, J.sb, scr, lane);
        }
        base += nit;
    }
    if (j0 == 0) { u32x4* z = (u32x4*)((bf16*)(p.ws + WS_WIN) + (size_t)4032 * DM); const int n16 = 64 * DM * 2 / 16;
      for (int i = blockIdx.x * NTHR + threadIdx.x; i < n16; i += gridDim.x * NTHR) z[i] = (u32x4){0u, 0u, 0u, 0u}; }
}
__device__ __forceinline__ void p0_modv(const Params& p, LAS unsigned char* lds) {
    const float* c = p.in[1]; const float* cc = p.in[3]; const float* wm = p.in[4]; const float* bm = p.in[5];
    float* modv = (float*)(p.ws + WS_MODV);
    LAS float* red = (LAS float*)lds;
    const int tid = threadIdx.x, cl = tid & 15, kg = tid >> 4;
    for (int it = blockIdx.x; it < NMODV / 64; it += gridDim.x) {
        const int n0 = it * 64 + 4 * cl;
        f32x4 a0 = {0.f, 0.f, 0.f, 0.f}, a1 = a0, a2 = a0;
#pragma unroll 4
        for (int i = 0; i < 32; ++i) { const int k = kg * 32 + i; const f32x4 w = *(const f32x4*)(wm + (size_t)k * NMODV + n0);
            const float x0 = c[k], x1 = c[DM + k], x2 = cc[k];
            a0 += w * (x0 * sigmoidf_(x0)); a1 += w * (x1 * sigmoidf_(x1)); a2 += w * (x2 * sigmoidf_(x2)); }
        *(LAS f32x4*)(red + (kg * 3 + 0) * 64 + 4 * cl) = a0; *(LAS f32x4*)(red + (kg * 3 + 1) * 64 + 4 * cl) = a1; *(LAS f32x4*)(red + (kg * 3 + 2) * 64 + 4 * cl) = a2;
        __syncthreads();
        if (tid < 192) { const int s = tid >> 6, col = tid & 63; float v = bm[it * 64 + col];
            for (int g = 0; g < 32; ++g) v += red[(g * 3 + s) * 64 + col];
            modv[s * NMODV + it * 64 + col] = v; }
        __syncthreads();
    }
}
__device__ __forceinline__ void norm_rows(const float* hl, const float* hc, const float* g, const float* modv, int shift_off, int scale_off, bf16* U, int nrows, int wave, int lane) {
    const int gw = blockIdx.x * NWAVES + wave, NGW = gridDim.x * NWAVES;
    for (int R = gw; R < nrows; R += NGW) {
        const float* xr = (R < ML ? hl + (size_t)R * DM : hc + (size_t)(R - ML) * DM) + 4 * lane;
        f32x4 v[4]; float s = 0.f;
#pragma unroll
        for (int j = 0; j < 4; ++j) { v[j] = *(const f32x4*)(xr + 256 * j); s += (v[j].x * v[j].x + v[j].y * v[j].y) + (v[j].z * v[j].z + v[j].w * v[j].w); }
        const float rstd = 1.0f / sqrtf(wave_sum(s) * (1.0f / DM) + 1e-6f);
        const float* mv = modv + mod_set(R) * NMODV;
        u32x2* o = (u32x2*)(U + (size_t)R * DM + 4 * lane);
#pragma unroll
        for (int j = 0; j < 4; ++j) { const int col = 4 * lane + 256 * j; const f32x4 gg = *(const f32x4*)(g + col), sh = *(const f32x4*)(mv + shift_off + col), sc = *(const f32x4*)(mv + scale_off + col);
            const f32x4 y = (v[j] * rstd) * gg * (sc + 1.0f) + sh; u32x2 w; w.x = pk2(y.x, y.y); w.y = pk2(y.z, y.w); o[64 * j] = w; }
    }
}

__device__ __forceinline__ void p6_token_prep(const Params& p, int wave, int lane) {
    bf16* pret = (bf16*)(p.ws + WS_PRET); const bf16* prw = (const bf16*)(p.ws + WS_PRW);
    float* INVN = (float*)(p.ws + WS_INVN); float* HW = (float*)(p.ws + WS_HW); float* HA = (float*)(p.ws + WS_HA); float* HG = (float*)(p.ws + WS_HG);
    const float* mu_k = p.in[14] + 512; const float* k_k = p.in[24];
    const int gw = blockIdx.x * NWAVES + wave, NGW = gridDim.x * NWAVES;
    for (int R = gw; R < MT; R += NGW) {
        {
            const int P0 = 8 * lane, T = P0 >> 8, hd = (P0 >> 6) & 3, s = (P0 >> 5) & 1, i0 = P0 & 31;
            bf16* z1p = pret + (size_t)R * PLD + T * 512 + hd * 128 + s * 64 + i0;
            const u32x4 a = *(const u32x4*)z1p, b = *(const u32x4*)(z1p + 32);
            const unsigned aw[4] = {a.x, a.y, a.z, a.w}, bw[4] = {b.x, b.y, b.z, b.w};
            float z1[8], z2[8], o1[8], o2[8];
#pragma unroll
            for (int e = 0; e < 4; ++e) { z1[2 * e] = bflo(aw[e]); z1[2 * e + 1] = bfhi(aw[e]); z2[2 * e] = bflo(bw[e]); z2[2 * e + 1] = bfhi(bw[e]); }
            const bool lat = R < ML; const int t = R & (SEQ - 1); const float pos = (float)(s == 0 ? (t >> 6) : (t & 63));
            const float ksc = T == 1 ? 0.08838834764831845f : 1.0f;
#pragma unroll
            for (int e = 0; e < 8; ++e) {
                float cs = 1.f, sn = 0.f;
                if (lat) { const float inv = exp2f(-(float)(i0 + e) * 0.4152410118609203f); const float rev = pos * inv * 0.15915494309189535f; sn = __builtin_amdgcn_sinf(rev); cs = __builtin_amdgcn_cosf(rev); }
                o1[e] = (z1[e] * cs - z2[e] * sn) * ksc; o2[e] = (z1[e] * sn + z2[e] * cs) * ksc;
            }
            u32x4 w1, w2; w1.x = pk2(o1[0], o1[1]); w1.y = pk2(o1[2], o1[3]); w1.z = pk2(o1[4], o1[5]); w1.w = pk2(o1[6], o1[7]);
            w2.x = pk2(o2[0], o2[1]); w2.y = pk2(o2[2], o2[3]); w2.z = pk2(o2[4], o2[5]); w2.w = pk2(o2[6], o2[7]);
            *(u32x4*)z1p = w1; *(u32x4*)(z1p + 32) = w2;
        }
        const bool hp = has_prev(R), hn = has_next(R);
        const bf16* row = prw + (size_t)R * PLD; const bf16* rowp = row - PLD; const bf16* rown = row + PLD;
#pragma unroll
        for (int jj = 0; jj < 4; ++jj) { const int j = lane + 64 * jj;
            if (j < 224) { const float la = bf1(row[RW_LA + j]); const float lp = hp ? bf1(rowp[RW_LB + j]) : 0.f, ln = hn ? bf1(rown[RW_LB + j]) : 0.f;
                const float hv = la + 0.5f * (lp + ln);
                if (j < 64) HW[((size_t)(j >> 5) * MT + R) * 32 + (j & 31)] = 1.0f - 2.0f * __builtin_amdgcn_rcpf(__expf(2.0f * hv) + 1.0f);
                else if (j < 128) HA[((size_t)((j - 64) >> 5) * MT + R) * 32 + ((j - 64) & 31)] = hv;
                else HG[(size_t)R * 96 + (j - 128)] = sigmoidf_(hv); } }
        {
            const u32x4 kc = *(const u32x4*)(row + 512 + 8 * lane); u32x4 kp = {0u, 0u, 0u, 0u}, kn = {0u, 0u, 0u, 0u};
            if (hp) kp = *(const u32x4*)(rowp + 512 + 8 * lane); if (hn) kn = *(const u32x4*)(rown + 512 + 8 * lane);
            const unsigned cw[4] = {kc.x, kc.y, kc.z, kc.w}, pw[4] = {kp.x, kp.y, kp.z, kp.w}, nw[4] = {kn.x, kn.y, kn.z, kn.w};
            float ss = 0.f;
#pragma unroll
            for (int e = 0; e < 8; ++e) { const int c = 8 * lane + e; const float kcv = (e & 1) ? bfhi(cw[e >> 1]) : bflo(cw[e >> 1]), kpv = (e & 1) ? bfhi(pw[e >> 1]) : bflo(pw[e >> 1]), knv = (e & 1) ? bfhi(nw[e >> 1]) : bflo(nw[e >> 1]);
                const float k = kcv + mu_k[c] * (0.5f * (kpv + knv) - kcv); const float kr = k * k_k[c]; ss += kr * kr; }
            ss = sum8(ss);
            if ((lane & 7) == 0) INVN[(size_t)R * 8 + (lane >> 3)] = 1.0f / fmaxf(sqrtf(ss), 1e-12f);
        }
    }
}

__device__ __forceinline__ float ret_loggamma(const Params& p, int d, int h) { const float x = p.in[12][d * 4 + h]; return -log1pf(expf(-x)); }
__device__ __forceinline__ bf16x8 ld8(const bf16* ptr) { return *(const bf16x8*)ptr; }
__device__ __forceinline__ void ret_kv_local(const Params& p, LAS unsigned char* lds, int wave, int lane) {
    const bf16* pret = (const bf16*)(p.ws + WS_PRET); bf16* KV = (bf16*)(p.ws + WS_RETKV);
    LAS bf16* KT = (LAS bf16*)lds; LAS bf16* VT0 = KT + 128 * 136; LAS bf16* VT1 = VT0 + 128 * 136;
    const int tid = threadIdx.x, i16 = lane & 15, q = lane >> 4;
    for (int it = blockIdx.x; it < 2 * 4 * NCH_RET; it += gridDim.x) {
        const int cc = it % NCH_RET, h = (it / NCH_RET) & 3, b = it / (NCH_RET * 4);
        const int R0 = cc < 2 ? ML + b * CTXL + cc * 128 : b * SEQ + (cc - 2) * 128;
        const float l0 = ret_loggamma(p, 0, h) * 1.4426950408889634f, l1 = ret_loggamma(p, 1, h) * 1.4426950408889634f;
        __syncthreads();
#pragma unroll
        for (int i = 0; i < 4; ++i) { const int idx = tid + NTHR * i, tok = idx & 127, c8 = idx >> 7;
            const bf16* rp = pret + (size_t)(R0 + tok) * PLD + h * 128 + 8 * c8;
            const u32x4 kk = *(const u32x4*)(rp + 512), vv = *(const u32x4*)(rp + 1024);
            const unsigned kw[4] = {kk.x, kk.y, kk.z, kk.w}, vw[4] = {vv.x, vv.y, vv.z, vv.w};
            const float w0 = exp2f(l0 * (float)(127 - tok)), w1 = exp2f(l1 * (float)tok);
#pragma unroll
            for (int e = 0; e < 8; ++e) { const unsigned ke = (e & 1) ? (kw[e >> 1] >> 16) : (kw[e >> 1] & 0xffffu); const float ve = (e & 1) ? bfhi(vw[e >> 1]) : bflo(vw[e >> 1]);
                KT[(8 * c8 + e) * 136 + tok] = (bf16)ke; VT0[(8 * c8 + e) * 136 + tok] = (bf16)f2bf(ve * w0); VT1[(8 * c8 + e) * 136 + tok] = (bf16)f2bf(ve * w1); } }
        __syncthreads();
#pragma unroll
        for (int d = 0; d < 2; ++d) {
            const LAS bf16* VT = d ? VT1 : VT0;
            f32x4 acc[8];
#pragma unroll
            for (int ct = 0; ct < 8; ++ct) acc[ct] = (f32x4){0.f, 0.f, 0.f, 0.f};
#pragma unroll
            for (int ks = 0; ks < 4; ++ks) {
                const bf16x8 af = *(const LAS bf16x8*)(VT + (16 * wave + i16) * 136 + 32 * ks + 8 * q);
#pragma unroll
                for (int ct = 0; ct < 8; ++ct) { const bf16x8 bfr = *(const LAS bf16x8*)(KT + (16 * ct + i16) * 136 + 32 * ks + 8 * q);
                    acc[ct] = __builtin_amdgcn_mfma_f32_16x16x32_bf16(bfr, af, acc[ct], 0, 0, 0); }
            }
            bf16* o = KV + ((size_t)(((b * 4 + h) * 2 + d) * NCH_RET + cc) * 128 + 16 * wave + i16) * 128 + 4 * q;
#pragma unroll
            for (int ct = 0; ct < 8; ++ct) { u32x2 w; w.x = pk2(acc[ct][0], acc[ct][1]); w.y = pk2(acc[ct][2], acc[ct][3]); *(u32x2*)(o + 16 * ct) = w; }
        }
    }
}
__device__ __forceinline__ void ret_scan(const Params& p) {
    bf16* KV = (bf16*)(p.ws + WS_RETKV);
    for (int idx = blockIdx.x * NTHR + threadIdx.x; idx < 2 * 4 * 2 * 16384; idx += gridDim.x * NTHR) {
        const int e = idx & 16383, d = (idx >> 14) & 1, h = (idx >> 15) & 3, b = idx >> 17;
        const float dec = expf(128.0f * ret_loggamma(p, d, h));
        bf16* base = KV + (size_t)(((b * 4 + h) * 2 + d) * NCH_RET) * 16384 + e;
        float st = 0.f;
#pragma unroll 1
        for (int s0 = 0; s0 < NCH_RET; s0 += 22) {
            float t[22];
#pragma unroll
            for (int j = 0; j < 22; ++j) { const int s = s0 + j, cc = d == 0 ? s : (s < 2 ? 1 - s : NCH_RET + 1 - s); t[j] = bf1(base[(size_t)cc * 16384]); }
#pragma unroll
            for (int j = 0; j < 22; ++j) { const int s = s0 + j, cc = d == 0 ? s : (s < 2 ? 1 - s : NCH_RET + 1 - s); base[(size_t)cc * 16384] = (bf16)f2bf(st); st = dec * st + t[j]; }
        }
    }
}
__device__ __forceinline__ void ret_out(const Params& p, LAS unsigned char* lds, int wave, int lane, int first, int nblk) {
    bf16* pret = (bf16*)(p.ws + WS_PRET); const bf16* KV = (const bf16*)(p.ws + WS_RETKV);
    LAS bf16* VT = (LAS bf16*)lds;
    const int tid = threadIdx.x, i16 = lane & 15, q = lane >> 4;
    for (int it = (int)blockIdx.x - first; it < 2 * 4 * 64; it += nblk) {
        const int c = it & 63, h = (it >> 6) & 3, b = it >> 8;
        const int R0 = b * SEQ + c * 128;
        const float l0 = ret_loggamma(p, 0, h) * 1.4426950408889634f, l1 = ret_loggamma(p, 1, h) * 1.4426950408889634f;
        __syncthreads();
#pragma unroll
        for (int i = 0; i < 4; ++i) { const int idx = tid + NTHR * i, tok = idx & 127, c8 = idx >> 7;
            const u32x4 vv = *(const u32x4*)(pret + (size_t)(R0 + tok) * PLD + 1024 + h * 128 + 8 * c8);
            const unsigned vw[4] = {vv.x, vv.y, vv.z, vv.w};
#pragma unroll
            for (int e = 0; e < 8; ++e) VT[(8 * c8 + e) * 136 + tok] = (bf16)((e & 1) ? (vw[e >> 1] >> 16) : (vw[e >> 1] & 0xffffu)); }
        __syncthreads();
        const int tk = 16 * wave + i16;
        bf16* qrow = pret + (size_t)(R0 + tk) * PLD + h * 128;
        bf16x8 aq[4];
#pragma unroll
        for (int ks = 0; ks < 4; ++ks) aq[ks] = ld8(qrow + 32 * ks + 8 * q);
        bf16x8 pf[4];
        {
            f32x4 sacc[8];
#pragma unroll
            for (int ct = 0; ct < 8; ++ct) { sacc[ct] = (f32x4){0.f, 0.f, 0.f, 0.f};
                const bf16* krow = pret + (size_t)(R0 + 16 * ct + i16) * PLD + 512 + h * 128 + 8 * q;
#pragma unroll
                for (int ks = 0; ks < 4; ++ks) sacc[ct] = __builtin_amdgcn_mfma_f32_16x16x32_bf16(ld8(krow + 32 * ks), aq[ks], sacc[ct], 0, 0, 0); }
#pragma unroll
            for (int ct = 0; ct < 8; ++ct)
#pragma unroll
                for (int r = 0; r < 4; ++r) { const int s = 16 * ct + 4 * q + r; const int df = tk - s; sacc[ct][r] *= df >= 0 ? exp2f(l0 * (float)df) : exp2f(l1 * (float)(-df)); }
#pragma unroll
            for (int ks = 0; ks < 4; ++ks) { u32x4 w; w.x = pk2(sacc[2 * ks][0], sacc[2 * ks][1]); w.y = pk2(sacc[2 * ks][2], sacc[2 * ks][3]); w.z = pk2(sacc[2 * ks + 1][0], sacc[2 * ks + 1][1]); w.w = pk2(sacc[2 * ks + 1][2], sacc[2 * ks + 1][3]);
                pf[ks] = __builtin_bit_cast(bf16x8, w); }
        }
        const bf16* F = KV + (size_t)(((b * 4 + h) * 2 + 0) * NCH_RET + c + 2) * 16384; const bf16* G = KV + (size_t)(((b * 4 + h) * 2 + 1) * NCH_RET + c + 2) * 16384;
        const float s0 = exp2f(l0 * (float)(tk + 1)), s1 = exp2f(l1 * (float)(128 - tk));
        f32x4 y[8]; float sum = 0.f;
#pragma unroll
        for (int vt = 0; vt < 8; ++vt) {
            f32x4 ay = {0.f, 0.f, 0.f, 0.f}, a0 = ay, a1 = ay;
#pragma unroll
            for (int ks = 0; ks < 4; ++ks) {
                const LAS bf16* vp = VT + (16 * vt + i16) * 136 + 32 * ks + 4 * q;
                const u32x2 lo = *(const LAS u32x2*)vp, hi = *(const LAS u32x2*)(vp + 16);
                u32x4 w; w.x = lo.x; w.y = lo.y; w.z = hi.x; w.w = hi.y;
                ay = __builtin_amdgcn_mfma_f32_16x16x32_bf16(__builtin_bit_cast(bf16x8, w), pf[ks], ay, 0, 0, 0);
                a0 = __builtin_amdgcn_mfma_f32_16x16x32_bf16(ld8(F + (size_t)(16 * vt + i16) * 128 + 32 * ks + 8 * q), aq[ks], a0, 0, 0, 0);
                a1 = __builtin_amdgcn_mfma_f32_16x16x32_bf16(ld8(G + (size_t)(16 * vt + i16) * 128 + 32 * ks + 8 * q), aq[ks], a1, 0, 0, 0);
            }
            y[vt] = ay + a0 * s0 + a1 * s1; sum += (y[vt][0] + y[vt][1]) + (y[vt][2] + y[vt][3]);
        }
        sum += __shfl_xor(sum, 16); sum += __shfl_xor(sum, 32);
        const float mu = sum * (1.0f / 128.0f); float sq = 0.f;
#pragma unroll
        for (int vt = 0; vt < 8; ++vt) { y[vt] = y[vt] - mu; sq += (y[vt][0] * y[vt][0] + y[vt][1] * y[vt][1]) + (y[vt][2] * y[vt][2] + y[vt][3] * y[vt][3]); }
        sq += __shfl_xor(sq, 16); sq += __shfl_xor(sq, 32);
        const float rstd = 1.0f / sqrtf(sq * (1.0f / 128.0f) + 1e-5f);
#pragma unroll
        for (int vt = 0; vt < 8; ++vt) {
            const u32x2 gw = *(const u32x2*)(qrow + 1536 + 16 * vt + 4 * q);
            const float g0 = bflo(gw.x), g1 = bfhi(gw.x), g2 = bflo(gw.y), g3 = bfhi(gw.y);
            u32x2 w; w.x = pk2(y[vt][0] * rstd * g0 * sigmoidf_(g0), y[vt][1] * rstd * g1 * sigmoidf_(g1)); w.y = pk2(y[vt][2] * rstd * g2 * sigmoidf_(g2), y[vt][3] * rstd * g3 * sigmoidf_(g3));
            *(u32x2*)(qrow + 16 * vt + 4 * q) = w;
        }
    }
}

__device__ __forceinline__ int rw_row(int z, int b, int pp) {
    if (pp < CTXL) return ML + b * CTXL + (z ? CTXL - 1 - pp : pp);
    const int t = pp - CTXL; return b * SEQ + (z ? SEQ - 1 - t : t);
}

constexpr int RW_NSEG = 33, RW_WLDS = 18432;
constexpr size_t WS_SEGQ = WS_GU2;
constexpr size_t WS_SEGP0 = MiB / 4, WS_SEGP1 = WS_Y1 + 16 * MiB;
static_assert(WS_SEGQ + (size_t)32 * 32 * 16384 <= WS_U && WS_SEGP0 + (size_t)16 * 31 * 16384 <= WS_GU1 && WS_SEGP1 + (size_t)16 * 31 * 16384 <= 256 * MiB, "rwkv segment state map");
__device__ __forceinline__ float* segp_ptr(unsigned char* ws, int scan, int j) { return (float*)(ws + ((scan < 16) ? WS_SEGP0 : WS_SEGP1)) + ((size_t)(scan & 15) * 31 + (j - 1)) * 4096; }
typedef __bf16 bf16x2_ __attribute__((ext_vector_type(2)));
__device__ __forceinline__ unsigned cvtpk(float lo, float hi) { const f32x2 v = {lo, hi}; return __builtin_bit_cast(unsigned, __builtin_convertvector(v, bf16x2_)); }
__device__ __forceinline__ bf16x8 pack8(f32x4 a, f32x4 b) { u32x4 w; w.x = cvtpk(a[0], a[1]); w.y = cvtpk(a[2], a[3]); w.z = cvtpk(b[0], b[1]); w.w = cvtpk(b[2], b[3]); return __builtin_bit_cast(bf16x8, w); }
__device__ __forceinline__ bf16x8 ldperm(const LAS unsigned char* img, int l15, int q, int ks) {
    const LAS unsigned char* a = img + l15 * 144 + 64 * ks + 8 * q; const u32x2 lo = *(const LAS u32x2*)a, hi = *(const LAS u32x2*)(a + 32);
    u32x4 w; w.x = lo.x; w.y = lo.y; w.z = hi.x; w.w = hi.y; return __builtin_bit_cast(bf16x8, w);
}
constexpr size_t WS_W2P = 128 * 1024, WS_A2P = 192 * 1024;
#define MFMA16(a, b, c) __builtin_amdgcn_mfma_f32_16x16x32_bf16((a), (b), (c), 0, 0, 0)

template <int MODE>
__device__ __forceinline__ void rw_segment(const Params& p, LAS unsigned char* wl, int lane0, int scan, int seg, bool ident) {
    const int Z = scan >> 4, dir = Z ? -1 : 1; const int b = (scan >> 3) & 1, h = scan & 7;
    unsigned char* ws = p.ws;
    const bf16* prw = (const bf16*)(ws + WS_PRW);
    const float* INVN = (const float*)(ws + WS_INVN); const float* HW = (const float*)(ws + WS_HW) + (size_t)Z * MT * 32; const float* HA = (const float*)(ws + WS_HA) + (size_t)Z * MT * 32;
    const float mu_r = p.in[14][h * 64 + lane0], mu_k = p.in[14][512 + h * 64 + lane0], mu_v = p.in[14][1024 + h * 64 + lane0], k_k = p.in[24][h * 64 + lane0], k_a = p.in[25][h * 64 + lane0];
    LAS unsigned char* const IMG_A = wl, * const IMG_R = wl + 2304, * const IMG_B = wl + 4608, * const IMG_K = wl + 6912;
    LAS unsigned char* const T1 = wl, * const DV = wl + 4096;
    LAS unsigned char* const UT = wl + 9216, * const VT = wl + 11264, * const LWB = wl + 13312, * const LAB = wl + 15360;
    LAS unsigned char* const AAB = wl + 13312, * const AAK = wl + 14336, * const A2 = wl + 15360;
    f32x4 S[4][4];
    { const int l15 = lane0 & 15, q = lane0 >> 4;
    if (MODE == 2) { const float* sst = (const float*)(ws + WS_SEGQ) + ((size_t)scan * 32 + (seg - 1)) * 4096 + l15 * 64 + 4 * q;
#pragma unroll
        for (int vt = 0; vt < 4; ++vt)
#pragma unroll
            for (int ct = 0; ct < 4; ++ct) S[vt][ct] = *(const f32x4*)(sst + (16 * vt) * 64 + 16 * ct);
    } else {
#pragma unroll
        for (int vt = 0; vt < 4; ++vt)
#pragma unroll
            for (int ct = 0; ct < 4; ++ct)
#pragma unroll
                for (int r = 0; r < 4; ++r) S[vt][ct][r] = (ident && vt == ct && l15 == 4 * q + r) ? 1.0f : 0.0f;
    }
    }
    const int pp_start = seg * 256;
#pragma unroll 1
    for (int ci = 0; ci < 16; ++ci) {
        int lane_ = lane0; asm volatile("" : "+v"(lane_));
        const int lane = lane_, l15 = lane & 15, q = lane >> 4, hc = h * 64 + lane;
        const bf16x8* w2p = (const bf16x8*)(ws + WS_W2P) + (size_t)((Z * 8 + h) * 4) * 64 + lane; const bf16x8* a2p = (const bf16x8*)(ws + WS_A2P) + (size_t)((Z * 8 + h) * 4) * 64 + lane;
        const int R0 = rw_row(Z, b, pp_start + 16 * ci);
        {
            const int Rt = R0 + dir * l15;
            const float* hwp = HW + (size_t)Rt * 32 + 8 * q; const float* hap = HA + (size_t)Rt * 32 + 8 * q;
            const bf16x8 hwf = pack8(*(const f32x4*)hwp, *(const f32x4*)(hwp + 4)), haf = pack8(*(const f32x4*)hap, *(const f32x4*)(hap + 4));
#pragma unroll
            for (int ct = 0; ct < 4; ++ct) { const f32x4 z4 = {0.f, 0.f, 0.f, 0.f};
                const f32x4 d = MFMA16(hwf, w2p[64 * ct], z4), d2 = MFMA16(haf, a2p[64 * ct], z4);
                const float w0 = p.in[16][Z * 512 + h * 64 + 16 * ct + l15], a0 = p.in[19][Z * 512 + h * 64 + 16 * ct + l15];
                u32x2 w; w.x = cvtpk(-0.6065306597126334f * sigmoidf_(w0 + d[0]), -0.6065306597126334f * sigmoidf_(w0 + d[1]));
                w.y = cvtpk(-0.6065306597126334f * sigmoidf_(w0 + d[2]), -0.6065306597126334f * sigmoidf_(w0 + d[3]));
                *(LAS u32x2*)(LWB + (16 * ct + l15) * 32 + 8 * q) = w;
                w.x = cvtpk(sigmoidf_(a0 + d2[0]), sigmoidf_(a0 + d2[1])); w.y = cvtpk(sigmoidf_(a0 + d2[2]), sigmoidf_(a0 + d2[3]));
                *(LAS u32x2*)(LAB + (16 * ct + l15) * 32 + 8 * q) = w; }
        }
        const float invl = INVN[(size_t)(R0 + dir * l15) * 8 + h];
        const bool okp = Z ? has_next(R0) : has_prev(R0), okn = Z ? has_prev(R0 - 15) : has_next(R0 + 15);
        unsigned pkw[9], prw_[9], pvw[9];
#pragma unroll
        for (int m = 0; m < 9; ++m) { const bf16* r0 = prw + (size_t)(R0 + dir * (2 * m - 1)) * PLD + hc; const bf16* r1 = prw + (size_t)(R0 + dir * (2 * m)) * PLD + hc;
            const bool ok0 = m > 0 || okp, ok1 = m < 8 || okn;
            pkw[m] = (ok0 ? (unsigned)r0[512] : 0u) | ((ok1 ? (unsigned)r1[512] : 0u) << 16);
            if (MODE == 2) prw_[m] = (ok0 ? (unsigned)r0[0] : 0u) | ((ok1 ? (unsigned)r1[0] : 0u) << 16);
            pvw[m] = ident ? 0u : ((ok0 ? (unsigned)r0[1024] : 0u) | ((ok1 ? (unsigned)r1[1024] : 0u) << 16)); }
#define RWPOS(arr, j) (((j) & 1) ? bfhi(arr[(j) >> 1]) : bflo(arr[(j) >> 1]))
        asm volatile("" ::: "memory");
        unsigned lww[8], law[8];
        { const u32x4 a = *(const LAS u32x4*)(LWB + lane * 32), c = *(const LAS u32x4*)(LWB + lane * 32 + 16), d = *(const LAS u32x4*)(LAB + lane * 32), e = *(const LAS u32x4*)(LAB + lane * 32 + 16);
          lww[0] = a.x; lww[1] = a.y; lww[2] = a.z; lww[3] = a.w; lww[4] = c.x; lww[5] = c.y; lww[6] = c.z; lww[7] = c.w;
          law[0] = d.x; law[1] = d.y; law[2] = d.z; law[3] = d.w; law[4] = e.x; law[5] = e.y; law[6] = e.z; law[7] = e.w; }
        float cum = 0.f, Eprev = 1.f, Elast = 1.f;
        float ve = 0.f;
#pragma unroll
        for (int i = 0; i < 16; ++i) {
            const int idx = i + 1;
            const float lw = (i & 1) ? bfhi(lww[i >> 1]) : bflo(lww[i >> 1]); cum += lw;
            const float E = __expf(cum), Einv = __builtin_amdgcn_rcpf(E);
            const float asig = (i & 1) ? bfhi(law[i >> 1]) : bflo(law[i >> 1]);
            const float kc_ = RWPOS(pkw, idx); const float k = kc_ + mu_k * (0.5f * (RWPOS(pkw, idx - 1) + RWPOS(pkw, idx + 1)) - kc_);
            const float invn = __int_as_float(__builtin_amdgcn_readlane(__float_as_int(invl), i));
            const float kk = k * k_k * invn, keff = k * (1.0f + (asig - 1.0f) * k_a);
            const float at = -kk * Eprev, bh = kk * asig * Einv, kh = keff * Einv;
            const unsigned wab = cvtpk(at, bh);
            *(LAS unsigned short*)(IMG_A + i * 144 + lane * 2) = (unsigned short)(wab & 0xffffu); *(LAS unsigned short*)(IMG_B + i * 144 + lane * 2) = (unsigned short)(wab >> 16);
            float rt = 0.f;
            if (MODE == 2) { const float rc_ = RWPOS(prw_, idx); const float r = rc_ + mu_r * (0.5f * (RWPOS(prw_, idx - 1) + RWPOS(prw_, idx + 1)) - rc_); rt = r * (Z == 0 ? E : Eprev); }
            const unsigned wkr = cvtpk(kh, rt);
            *(LAS unsigned short*)(IMG_K + i * 144 + lane * 2) = (unsigned short)(wkr & 0xffffu); if (MODE == 2) *(LAS unsigned short*)(IMG_R + i * 144 + lane * 2) = (unsigned short)(wkr >> 16);
            float v = 0.f;
            { const float vc_ = RWPOS(pvw, idx); v = vc_ + mu_v * (0.5f * (RWPOS(pvw, idx - 1) + RWPOS(pvw, idx + 1)) - vc_);
                if (i & 1) *(LAS unsigned*)(VT + lane * 32 + 2 * (i - 1)) = cvtpk(ve, v); else ve = v; }
            Eprev = E; Elast = E;
        }
        asm volatile("" ::: "memory");
        bf16x8 fA[2], fB[2], fK[2], fR[2];
#pragma unroll
        for (int ks = 0; ks < 2; ++ks) { fA[ks] = ldperm(IMG_A, l15, q, ks); fB[ks] = ldperm(IMG_B, l15, q, ks); fK[ks] = ldperm(IMG_K, l15, q, ks); if (MODE == 2) fR[ks] = ldperm(IMG_R, l15, q, ks); }
        bf16x8 bkf[4];
        { const unsigned ta = (unsigned)(size_t)(q < 2 ? IMG_B : IMG_K) + (unsigned)((8 * (q & 1) + (l15 >> 2)) * 144 + 8 * (l15 & 3));
          u32x2 t0, t1, t2, t3, t4, t5, t6, t7;
          asm volatile("ds_read_b64_tr_b16 %0, %8\n\tds_read_b64_tr_b16 %1, %8 offset:576\n\tds_read_b64_tr_b16 %2, %8 offset:32\n\tds_read_b64_tr_b16 %3, %8 offset:608\n\t"
                       "ds_read_b64_tr_b16 %4, %8 offset:64\n\tds_read_b64_tr_b16 %5, %8 offset:640\n\tds_read_b64_tr_b16 %6, %8 offset:96\n\tds_read_b64_tr_b16 %7, %8 offset:672\n\ts_waitcnt lgkmcnt(0)"
                       : "=&v"(t0), "=&v"(t1), "=&v"(t2), "=&v"(t3), "=&v"(t4), "=&v"(t5), "=&v"(t6), "=&v"(t7) : "v"(ta) : "memory");
          bkf[0] = __builtin_bit_cast(bf16x8, (u32x4){t0.x, t0.y, t1.x, t1.y}); bkf[1] = __builtin_bit_cast(bf16x8, (u32x4){t2.x, t2.y, t3.x, t3.y});
          bkf[2] = __builtin_bit_cast(bf16x8, (u32x4){t4.x, t4.y, t5.x, t5.y}); bkf[3] = __builtin_bit_cast(bf16x8, (u32x4){t6.x, t6.y, t7.x, t7.y}); }
        asm volatile("" ::: "memory");
        {
            f32x4 gab = {0.f, 0.f, 0.f, 0.f}, gak = gab, grb = gab, grk = gab;
#pragma unroll
            for (int ks = 0; ks < 2; ++ks) { gab = MFMA16(fB[ks], fA[ks], gab); gak = MFMA16(fK[ks], fA[ks], gak); if (MODE == 2) { grb = MFMA16(fB[ks], fR[ks], grb); grk = MFMA16(fK[ks], fR[ks], grk); } }
#pragma unroll
            for (int r = 0; r < 4; ++r) { const int s = 4 * q + r; if (!(s < l15)) { gab[r] = 0.f; gak[r] = 0.f; } if (!(Z == 0 ? s <= l15 : s < l15)) { grb[r] = 0.f; grk[r] = 0.f; } }
            *(LAS f32x4*)(AAB + l15 * 64 + 16 * q) = gab; *(LAS f32x4*)(AAK + l15 * 64 + 16 * q) = gak;
            if (MODE == 2) { u32x2 w; w.x = cvtpk(grb[0], grb[1]); w.y = cvtpk(grb[2], grb[3]); *(LAS u32x2*)(A2 + l15 * 80 + 8 * q) = w;
                             w.x = cvtpk(grk[0], grk[1]); w.y = cvtpk(grk[2], grk[3]); *(LAS u32x2*)(A2 + l15 * 80 + 32 + 8 * q) = w; }
            *(LAS float*)(DV + lane * 4) = Elast;
        }
        f32x4 yp[4];
#pragma unroll
        for (int vt = 0; vt < 4; ++vt) { const bf16x8 sf0 = pack8(S[vt][0], S[vt][1]), sf1 = pack8(S[vt][2], S[vt][3]);
            f32x4 t1 = {0.f, 0.f, 0.f, 0.f}; t1 = MFMA16(fA[0], sf0, t1); t1 = MFMA16(fA[1], sf1, t1);
            *(LAS f32x4*)(T1 + (16 * vt + l15) * 64 + 16 * q) = t1;
            if (MODE == 2) { f32x4 y = {0.f, 0.f, 0.f, 0.f}; y = MFMA16(sf0, fR[0], y); y = MFMA16(sf1, fR[1], y); yp[vt] = y; } }
        asm volatile("" ::: "memory");
        float U[16]; unsigned vw_[8];
        { const u32x4 a = *(const LAS u32x4*)(VT + lane * 32), c = *(const LAS u32x4*)(VT + lane * 32 + 16); vw_[0] = a.x; vw_[1] = a.y; vw_[2] = a.z; vw_[3] = a.w; vw_[4] = c.x; vw_[5] = c.y; vw_[6] = c.z; vw_[7] = c.w; }
        { const f32x4 t0 = *(const LAS f32x4*)(T1 + lane * 64), t1 = *(const LAS f32x4*)(T1 + lane * 64 + 16), t2 = *(const LAS f32x4*)(T1 + lane * 64 + 32), t3 = *(const LAS f32x4*)(T1 + lane * 64 + 48);
#pragma unroll
          for (int r = 0; r < 4; ++r) { U[r] = t0[r]; U[4 + r] = t1[r]; U[8 + r] = t2[r]; U[12 + r] = t3[r]; } }
#pragma unroll
        for (int i = 1; i < 16; ++i) {
            float acc = U[i];
#pragma unroll
            for (int g = 0; g <= (i - 1) >> 2; ++g) { const f32x4 ab = *(const LAS f32x4*)(AAB + i * 64 + 16 * g);
#pragma unroll
                for (int r = 0; r < 4; ++r) if (4 * g + r < i) acc += ab[r] * U[4 * g + r];
                { const f32x4 ak = *(const LAS f32x4*)(AAK + i * 64 + 16 * g);
#pragma unroll
                    for (int r = 0; r < 4; ++r) if (4 * g + r < i) acc += ak[r] * ((r & 1) ? bfhi(vw_[(4 * g + r) >> 1]) : bflo(vw_[(4 * g + r) >> 1])); } }
            U[i] = acc;
        }
        { u32x4 w0_, w1_; w0_.x = cvtpk(U[0], U[1]); w0_.y = cvtpk(U[2], U[3]); w0_.z = cvtpk(U[4], U[5]); w0_.w = cvtpk(U[6], U[7]);
          w1_.x = cvtpk(U[8], U[9]); w1_.y = cvtpk(U[10], U[11]); w1_.z = cvtpk(U[12], U[13]); w1_.w = cvtpk(U[14], U[15]);
          *(LAS u32x4*)(UT + lane * 32) = w0_; *(LAS u32x4*)(UT + lane * 32 + 16) = w1_; }
        asm volatile("" ::: "memory");
        bf16x8 uvf[4];
#pragma unroll
        for (int t = 0; t < 4; ++t) uvf[t] = *(const LAS bf16x8*)((q < 2 ? UT : VT) + (16 * t + l15) * 32 + 16 * (q & 1));
        if (MODE == 2) {
            const bf16x8 a2f_ = *(const LAS bf16x8*)(A2 + l15 * 80 + 16 * q);
            const int Rt = R0 + dir * l15;
            bf16* yo = Z == 0 ? (bf16*)(ws + WS_PRW) + (size_t)Rt * PLD + RW_Y + h * 64 + 4 * q : (bf16*)(ws + WS_Y1) + (size_t)Rt * 512 + h * 64 + 4 * q;
#pragma unroll
            for (int vt = 0; vt < 4; ++vt) { const f32x4 y = MFMA16(uvf[vt], a2f_, yp[vt]);
                u32x2 w; w.x = cvtpk(y[0], y[1]); w.y = cvtpk(y[2], y[3]); *(u32x2*)(yo + 16 * vt) = w; }
        }
#pragma unroll
        for (int ct = 0; ct < 4; ++ct) { const f32x4 dv = *(const LAS f32x4*)(DV + (16 * ct + 4 * q) * 4);
#pragma unroll
            for (int vt = 0; vt < 4; ++vt) S[vt][ct] = MFMA16(bkf[ct], uvf[vt], S[vt][ct]) * dv; }
        asm volatile("s_waitcnt lgkmcnt(0)" ::: "memory");
    }
    const int l15 = lane0 & 15, q = lane0 >> 4;
    if (MODE == 0 && !ident) { float* o = (float*)(ws + WS_SEGQ) + ((size_t)scan * 32 + seg) * 4096 + l15 * 64 + 4 * q; asm volatile("" : "+v"(o));
#pragma unroll
        for (int vt = 0; vt < 4; ++vt)
#pragma unroll
            for (int ct = 0; ct < 4; ++ct) *(f32x4*)(o + (16 * vt) * 64 + 16 * ct) = S[vt][ct]; }
    if (MODE == 0 && ident) { float* o = segp_ptr(ws, scan, seg) + (4 * q) * 64 + l15;
        asm volatile("" : "+v"(o));
#pragma unroll
        for (int vt = 0; vt < 4; ++vt)
#pragma unroll
            for (int ct = 0; ct < 4; ++ct)
#pragma unroll
                for (int r = 0; r < 4; ++r) o[(16 * ct + r) * 64 + 16 * vt] = S[vt][ct][r]; }
}
__device__ __forceinline__ void rw_pass_a(const Params& p, LAS unsigned char* lds, int wave, int lane) {
    LAS unsigned char* wl = lds + wave * RW_WLDS;
#pragma unroll 1
    for (int it = blockIdx.x * NWAVES + wave; it < 1024 + 992; it += gridDim.x * NWAVES) {
        const bool ident = it >= 1024; const int t = it - 1024; const int scan = ident ? t / 31 : it >> 5, seg = ident ? 1 + t % 31 : it & 31;
        rw_segment<0>(p, wl, lane, scan, seg, ident);
    }
}
__device__ __forceinline__ void rw_pass_c(const Params& p, LAS unsigned char* lds, int wave, int lane) {
    LAS unsigned char* wl = lds + wave * RW_WLDS;
    if (wave < 4)
#pragma unroll 1
    for (int it = blockIdx.x * 4 + wave; it < 1024; it += gridDim.x * 4) rw_segment<2>(p, wl, lane, it >> 5, 1 + (it & 31), false);
}
__device__ __forceinline__ void rw_pass_b(const Params& p, int wave, int lane) {
    const int l15 = lane & 15, q = lane >> 4;
    for (int it = blockIdx.x * NWAVES + wave; it < 128; it += gridDim.x * NWAVES) {
        const int scan = it >> 2, vt = it & 3;
        float* qb = (float*)(p.ws + WS_SEGQ) + (size_t)scan * 32 * 4096 + (16 * vt + l15) * 64 + 4 * q;
        f32x4 S[4];
#pragma unroll
        for (int ct = 0; ct < 4; ++ct) S[ct] = *(const f32x4*)(qb + 16 * ct);
#pragma unroll 1
        for (int m = 1; m < 32; ++m) {
            const float* pt = segp_ptr(p.ws, scan, m);
            bf16x8 shi[2], slo[2];
#pragma unroll
            for (int ks = 0; ks < 2; ++ks) { const f32x4 a = S[2 * ks], bq = S[2 * ks + 1]; shi[ks] = pack8(a, bq);
                const u32x4 hw = __builtin_bit_cast(u32x4, shi[ks]);
                const f32x4 ah = {bflo(hw.x), bfhi(hw.x), bflo(hw.y), bfhi(hw.y)}, bh = {bflo(hw.z), bfhi(hw.z), bflo(hw.w), bfhi(hw.w)};
                slo[ks] = pack8(a - ah, bq - bh); }
            f32x4 N[4];
#pragma unroll
            for (int ct = 0; ct < 4; ++ct) { f32x4 acc = *(const f32x4*)(qb + (size_t)m * 4096 + 16 * ct);
#pragma unroll
                for (int ks = 0; ks < 2; ++ks) { const float* pr_ = pt + (16 * ct + l15) * 64 + 32 * ks + 4 * q; const f32x4 a = *(const f32x4*)pr_, bq = *(const f32x4*)(pr_ + 16);
                    const bf16x8 phi = pack8(a, bq); const u32x4 hw = __builtin_bit_cast(u32x4, phi);
                    const f32x4 ah = {bflo(hw.x), bfhi(hw.x), bflo(hw.y), bfhi(hw.y)}, bh = {bflo(hw.z), bfhi(hw.z), bflo(hw.w), bfhi(hw.w)};
                    const bf16x8 plo = pack8(a - ah, bq - bh);
                    acc = MFMA16(phi, shi[ks], acc); acc = MFMA16(plo, shi[ks], acc); acc = MFMA16(phi, slo[ks], acc); }
                N[ct] = acc; }
#pragma unroll
            for (int ct = 0; ct < 4; ++ct) { S[ct] = N[ct]; *(f32x4*)(qb + (size_t)m * 4096 + 16 * ct) = N[ct]; }
        }
    }
}

__device__ __forceinline__ void p0_lora_frags(const Params& p) {
    for (int idx = blockIdx.x * NTHR + threadIdx.x; idx < 2 * 4096; idx += gridDim.x * NTHR) {
        const int which = idx >> 12, t = idx & 4095, lane = t & 63, ct = (t >> 6) & 3, h = (t >> 8) & 7, z = t >> 11, l15 = lane & 15, q = lane >> 4;
        const float* W = which ? p.in[21] : p.in[18]; float v[8];
#pragma unroll
        for (int e = 0; e < 8; ++e) v[e] = W[(size_t)(z * 32 + 8 * q + e) * 512 + h * 64 + 16 * ct + l15];
        u32x4 w; w.x = pk2(v[0], v[1]); w.y = pk2(v[2], v[3]); w.z = pk2(v[4], v[5]); w.w = pk2(v[6], v[7]);
        *(u32x4*)(p.ws + (which ? WS_A2P : WS_W2P) + (size_t)t * 16) = w;
    }
}

__device__ __forceinline__ void rwkv_readout(const Params& p, LAS unsigned char* lds, int wave, int lane) {
    LAS bf16* g2s = (LAS bf16*)lds; LAS bf16* a2s = g2s + 96 * 512;
    for (int i = threadIdx.x; i < 96 * 512; i += NTHR) g2s[i] = (bf16)f2bf(p.in[23][i]);
    for (int i = threadIdx.x; i < 32 * 512; i += NTHR) a2s[i] = (bf16)f2bf(p.in[21][i]);
    __syncthreads();
    bf16* prw = (bf16*)(p.ws + WS_PRW); const bf16* Y1 = (const bf16*)(p.ws + WS_Y1);
    const float* HA = (const float*)(p.ws + WS_HA); const float* HG = (const float*)(p.ws + WS_HG);
    const int gw = blockIdx.x * NWAVES + wave, NGW = gridDim.x * NWAVES;
    const int c0 = 8 * lane;
    float mur[8], muk[8], muv[8], kav[8], rkv[8], lnw[8], lnb[8], a0v[8];
#pragma unroll
    for (int e = 0; e < 8; ++e) { mur[e] = p.in[14][c0 + e]; muk[e] = p.in[14][512 + c0 + e]; muv[e] = p.in[14][1024 + c0 + e]; kav[e] = p.in[25][c0 + e]; rkv[e] = p.in[26][c0 + e];
        lnw[e] = p.in[27][c0 + e]; lnb[e] = p.in[28][c0 + e]; a0v[e] = p.in[19][c0 + e]; }
    for (int R = gw; R < ML; R += NGW) {
        bf16* row = prw + (size_t)R * PLD; const bool hp = has_prev(R), hn = has_next(R);
        float y[8], r[8], k[8], v[8];
        { const u32x4 a = *(const u32x4*)(row + RW_Y + c0), bb = *(const u32x4*)(Y1 + (size_t)R * 512 + c0); const unsigned aw[4] = {a.x, a.y, a.z, a.w}, bw[4] = {bb.x, bb.y, bb.z, bb.w};
#pragma unroll
          for (int e = 0; e < 4; ++e) { y[2 * e] = bflo(aw[e]) + bflo(bw[e]); y[2 * e + 1] = bfhi(aw[e]) + bfhi(bw[e]); } }
#pragma unroll
        for (int tns = 0; tns < 3; ++tns) {
            const u32x4 cc = *(const u32x4*)(row + 512 * tns + c0); u32x4 pp = {0u, 0u, 0u, 0u}, nn = {0u, 0u, 0u, 0u};
            if (hp) pp = *(const u32x4*)(row - PLD + 512 * tns + c0); if (hn) nn = *(const u32x4*)(row + PLD + 512 * tns + c0);
            const unsigned cw[4] = {cc.x, cc.y, cc.z, cc.w}, pw[4] = {pp.x, pp.y, pp.z, pp.w}, nw[4] = {nn.x, nn.y, nn.z, nn.w};
#pragma unroll
            for (int e = 0; e < 8; ++e) { const float cv = (e & 1) ? bfhi(cw[e >> 1]) : bflo(cw[e >> 1]), pv = (e & 1) ? bfhi(pw[e >> 1]) : bflo(pw[e >> 1]), nv = (e & 1) ? bfhi(nw[e >> 1]) : bflo(nw[e >> 1]);
                const float mu = tns == 0 ? mur[e] : (tns == 1 ? muk[e] : muv[e]); const float o = cv + mu * (0.5f * (pv + nv) - cv);
                if (tns == 0) r[e] = o; else if (tns == 1) k[e] = o; else v[e] = o; }
        }
        float s = 0.f;
#pragma unroll
        for (int e = 0; e < 8; ++e) s += y[e];
        const float mu = sum8(s) * (1.0f / 64.0f); float sq = 0.f;
#pragma unroll
        for (int e = 0; e < 8; ++e) { y[e] -= mu; sq += y[e] * y[e]; }
        const float rstd = 1.0f / sqrtf(sum8(sq) * (1.0f / 64.0f) + 64e-5f);
        float ap[8], g[8];
#pragma unroll
        for (int e = 0; e < 8; ++e) { ap[e] = a0v[e]; g[e] = 0.f; }
        const float hav = HA[(size_t)R * 32 + (lane & 31)];
#pragma unroll 4
        for (int j = 0; j < 32; ++j) { const float hv = __shfl(hav, j); const u32x4 w = *(const LAS u32x4*)(a2s + j * 512 + c0); const unsigned ww[4] = {w.x, w.y, w.z, w.w};
#pragma unroll
            for (int e = 0; e < 4; ++e) { ap[2 * e] += hv * bflo(ww[e]); ap[2 * e + 1] += hv * bfhi(ww[e]); } }
        const float hg0 = HG[(size_t)R * 96 + lane], hg1 = HG[(size_t)R * 96 + 64 + (lane & 31)];
#pragma unroll 4
        for (int j = 0; j < 96; ++j) { const float hv = j < 64 ? __shfl(hg0, j) : __shfl(hg1, j - 64); const u32x4 w = *(const LAS u32x4*)(g2s + j * 512 + c0); const unsigned ww[4] = {w.x, w.y, w.z, w.w};
#pragma unroll
            for (int e = 0; e < 4; ++e) { g[2 * e] += hv * bflo(ww[e]); g[2 * e + 1] += hv * bfhi(ww[e]); } }
        float bs = 0.f;
#pragma unroll
        for (int e = 0; e < 8; ++e) { const float asig = sigmoidf_(ap[e]); const float keff = k[e] * (1.0f + (asig - 1.0f) * kav[e]); bs += r[e] * keff * rkv[e]; }
        bs = sum8(bs);
        float o[8];
#pragma unroll
        for (int e = 0; e < 8; ++e) o[e] = (y[e] * rstd * lnw[e] + lnb[e] + bs * v[e]) * g[e];
        u32x4 w; w.x = pk2(o[0], o[1]); w.y = pk2(o[2], o[3]); w.z = pk2(o[4], o[5]); w.w = pk2(o[6], o[7]);
        *(u32x4*)(row + RW_Y + c0) = w;
    }
}

constexpr int LDS_BYTES = 147456 + 64;
constexpr int LDS_BARW = 147456;
constexpr int NPHASE = 17;
__global__ void __launch_bounds__(NTHR, 2) fwd_megakernel(Params p) {
    extern __shared__ __attribute__((aligned(16))) unsigned char lds_raw[];
    LAS unsigned char* lds = (LAS unsigned char*)lds_raw;
    cg::grid_group grid = cg::this_grid();
    const int tid = threadIdx.x, lane = tid & 63, wave = __builtin_amdgcn_readfirstlane(tid >> 6);
    unsigned char* ws = p.ws;
    const float* x = p.in[0]; const float* ctx = p.in[2];
    float* Hl = p.out; float* Hc = (float*)(ws + WS_HC);
    const float* modv = (const float*)(ws + WS_MODV);
    bf16* U = (bf16*)(ws + WS_U); bf16* ACT = (bf16*)(ws + WS_ACT); bf16* PRET = (bf16*)(ws + WS_PRET); bf16* PRW = (bf16*)(ws + WS_PRW);
    const int lo = p.ph_lo, hi = p.ph_hi, G = gridDim.x, bx = blockIdx.x;
#define IN(k) (lo <= (k) && (k) < hi)
#define SEAM(k) do { if (IN(k) && IN((k) + 1)) { if ((k) == 0) grid.sync(); else xcd_barrier(bar); } } while (0)
    if (tid < 16) ((LAS unsigned*)(lds + LDS_BARW))[tid] = 0u;
    __syncthreads();
    const XcdBarrier bar = xcd_barrier_post((unsigned*)(ws + WS_BAR), (volatile LAS unsigned*)(lds + LDS_BARW));

    if (IN(0)) { p0_modv(p, lds); p0_lora_frags(p); p0_weights(p, lds, wave, lane, 0, 18); } SEAM(0);
    if (IN(1)) norm_rows(x, ctx, p.in[6], modv, 0 * DM, 1 * DM, U, MT, wave, lane); SEAM(1);
    if (IN(2)) { pg8::Gemm g{U, (const bf16*)(ws + WS_GU1), MT, 2 * DFF, DM, DM}; pg8::StaticOrder S; S.init(MT, 2 * DFF, G, bx); EpiSwiGLU E{ACT, DFF};
        pg8::gemm_phase<EpiSwiGLU, pg8::StaticOrder, true, true>(lds, g, S, E); } SEAM(2);
    if (IN(3)) { pg8::Gemm g{ACT, (const bf16*)(ws + WS_D1), MT, DM, DFF, DFF}; pg8::StaticOrder S; S.init(MT, DM, G, bx); EpiResid E{x, ctx, Hl, Hc, modv, 2 * DM, 0.5f};
        pg8::gemm_phase<EpiResid, pg8::StaticOrder, true, true>(lds, g, S, E); } SEAM(3);
    if (IN(4)) norm_rows(Hl, Hc, p.in[10], modv, 3 * DM, 4 * DM, U, MT, wave, lane); SEAM(4);
    if (IN(5)) { pg8::Gemm g{U, (const bf16*)(ws + WS_WIN), MT, 4096, DM, DM}; pg8::StaticOrder S; S.init(MT, 4096, G, bx); EpiB<0, true> E{PRET, PRW, nullptr, PLD};
        pg8::gemm_phase<EpiB<0, true>, pg8::StaticOrder, true, true>(lds, g, S, E); } SEAM(5);
    if (IN(6)) p6_token_prep(p, wave, lane); SEAM(6);
    if (IN(7)) { rw_pass_a(p, lds, wave, lane); __syncthreads(); ret_kv_local(p, lds, wave, lane); } SEAM(7);
    if (IN(8)) { rw_pass_b(p, wave, lane); ret_scan(p); } SEAM(8);
    if (IN(9)) { rw_pass_c(p, lds, wave, lane); __syncthreads(); ret_out(p, lds, wave, lane, 0, G); } SEAM(9);
    if (IN(10)) { rwkv_readout(p, lds, wave, lane); norm_rows(Hl, Hc, p.in[10], modv, 3 * DM, 4 * DM, U, ML, wave, lane); __syncthreads(); p0_weights(p, lds, wave, lane, 18, NTRJOB); } SEAM(10);
    if (IN(11)) {
        pg8::StaticOrder S; S.init(ML, DM, G, bx);
        { pg8::Gemm g{PRET, (const bf16*)(ws + WS_RO), ML, DM, 512, PLD}; EpiB<0, false> E{PRET + 1024, nullptr, nullptr, PLD}; pg8::gemm_phase<EpiB<0, false>, pg8::StaticOrder, false, true>(lds, g, S, E); }
        { pg8::Gemm g{U, (const bf16*)(ws + WS_WG), ML, DM, DM, DM}; EpiB<1, false> E{PRET + 1024, nullptr, nullptr, PLD}; pg8::gemm_phase<EpiB<1, false>, pg8::StaticOrder, false, true>(lds, g, S, E); }
        { pg8::Gemm g{PRW + RW_Y, (const bf16*)(ws + WS_RWO), ML, DM, 512, PLD}; EpiB<0, false> E{PRW, nullptr, nullptr, PLD}; pg8::gemm_phase<EpiB<0, false>, pg8::StaticOrder, false, true>(lds, g, S, E); }
        { pg8::Gemm g{U, (const bf16*)(ws + WS_WG) + (size_t)DM * DM, ML, DM, DM, DM}; EpiB<2, false> E{PRET + 1024, nullptr, PRW, PLD}; pg8::gemm_phase<EpiB<2, false>, pg8::StaticOrder, false, true>(lds, g, S, E); }
    } SEAM(11);
    if (IN(12)) { pg8::Gemm g{PRET + 1024, (const bf16*)(ws + WS_WOUT), ML, DM, DM, PLD}; pg8::StaticOrder S; S.init(ML, DM, G, bx); EpiResid E{Hl, Hc, Hl, Hc, modv, 5 * DM, 1.0f};
        pg8::gemm_phase<EpiResid, pg8::StaticOrder, false, true>(lds, g, S, E); } SEAM(12);
    if (IN(13)) norm_rows(Hl, Hc, p.in[31], modv, 6 * DM, 7 * DM, U, ML, wave, lane); SEAM(13);
    if (IN(14)) { pg8::Gemm g{U, (const bf16*)(ws + WS_GU2), ML, 2 * DFF, DM, DM}; pg8::StaticOrder S; S.init(ML, 2 * DFF, G, bx); EpiSwiGLU E{ACT, DFF};
        pg8::gemm_phase<EpiSwiGLU, pg8::StaticOrder, true, true>(lds, g, S, E); } SEAM(14);
    if (IN(15)) { pg8::Gemm g{ACT, (const bf16*)(ws + WS_D2), ML, DM, DFF, DFF}; pg8::StaticOrder S; S.init(ML, DM, G, bx); EpiResid E{Hl, Hc, Hl, Hc, modv, 8 * DM, 0.5f};
        pg8::gemm_phase<EpiResid, pg8::StaticOrder, false, true>(lds, g, S, E); } SEAM(15);
    if (IN(16)) {
        const int gw = bx * NWAVES + wave, NGW = G * NWAVES; const float* gf = p.in[35];
        for (int R = gw; R < ML; R += NGW) { float* xr = Hl + (size_t)R * DM + 4 * lane; f32x4 v[4]; float s = 0.f;
#pragma unroll
            for (int j = 0; j < 4; ++j) { v[j] = *(const f32x4*)(xr + 256 * j); s += (v[j].x * v[j].x + v[j].y * v[j].y) + (v[j].z * v[j].z + v[j].w * v[j].w); }
            const float rstd = 1.0f / sqrtf(wave_sum(s) * (1.0f / DM) + 1e-6f);
#pragma unroll
            for (int j = 0; j < 4; ++j) *(f32x4*)(xr + 256 * j) = (v[j] * rstd) * *(const f32x4*)(gf + 4 * lane + 256 * j); }
    }
#undef IN
#undef SEAM
}

extern "C" void kernel_launch(void* const* d_in, const int* in_sizes, int n_in, void* d_out, int out_size, void* d_ws, size_t ws_size, hipStream_t stream) {
    static int grid = 0;
    if (grid == 0) {
        if (n_in != 36 || out_size != ML * DM || ws_size < 256 * MiB) { fprintf(stderr, "kernel_launch: unexpected problem (n_in %d out %d ws %zu)\n", n_in, out_size, ws_size); grid = -1; return; }
        int dev = 0, cus = 0, per_cu = 0;
        (void)hipGetDevice(&dev); (void)hipDeviceGetAttribute(&cus, hipDeviceAttributeMultiprocessorCount, dev);
        if (hipFuncSetAttribute((const void*)fwd_megakernel, hipFuncAttributeMaxDynamicSharedMemorySize, LDS_BYTES) != hipSuccess) { fprintf(stderr, "kernel_launch: hipFuncSetAttribute failed\n"); grid = -1; return; }
        if (hipOccupancyMaxActiveBlocksPerMultiprocessor(&per_cu, (const void*)fwd_megakernel, NTHR, LDS_BYTES) != hipSuccess || per_cu < 1) { fprintf(stderr, "kernel_launch: occupancy query says %d\n", per_cu); per_cu = 1; }
        (void)hipGetLastError();
        grid = cus * (per_cu > 1 ? 1 : per_cu);
        fprintf(stderr, "kernel_launch: cus %d per_cu %d grid %d\n", cus, per_cu, grid);
    }
    if (grid < 0) return;
    if (hipMemsetAsync((char*)d_ws + WS_BAR, 0, XCD_BAR_WORDS * 4, stream) != hipSuccess) { fprintf(stderr, "kernel_launch: memset of the barrier words failed\n"); return; }
    Params p{};
    for (int i = 0; i < 36; ++i) p.in[i] = (const float*)d_in[i];
    p.out = (float*)d_out; p.ws = (unsigned char*)d_ws; p.ph_lo = 0; p.ph_hi = NPHASE;
    void* args[] = {&p};
    hipError_t e = hipLaunchCooperativeKernel((const void*)fwd_megakernel, dim3(grid), dim3(NTHR), args, LDS_BYTES, stream);
    if (e != hipSuccess) fprintf(stderr, "kernel_launch: cooperative launch failed: %s (grid %d)\n", hipGetErrorString(e), grid);
}
```

```cpp
#include <hip/hip_runtime.h>
#include <hip/hip_cooperative_groups.h>
#include <cstdio>
#include <cstdint>
namespace cg = cooperative_groups;


namespace pg8 {
#define PG8_LAS __attribute__((address_space(3)))
typedef unsigned short bf16_t;
typedef short bf16x8 __attribute__((ext_vector_type(8)));
typedef float f32x4 __attribute__((ext_vector_type(4)));
typedef unsigned u32x4 __attribute__((ext_vector_type(4)));
constexpr int BM = 256, BK = 64, HALF = 128, HTB = HALF * BK * 2  , STAGE_BYTES = 8 * HTB, NXCD = 8, WGM = 8;

__host__ __device__ __forceinline__ int lds_byte(int r, int c) { const int st = (r >> 4) * 2 + (c >> 5), rr = r & 15, cc = c & 31, ob = rr * 64 + cc * 2; return st * 1024 + (ob ^ (((ob >> 9) & 1) << 5)); }
__host__ __device__ __forceinline__ void stage_rc(int b, int& R, int& C) { const int st = b / 1024, sb = b % 1024, swz = sb ^ (((sb >> 9) & 1) << 5); R = (st >> 1) * 16 + swz / 64; C = (st & 1) * 32 + (swz % 64) / 2; }
__host__ __device__ __forceinline__ int perm32(int rho) { const int n = rho >> 4, i = rho & 15; return 8 * (i >> 2) + 4 * n + (i & 3); }

struct Unit { int pm, pn; };
struct Gemm { const bf16_t* A; const bf16_t* Bt; int M, N, K, lda; };

struct StaticOrder {
    int nM, nN, nwg, G, c;
    __host__ __device__ void init(int M, int N, int G_, int c_) { nM = M / BM; nN = N / BM; nwg = nM * nN; G = G_; c = c_; }
    __host__ __device__ bool next(int i, Unit& u) const {
        const long L = (long)i * G + c; if (L >= nwg) return false;
        int wgid = (int)L; { const int q = nwg / NXCD, r = nwg % NXCD, xcd = wgid % NXCD, off = wgid / NXCD; wgid = (xcd < r ? xcd * (q + 1) : r * (q + 1) + (xcd - r) * q) + off; }
        const int nig = WGM * nN, gid = wgid / nig, fm = gid * WGM, gsz = (nM - fm) < WGM ? (nM - fm) : WGM;
        u.pm = fm + ((wgid % nig) % gsz); u.pn = (wgid % nig) / gsz; return true;
    }
    __device__ __forceinline__ void a_ready(const Unit&) const {}
    __device__ __forceinline__ void done(const Unit&) const {}
};

__device__ __forceinline__ unsigned cvt_pk_bf16(float lo, float hi) { unsigned r; asm volatile("v_cvt_pk_bf16_f32 %0, %1, %2" : "=v"(r) : "v"(lo), "v"(hi)); return r; }
template <class Epi, class Sched, bool ALIGN_EPI = false, bool SP2 = false>
__device__ __forceinline__ void gemm_phase(PG8_LAS unsigned char* lds, const Gemm g, const Sched& S, const Epi& E) {
    const int tid = threadIdx.x, wid = __builtin_amdgcn_readfirstlane(tid >> 6), lane = tid & 63, wr = wid >> 2, wc = wid & 3, fr = lane & 15, fq = lane >> 4;
    const int K = g.K, nt = K / BK;
    unsigned voffA[2], voffB[2];
#pragma unroll
    for (int i = 0; i < 2; ++i) { int R, C; stage_rc(tid * 16 + i * 8192, R, C); const int Rb = Epi::PERM ? ((R & ~31) + perm32(R & 31)) : R;
        voffA[i] = (unsigned)(R * g.lda + C) * 2u; voffB[i] = (unsigned)(Rb * K + C) * 2u; }
    const size_t kstep = (size_t)(BK * 2);
    const size_t hstepA = (size_t)HALF * g.lda * 2, hstepB = (size_t)HALF * K * 2;
    const size_t tstepA = 2 * hstepA, tstepB = 2 * hstepB;
    const unsigned ldsw = (unsigned)wid * 1024u;
    const int aoff = lds_byte(wr * 64 + fr, fq * 8), boff = lds_byte(wc * 32 + fr, fq * 8);
#define PG8_SA(b, h) (((b) * 2 + (h)) * HTB)
#define PG8_SB(b, h) ((4 + (b) * 2 + (h)) * HTB)
#define PG8_STAGE(bufoff, gbase, voff) do { _Pragma("unroll") for (int _i = 0; _i < 2; ++_i) \
        __builtin_amdgcn_global_load_lds((const unsigned*)((const char*)(gbase) + (voff)[_i]), (PG8_LAS unsigned*)(lds + (bufoff) + ldsw + _i * 8192), 16, 0, 0); } while (0)
#define PG8_LDA(dst, b, h) do { _Pragma("unroll") for (int m = 0; m < 4; ++m) _Pragma("unroll") for (int k = 0; k < 2; ++k) dst[m][k] = *(const PG8_LAS bf16x8*)(lds + PG8_SA(b, h) + aoff + m * 2048 + k * 1024); } while (0)
#define PG8_LDB(dst, b, h) do { _Pragma("unroll") for (int n = 0; n < 2; ++n) _Pragma("unroll") for (int k = 0; k < 2; ++k) dst[n][k] = *(const PG8_LAS bf16x8*)(lds + PG8_SB(b, h) + boff + n * 2048 + k * 1024); } while (0)
#define PG8_MMA(ai, bj, At, Bt) do { __builtin_amdgcn_s_setprio(1); _Pragma("unroll") for (int m = 0; m < 4; ++m) _Pragma("unroll") for (int n = 0; n < 2; ++n) _Pragma("unroll") for (int k = 0; k < 2; ++k) \
        acc[ai][bj][m][n] = __builtin_amdgcn_mfma_f32_16x16x32_bf16(Bt[n][k], At[m][k], acc[ai][bj][m][n], 0, 0, 0); __builtin_amdgcn_s_setprio(0); } while (0)
#define PG8_WAIT_V(n) asm volatile("s_waitcnt vmcnt(" #n ")" ::: "memory")
#define PG8_WAIT_L(n) asm volatile("s_waitcnt lgkmcnt(" #n ")" ::: "memory")
#define PG8_BAR __builtin_amdgcn_s_barrier()
#define PG8_SCHED __builtin_amdgcn_sched_barrier(0)
    Unit cur, nxt; int ui = 0;
    if (!S.next(0, cur)) return;
    f32x4 acc[2][2][4][2];
#pragma unroll
    for (int a = 0; a < 2; ++a)
#pragma unroll
        for (int b = 0; b < 2; ++b)
#pragma unroll
            for (int m = 0; m < 4; ++m)
#pragma unroll
                for (int n = 0; n < 2; ++n) acc[a][b][m][n] = (f32x4){0.f, 0.f, 0.f, 0.f};
    bf16x8 At[4][2], B0[2][2], B1[2][2];
    const char* cA = (const char*)g.A + (size_t)cur.pm * tstepA; const char* cB = (const char*)g.Bt + (size_t)cur.pn * tstepB;
    S.a_ready(cur);
    if constexpr (SP2) {
        PG8_STAGE(PG8_SB(0, 0), cB, voffB); PG8_STAGE(PG8_SB(0, 1), cB + hstepB, voffB); PG8_STAGE(PG8_SA(0, 0), cA, voffA); PG8_STAGE(PG8_SA(0, 1), cA + hstepA, voffA);
        if (wr == 1) PG8_BAR;
        PG8_WAIT_V(2); PG8_BAR;
        PG8_STAGE(PG8_SB(1, 0), cB + kstep, voffB); PG8_STAGE(PG8_SA(1, 0), cA + kstep, voffA); PG8_STAGE(PG8_SB(1, 1), cB + hstepB + kstep, voffB);
        PG8_WAIT_V(6); PG8_BAR;
    } else {
        PG8_STAGE(PG8_SB(0, 0), cB, voffB); PG8_STAGE(PG8_SA(0, 0), cA, voffA); PG8_STAGE(PG8_SB(0, 1), cB + hstepB, voffB); PG8_STAGE(PG8_SA(0, 1), cA + hstepA, voffA);
        if (wr == 1) PG8_BAR;
        PG8_WAIT_V(4); PG8_BAR;
        PG8_STAGE(PG8_SB(1, 0), cB + kstep, voffB); PG8_STAGE(PG8_SA(1, 0), cA + kstep, voffA); PG8_STAGE(PG8_SB(1, 1), cB + hstepB + kstep, voffB);
        PG8_WAIT_V(6); PG8_BAR;
    }
    for (;;) {
        const bool has_next = S.next(ui + 1, nxt);
        const char* nA = has_next ? (const char*)g.A + (size_t)nxt.pm * tstepA : cA; const char* nB = has_next ? (const char*)g.Bt + (size_t)nxt.pn * tstepB : cB;
        for (int t = 0; t < nt; t += 2) {
            const bool last = (t == nt - 2);
            const char* a1 = cA + (size_t)(t + 1) * kstep;
            const char* a2 = last ? nA : cA + (size_t)(t + 2) * kstep; const char* b2 = last ? nB : cB + (size_t)(t + 2) * kstep;
            const char* a3 = a2 + kstep; const char* b3 = b2 + kstep;
            if (last && has_next) S.a_ready(nxt);
            if constexpr (SP2) {
            PG8_LDB(B0, 0, 0); PG8_LDB(B1, 0, 1); PG8_SCHED; PG8_LDA(At, 0, 0); PG8_STAGE(PG8_SA(1, 1), a1 + hstepA, voffA);
            PG8_WAIT_V(8); PG8_WAIT_L(0); PG8_BAR; PG8_MMA(0, 0, At, B0); PG8_MMA(0, 1, At, B1); PG8_BAR; PG8_SCHED;
            PG8_LDA(At, 0, 1); PG8_STAGE(PG8_SB(0, 0), b2, voffB); PG8_STAGE(PG8_SB(0, 1), b2 + hstepB, voffB); PG8_STAGE(PG8_SA(0, 0), a2, voffA);
            PG8_WAIT_V(8); PG8_WAIT_L(0); PG8_BAR; PG8_MMA(1, 0, At, B0); PG8_MMA(1, 1, At, B1); PG8_BAR; PG8_SCHED;
            PG8_LDB(B0, 1, 0); PG8_LDB(B1, 1, 1); PG8_SCHED; PG8_LDA(At, 1, 0); PG8_STAGE(PG8_SA(0, 1), a2 + hstepA, voffA);
            PG8_WAIT_V(8); PG8_WAIT_L(0); PG8_BAR; PG8_MMA(0, 0, At, B0); PG8_MMA(0, 1, At, B1); PG8_BAR; PG8_SCHED;
            PG8_LDA(At, 1, 1); PG8_STAGE(PG8_SB(1, 0), b3, voffB); PG8_STAGE(PG8_SB(1, 1), b3 + hstepB, voffB); PG8_STAGE(PG8_SA(1, 0), a3, voffA);
            PG8_WAIT_V(8); PG8_WAIT_L(0); PG8_BAR; PG8_MMA(1, 0, At, B0); PG8_MMA(1, 1, At, B1); PG8_BAR; PG8_SCHED;
            } else {
            PG8_LDB(B0, 0, 0); PG8_SCHED; PG8_LDA(At, 0, 0); PG8_STAGE(PG8_SA(1, 1), a1 + hstepA, voffA);
            PG8_WAIT_L(8); PG8_BAR; PG8_WAIT_L(0); PG8_MMA(0, 0, At, B0); PG8_BAR; PG8_SCHED;
            PG8_LDB(B1, 0, 1); PG8_STAGE(PG8_SB(0, 0), b2, voffB);
            PG8_BAR; PG8_WAIT_L(0); PG8_MMA(0, 1, At, B1); PG8_BAR;
            PG8_LDA(At, 0, 1); PG8_STAGE(PG8_SA(0, 0), a2, voffA);
            PG8_BAR; PG8_WAIT_L(0); PG8_MMA(1, 0, At, B0); PG8_BAR; PG8_SCHED;
            PG8_STAGE(PG8_SB(0, 1), b2 + hstepB, voffB);
            PG8_WAIT_V(6); PG8_BAR; PG8_MMA(1, 1, At, B1); PG8_BAR;
            PG8_LDB(B0, 1, 0); PG8_SCHED; PG8_LDA(At, 1, 0); PG8_STAGE(PG8_SA(0, 1), a2 + hstepA, voffA);
            PG8_WAIT_L(8); PG8_BAR; PG8_WAIT_L(0); PG8_MMA(0, 0, At, B0); PG8_BAR; PG8_SCHED;
            PG8_LDB(B1, 1, 1); PG8_STAGE(PG8_SB(1, 0), b3, voffB);
            PG8_BAR; PG8_WAIT_L(0); PG8_MMA(0, 1, At, B1); PG8_BAR;
            PG8_LDA(At, 1, 1); PG8_STAGE(PG8_SA(1, 0), a3, voffA);
            PG8_BAR; PG8_WAIT_L(0); PG8_MMA(1, 0, At, B0); PG8_BAR; PG8_SCHED;
            PG8_STAGE(PG8_SB(1, 1), b3 + hstepB, voffB);
            PG8_WAIT_V(6); PG8_BAR; PG8_MMA(1, 1, At, B1); PG8_BAR;
            }
        }
        if constexpr (ALIGN_EPI) { if (wr == 0) PG8_BAR; }
        if constexpr (!Epi::AFTER_DRAIN) { E(acc, cur, wr, wc, fr, fq); S.done(cur); }
        if (!has_next) break;
#pragma unroll
        for (int a = 0; a < 2; ++a)
#pragma unroll
            for (int b = 0; b < 2; ++b)
#pragma unroll
                for (int m = 0; m < 4; ++m)
#pragma unroll
                    for (int n = 0; n < 2; ++n) acc[a][b][m][n] = (f32x4){0.f, 0.f, 0.f, 0.f};
        cur = nxt; cA = nA; cB = nB; ++ui;
        if constexpr (ALIGN_EPI) { if (wr == 1) PG8_BAR; }
    }
    PG8_WAIT_V(0);
    if constexpr (!ALIGN_EPI) { if (wr == 0) PG8_BAR; }
    PG8_BAR;
    if constexpr (Epi::AFTER_DRAIN) { E.fused(acc, cur, wr, wc, fr, fq, lds, wid, lane); S.done(cur); }
#undef PG8_SA
#undef PG8_SB
#undef PG8_STAGE
#undef PG8_LDA
#undef PG8_LDB
#undef PG8_MMA
#undef PG8_WAIT_V
#undef PG8_WAIT_L
#undef PG8_BAR
#undef PG8_SCHED
}
}

#define LAS __attribute__((address_space(3)))
typedef unsigned short bf16;
typedef float f32x4 __attribute__((ext_vector_type(4)));
typedef float f32x2 __attribute__((ext_vector_type(2)));
typedef unsigned u32x4 __attribute__((ext_vector_type(4)));
typedef unsigned u32x2 __attribute__((ext_vector_type(2)));
typedef short bf16x8 __attribute__((ext_vector_type(8)));
typedef short s16x4 __attribute__((ext_vector_type(4)));

constexpr int NTHR = 512, NWAVES = 8;
constexpr int DM = 1024, BATCH = 2, SEQ = 8192, CTXL = 256;
constexpr int ML = BATCH * SEQ, MC = BATCH * CTXL, MT = ML + MC;
constexpr int DFF = 2816, NMODV = 9 * DM, INW = 5632;
constexpr int PLD = 2048;
constexpr int RW_LA = 1536, RW_LB = 1760, RW_Y = 1536;
constexpr int NCH_RET = 66;
constexpr size_t MiB = 1u << 20;
constexpr size_t WS_BAR = 112 * 1024;
constexpr size_t WS_MODV = 0;
constexpr size_t WS_GU1 = 12 * MiB, WS_D1 = 23 * MiB, WS_WIN = WS_D1 + 11 * MiB / 2, WS_WG = WS_WIN + 8 * MiB, WS_RO = WS_WG + 4 * MiB, WS_RWO = WS_RO + MiB,
                 WS_WOUT = WS_RWO + MiB, WS_GU2 = WS_WOUT + 2 * MiB, WS_D2 = WS_GU2 + 11 * MiB, WS_U = WS_D2 + 11 * MiB / 2;
static_assert(WS_U == 61 * MiB, "ws map");
constexpr size_t WS_HC = WS_U + 33 * MiB, WS_BIG = WS_HC + 2 * MiB;
constexpr size_t WS_ACT = WS_BIG, WS_PRET = WS_BIG, WS_PRW = WS_BIG + 66 * MiB, WS_Y1 = WS_BIG + 132 * MiB;
constexpr size_t WS_RETKV = WS_U;
constexpr size_t WS_INVN = WS_GU1, WS_HW = WS_INVN + 3 * MiB / 4, WS_HA = WS_HW + 17 * MiB / 4, WS_HG = WS_HA + 17 * MiB / 4;
static_assert(WS_HG + (size_t)MT * 96 * 4 <= WS_WIN, "small arrays");
static_assert(WS_Y1 + (size_t)ML * 512 * 2 <= 256 * MiB, "ws end");

struct Params { const float* in[36]; float* out; unsigned char* ws; int ph_lo, ph_hi; };

__device__ __forceinline__ unsigned f2bf(float f) { unsigned u = __float_as_uint(f); return (u + 0x7fffu + ((u >> 16) & 1u)) >> 16; }
__device__ __forceinline__ unsigned pk2(float lo, float hi) { return f2bf(lo) | (f2bf(hi) << 16); }
__device__ __forceinline__ float bflo(unsigned w) { return __uint_as_float(w << 16); }
__device__ __forceinline__ float bfhi(unsigned w) { return __uint_as_float(w & 0xffff0000u); }
__device__ __forceinline__ float bf1(bf16 h) { return __uint_as_float((unsigned)h << 16); }
__device__ __forceinline__ float sigmoidf_(float x) { return __builtin_amdgcn_rcpf(1.0f + __expf(-x)); }
__device__ __forceinline__ float wave_sum(float v) {
#pragma unroll
    for (int o = 1; o < 64; o <<= 1) v += __shfl_xor(v, o);
    return v;
}
template <int CTRL> __device__ __forceinline__ float dpp_add(float v) { return v + __int_as_float(__builtin_amdgcn_update_dpp(0, __float_as_int(v), CTRL, 0xF, 0xF, true)); }
__device__ __forceinline__ float sum4(float v) { v = dpp_add<0xB1>(v); v = dpp_add<0x4E>(v); return v; }
__device__ __forceinline__ float sum8(float v) { v = sum4(v); v = dpp_add<0x141>(v); return v; }
__device__ __forceinline__ float sum16(float v) { v = sum8(v); v = dpp_add<0x140>(v); return v; }
__device__ __forceinline__ int mod_set(int R) { return R < SEQ ? 0 : (R < ML ? 1 : 2); }
__device__ __forceinline__ bool has_prev(int R) { return R < ML ? (R & (SEQ - 1)) != 0 : ((R - ML) & (CTXL - 1)) != 0; }
__device__ __forceinline__ bool has_next(int R) { return R < ML ? (R & (SEQ - 1)) != SEQ - 1 : ((R - ML) & (CTXL - 1)) != CTXL - 1; }


#define GAS __attribute__((address_space(1)))
#define XB_TMO      128
#define XB_XCNT(j)  (256  + 64 * (j))
#define XB_XSUB(j)  (1280 + 64 * (j))
#define XB_XGEN(j)  (2304 + 64 * (j))
#define XB_TOP      3328
#define XB_TOPGEN   3392
#define XCD_BAR_WORDS 3456
#define XB_SPIN_CAP (1u << 18)

__device__ __forceinline__ unsigned xb_ld(unsigned* p)              { return __hip_atomic_load(p, __ATOMIC_RELAXED, __HIP_MEMORY_SCOPE_AGENT); }
__device__ __forceinline__ unsigned xb_add(unsigned* p, unsigned v) { return __hip_atomic_fetch_add(p, v, __ATOMIC_RELAXED, __HIP_MEMORY_SCOPE_AGENT); }
__device__ __forceinline__ unsigned xb_xcc_id() { return (unsigned)__builtin_amdgcn_s_getreg((3 << 11) | 20) & 0xFu; }
#define XB_SPIN(cond, bar) do { unsigned _sp = 0; while (cond) { __builtin_amdgcn_s_sleep(1); \
    if ((++_sp & 255u) == 0u) { if (xb_ld(&(bar)[XB_TMO])) break; if (_sp > XB_SPIN_CAP) { atomicAdd(&(bar)[XB_TMO], 1u); break; } } } } while (0)

struct XcdBarrier {
    unsigned* bar; unsigned x;
    volatile LAS unsigned* st;
};

__device__ __forceinline__ XcdBarrier xcd_barrier_post(unsigned* bar, volatile LAS unsigned* st) {
    XcdBarrier b; b.bar = bar; b.x = xb_xcc_id(); b.st = st;
    if (threadIdx.x == 0) (void)xb_add(&bar[XB_XCNT(b.x)], 1u);
    return b;
}
__device__ __forceinline__ void xcd_barrier_complete(unsigned* bar, unsigned x, unsigned& nloc, unsigned& nx) {
    const unsigned G = gridDim.x * gridDim.y * gridDim.z;
    unsigned sum, cnt, mine, sp = 0u;
    for (;;) {
        sum = 0u; cnt = 0u; mine = 0u;
#pragma unroll
        for (unsigned j = 0; j < 16; ++j) { const unsigned c = xb_ld(&bar[XB_XCNT(j)]); sum += c; cnt += (c > 0u) ? 1u : 0u; mine = (j == x) ? c : mine; }
        if (sum == G) break;
        __builtin_amdgcn_s_sleep(1);
        if ((++sp & 255u) == 0u) { if (xb_ld(&bar[XB_TMO])) break; if (sp > XB_SPIN_CAP) { atomicAdd(&bar[XB_TMO], 1u); break; } }
    }
    nloc = mine > 0u ? mine : 1u; nx = cnt > 0u ? cnt : 1u;
}

__device__ __forceinline__ void xcd_barrier(const XcdBarrier& b) {
    asm volatile("s_waitcnt vmcnt(0)" ::: "memory");
    __syncthreads();
    if (threadIdx.x == 0) {
        unsigned* bar = b.bar;
        __builtin_amdgcn_s_waitcnt(0);
        unsigned nloc = b.st[0], nx = b.st[1];
        if (nloc == 0u) { xcd_barrier_complete(bar, b.x, nloc, nx); b.st[0] = nloc; b.st[1] = nx; }
        const unsigned old = xb_add(&bar[XB_XSUB(b.x)], 1u);
        const unsigned gen = old / nloc;
        if (old + 1u == (gen + 1u) * nloc) {
            __builtin_amdgcn_fence(__ATOMIC_RELEASE, "agent");
            asm volatile("s_waitcnt vmcnt(0)" ::: "memory");
            const unsigned og = xb_add(&bar[XB_TOP], 1u);
            const unsigned tg = og / nx;
            if (og + 1u == (tg + 1u) * nx) xb_add(&bar[XB_TOPGEN], 1u);
            else XB_SPIN(xb_ld(&bar[XB_TOPGEN]) == tg, bar);
            __builtin_amdgcn_fence(__ATOMIC_ACQUIRE, "agent");
            xb_add(&bar[XB_XGEN(b.x)], 1u);
            asm volatile("s_waitcnt vmcnt(0)" ::: "memory");
        } else {
            XB_SPIN(xb_ld(&bar[XB_XGEN(b.x)]) == gen, bar);
            __builtin_amdgcn_fence(__ATOMIC_ACQUIRE, "agent");
            asm volatile("s_waitcnt vmcnt(0)" ::: "memory");
        }
    }
    __syncthreads();
}

using pg8::Unit;
struct EpiSwiGLU {
    static constexpr bool PERM = true, AFTER_DRAIN = false;
    bf16* O; int ldo;
    __device__ __forceinline__ void operator()(const f32x4 (&acc)[2][2][4][2], const Unit& u, int wr, int wc, int fr, int fq) const {
        const int row0 = u.pm * 256 + wr * 64 + fr, col0 = u.pn * 128 + wc * 32 + 8 * fq;
#pragma unroll
        for (int ai = 0; ai < 2; ++ai)
#pragma unroll
            for (int m = 0; m < 4; ++m) {
                bf16* rowp = O + (size_t)(row0 + ai * 128 + m * 16) * ldo + col0;
                float v[8];
#pragma unroll
                for (int n = 0; n < 2; ++n)
#pragma unroll
                    for (int i = 0; i < 4; ++i) { const float g = acc[ai][0][m][n][i], up = acc[ai][1][m][n][i]; v[4 * n + i] = g * sigmoidf_(g) * up; }
                u32x4 w; w.x = pg8::cvt_pk_bf16(v[0], v[1]); w.y = pg8::cvt_pk_bf16(v[2], v[3]); w.z = pg8::cvt_pk_bf16(v[4], v[5]); w.w = pg8::cvt_pk_bf16(v[6], v[7]);
                *(u32x4*)rowp = w;
            }
    }
};
struct EpiResid {
    static constexpr bool PERM = false, AFTER_DRAIN = false;
    const float* base_lat; const float* base_ctx; float* out_lat; float* out_ctx; const float* modv; int modoff; float sc;
    __device__ __forceinline__ void operator()(const f32x4 (&acc)[2][2][4][2], const Unit& u, int wr, int wc, int fr, int fq) const {
        const bool isc = u.pm >= 64; const int pml = isc ? u.pm - 64 : u.pm;
        const float* base = isc ? base_ctx : base_lat; float* out = isc ? out_ctx : out_lat;
        const float* gate = modv + (isc ? 2 : (u.pm >= 32 ? 1 : 0)) * NMODV + modoff;
        const int col0 = u.pn * 256 + wc * 32 + 4 * fq;
        f32x4 gv[2][2];
#pragma unroll
        for (int bj = 0; bj < 2; ++bj)
#pragma unroll
            for (int n = 0; n < 2; ++n) gv[bj][n] = *(const f32x4*)(gate + col0 + bj * 128 + n * 16) * sc;
#pragma unroll
        for (int ai = 0; ai < 2; ++ai)
#pragma unroll
            for (int m = 0; m < 4; ++m) {
                const size_t off = (size_t)(pml * 256 + ai * 128 + wr * 64 + m * 16 + fr) * DM + col0;
#pragma unroll
                for (int bj = 0; bj < 2; ++bj)
#pragma unroll
                    for (int n = 0; n < 2; ++n) { const f32x4 b = *(const f32x4*)(base + off + bj * 128 + n * 16); *(f32x4*)(out + off + bj * 128 + n * 16) = b + gv[bj][n] * acc[ai][bj][m][n]; }
                asm volatile("" ::: "memory");
            }
    }
};
template <int MODE, bool SPLIT> struct EpiB {
    static constexpr bool PERM = true, AFTER_DRAIN = false;
    bf16* O; bf16* O2; const bf16* X; int ld;
    __device__ __forceinline__ void operator()(const f32x4 (&acc)[2][2][4][2], const Unit& u, int wr, int wc, int fr, int fq) const {
        int pn = u.pn; bf16* Ob = O; if (SPLIT && pn >= 8) { pn -= 8; Ob = O2; }
        const int row0 = u.pm * 256 + wr * 64 + fr, col0 = pn * 256 + wc * 32 + 8 * fq;
#pragma unroll
        for (int ai = 0; ai < 2; ++ai)
#pragma unroll
            for (int m = 0; m < 4; ++m) {
                const size_t off = (size_t)(row0 + ai * 128 + m * 16) * ld + col0;
#pragma unroll
                for (int bj = 0; bj < 2; ++bj) {
                    float v[8];
#pragma unroll
                    for (int n = 0; n < 2; ++n)
#pragma unroll
                        for (int i = 0; i < 4; ++i) v[4 * n + i] = acc[ai][bj][m][n][i];
                    if (MODE == 1) { const u32x4 o = *(const u32x4*)(Ob + off + bj * 128);
                        const unsigned ow[4] = {o.x, o.y, o.z, o.w};
#pragma unroll
                        for (int i = 0; i < 4; ++i) { v[2 * i] = sigmoidf_(v[2 * i]) * bflo(ow[i]); v[2 * i + 1] = sigmoidf_(v[2 * i + 1]) * bfhi(ow[i]); } }
                    if (MODE == 2) { const u32x4 o = *(const u32x4*)(Ob + off + bj * 128); const u32x4 x = *(const u32x4*)(X + off + bj * 128);
                        const unsigned ow[4] = {o.x, o.y, o.z, o.w}, xw[4] = {x.x, x.y, x.z, x.w};
#pragma unroll
                        for (int i = 0; i < 4; ++i) { v[2 * i] = bflo(ow[i]) + sigmoidf_(v[2 * i]) * bflo(xw[i]); v[2 * i + 1] = bfhi(ow[i]) + sigmoidf_(v[2 * i + 1]) * bfhi(xw[i]); } }
                    u32x4 w; w.x = pg8::cvt_pk_bf16(v[0], v[1]); w.y = pg8::cvt_pk_bf16(v[2], v[3]); w.z = pg8::cvt_pk_bf16(v[4], v[5]); w.w = pg8::cvt_pk_bf16(v[6], v[7]);
                    *(u32x4*)(Ob + off + bj * 128) = w;
                }
                asm volatile("" ::: "memory");
            }
    }
};

__device__ __forceinline__ void tr_item(const float* W, int ldw, int K, int c0, int kb, bf16* WT, int drow, const float* mu, float sa, float sb, LAS float* scr, int lane) {
    const int k0 = 64 * kb;
#pragma unroll 8
    for (int i = 0; i < 32; ++i) { const int kk = 2 * i + (lane >> 5); float v = W[(size_t)(k0 + kk) * ldw + c0 + (lane & 31)]; if (mu) v *= sa + sb * mu[k0 + kk]; scr[kk * 33 + (lane & 31)] = v; }
    asm volatile("s_waitcnt lgkmcnt(0)" ::: "memory");
    const int c = lane & 7;
#pragma unroll
    for (int j = 0; j < 4; ++j) { const int n = (lane >> 3) + 8 * j; const LAS float* s = scr + (8 * c) * 33 + n;
        u32x4 o; o.x = pk2(s[0 * 33], s[1 * 33]); o.y = pk2(s[2 * 33], s[3 * 33]); o.z = pk2(s[4 * 33], s[5 * 33]); o.w = pk2(s[6 * 33], s[7 * 33]);
        *(u32x4*)(WT + (size_t)(drow + n) * K + k0 + 8 * c) = o; }
    asm volatile("s_waitcnt lgkmcnt(0)" ::: "memory");
}
struct TrJob { const float* W; int ldw, K, c0, nc; bf16* WT; int mode, r0; const float* mu; float sa, sb; };
constexpr int NTRJOB = 21;
__device__ __forceinline__ TrJob tr_job(int j, const Params& p) {
    unsigned char* ws = p.ws; TrJob J; J.mu = nullptr; J.sa = 1.f; J.sb = 0.f; J.mode = 0; J.r0 = 0; J.c0 = 0;
    const float* mux = p.in[15];
    switch (j) {
    case 0: J.W = p.in[7]; J.ldw = DFF; J.K = DM; J.nc = DFF; J.WT = (bf16*)(ws + WS_GU1); J.mode = 1; break;
    case 1: J.W = p.in[8]; J.ldw = DFF; J.K = DM; J.nc = DFF; J.WT = (bf16*)(ws + WS_GU1); J.mode = 2; break;
    case 2: J.W = p.in[9]; J.ldw = DM; J.K = DFF; J.nc = DM; J.WT = (bf16*)(ws + WS_D1); break;
    case 3: J.W = p.in[11]; J.ldw = INW; J.K = DM; J.nc = 3584; J.WT = (bf16*)(ws + WS_WIN); break;
    case 4: J.W = p.in[11]; J.ldw = INW; J.K = DM; J.c0 = 3584; J.nc = 2048; J.WT = (bf16*)(ws + WS_WG); break;
    case 5: J.W = p.in[17]; J.ldw = 32; J.K = DM; J.nc = 32; J.WT = (bf16*)(ws + WS_WIN); J.r0 = 3584; J.mu = mux; J.sa = 1.f; J.sb = -1.f; break;
    case 6: J.W = p.in[17] + DM * 32; J.ldw = 32; J.K = DM; J.nc = 32; J.WT = (bf16*)(ws + WS_WIN); J.r0 = 3616; J.mu = mux; J.sa = 1.f; J.sb = -1.f; break;
    case 7: J.W = p.in[20]; J.ldw = 32; J.K = DM; J.nc = 32; J.WT = (bf16*)(ws + WS_WIN); J.r0 = 3648; J.mu = mux + DM; J.sa = 1.f; J.sb = -1.f; break;
    case 8: J.W = p.in[20] + DM * 32; J.ldw = 32; J.K = DM; J.nc = 32; J.WT = (bf16*)(ws + WS_WIN); J.r0 = 3680; J.mu = mux + DM; J.sa = 1.f; J.sb = -1.f; break;
    case 9: J.W = p.in[22]; J.ldw = 96; J.K = DM; J.nc = 96; J.WT = (bf16*)(ws + WS_WIN); J.r0 = 3712; J.mu = mux + 2 * DM; J.sa = 1.f; J.sb = -1.f; break;
    case 10: J.W = p.in[17]; J.ldw = 32; J.K = DM; J.nc = 32; J.WT = (bf16*)(ws + WS_WIN); J.r0 = 3808; J.mu = mux; J.sa = 0.f; J.sb = 1.f; break;
    case 11: J.W = p.in[17] + DM * 32; J.ldw = 32; J.K = DM; J.nc = 32; J.WT = (bf16*)(ws + WS_WIN); J.r0 = 3840; J.mu = mux; J.sa = 0.f; J.sb = 1.f; break;
    case 12: J.W = p.in[20]; J.ldw = 32; J.K = DM; J.nc = 32; J.WT = (bf16*)(ws + WS_WIN); J.r0 = 3872; J.mu = mux + DM; J.sa = 0.f; J.sb = 1.f; break;
    case 13: J.W = p.in[20] + DM * 32; J.ldw = 32; J.K = DM; J.nc = 32; J.WT = (bf16*)(ws + WS_WIN); J.r0 = 3904; J.mu = mux + DM; J.sa = 0.f; J.sb = 1.f; break;
    case 14: J.W = p.in[22]; J.ldw = 96; J.K = DM; J.nc = 96; J.WT = (bf16*)(ws + WS_WIN); J.r0 = 3936; J.mu = mux + 2 * DM; J.sa = 0.f; J.sb = 1.f; break;
    case 15: J.W = p.in[13]; J.ldw = DM; J.K = 512; J.nc = DM; J.WT = (bf16*)(ws + WS_RO); break;
    case 16: J.W = p.in[29]; J.ldw = DM; J.K = 512; J.nc = DM; J.WT = (bf16*)(ws + WS_RWO); break;
    case 17: J.W = p.in[30]; J.ldw = DM; J.K = DM; J.nc = DM; J.WT = (bf16*)(ws + WS_WOUT); break;
    case 18: J.W = p.in[32]; J.ldw = DFF; J.K = DM; J.nc = DFF; J.WT = (bf16*)(ws + WS_GU2); J.mode = 1; break;
    case 19: J.W = p.in[33]; J.ldw = DFF; J.K = DM; J.nc = DFF; J.WT = (bf16*)(ws + WS_GU2); J.mode = 2; break;
    default: J.W = p.in[34]; J.ldw = DM; J.K = DFF; J.nc = DM; J.WT = (bf16*)(ws + WS_D2); break;
    }
    return J;
}
__device__ __forceinline__ void p0_weights(const Params& p, LAS unsigned char* lds, int wave, int lane, int j0, int j1) {
    LAS float* scr = (LAS float*)(lds + wave * 16384);
    const int gw = blockIdx.x * NWAVES + wave, NGW = gridDim.x * NWAVES;
    int base = 0;
    for (int j = j0; j < j1; ++j) {
        const TrJob J = tr_job(j, p);
        const int nnb = J.nc / 32, nit = (J.K / 64) * nnb;
        int it = gw - (base % NGW); if (it < 0) it += NGW;
        for (; it < nit; it += NGW) {
            const int kb = it / nnb, nb = it % nnb, n0 = 32 * nb;
            const int drow = J.mode == 0 ? J.r0 + n0 : ((n0 >> 7) * 256 + (n0 & 127) + (J.mode == 2 ? 128 : 0));
            tr_item(J.W, J.ldw, J.K, J.c0 + n0, kb, J.WT, drow, J.mu, J.sa, J.sb, scr, lane);
        }
        base += nit;
    }
    if (j0 == 0) { u32x4* z = (u32x4*)((bf16*)(p.ws + WS_WIN) + (size_t)4032 * DM); const int n16 = 64 * DM * 2 / 16;
      for (int i = blockIdx.x * NTHR + threadIdx.x; i < n16; i += gridDim.x * NTHR) z[i] = (u32x4){0u, 0u, 0u, 0u}; }
}
__device__ __forceinline__ void p0_modv(const Params& p, LAS unsigned char* lds) {
    const float* c = p.in[1]; const float* cc = p.in[3]; const float* wm = p.in[4]; const float* bm = p.in[5];
    float* modv = (float*)(p.ws + WS_MODV);
    LAS float* red = (LAS float*)lds;
    const int tid = threadIdx.x, cl = tid & 15, kg = tid >> 4;
    for (int it = blockIdx.x; it < NMODV / 64; it += gridDim.x) {
        const int n0 = it * 64 + 4 * cl;
        f32x4 a0 = {0.f, 0.f, 0.f, 0.f}, a1 = a0, a2 = a0;
#pragma unroll 4
        for (int i = 0; i < 32; ++i) { const int k = kg * 32 + i; const f32x4 w = *(const f32x4*)(wm + (size_t)k * NMODV + n0);
            const float x0 = c[k], x1 = c[DM + k], x2 = cc[k];
            a0 += w * (x0 * sigmoidf_(x0)); a1 += w * (x1 * sigmoidf_(x1)); a2 += w * (x2 * sigmoidf_(x2)); }
        *(LAS f32x4*)(red + (kg * 3 + 0) * 64 + 4 * cl) = a0; *(LAS f32x4*)(red + (kg * 3 + 1) * 64 + 4 * cl) = a1; *(LAS f32x4*)(red + (kg * 3 + 2) * 64 + 4 * cl) = a2;
        __syncthreads();
        if (tid < 192) { const int s = tid >> 6, col = tid & 63; float v = bm[it * 64 + col];
            for (int g = 0; g < 32; ++g) v += red[(g * 3 + s) * 64 + col];
            modv[s * NMODV + it * 64 + col] = v; }
        __syncthreads();
    }
}
__device__ __forceinline__ void norm_rows(const float* hl, const float* hc, const float* g, const float* modv, int shift_off, int scale_off, bf16* U, int nrows, int wave, int lane) {
    const int gw = blockIdx.x * NWAVES + wave, NGW = gridDim.x * NWAVES;
    for (int R = gw; R < nrows; R += NGW) {
        const float* xr = (R < ML ? hl + (size_t)R * DM : hc + (size_t)(R - ML) * DM) + 4 * lane;
        f32x4 v[4]; float s = 0.f;
#pragma unroll
        for (int j = 0; j < 4; ++j) { v[j] = *(const f32x4*)(xr + 256 * j); s += (v[j].x * v[j].x + v[j].y * v[j].y) + (v[j].z * v[j].z + v[j].w * v[j].w); }
        const float rstd = 1.0f / sqrtf(wave_sum(s) * (1.0f / DM) + 1e-6f);
        const float* mv = modv + mod_set(R) * NMODV;
        u32x2* o = (u32x2*)(U + (size_t)R * DM + 4 * lane);
#pragma unroll
        for (int j = 0; j < 4; ++j) { const int col = 4 * lane + 256 * j; const f32x4 gg = *(const f32x4*)(g + col), sh = *(const f32x4*)(mv + shift_off + col), sc = *(const f32x4*)(mv + scale_off + col);
            const f32x4 y = (v[j] * rstd) * gg * (sc + 1.0f) + sh; u32x2 w; w.x = pk2(y.x, y.y); w.y = pk2(y.z, y.w); o[64 * j] = w; }
    }
}

__device__ __forceinline__ void p6_token_prep(const Params& p, int wave, int lane) {
    bf16* pret = (bf16*)(p.ws + WS_PRET); const bf16* prw = (const bf16*)(p.ws + WS_PRW);
    float* INVN = (float*)(p.ws + WS_INVN); float* HW = (float*)(p.ws + WS_HW); float* HA = (float*)(p.ws + WS_HA); float* HG = (float*)(p.ws + WS_HG);
    const float* mu_k = p.in[14] + 512; const float* k_k = p.in[24];
    const int gw = blockIdx.x * NWAVES + wave, NGW = gridDim.x * NWAVES;
    for (int R = gw; R < MT; R += NGW) {
        {
            const int P0 = 8 * lane, T = P0 >> 8, hd = (P0 >> 6) & 3, s = (P0 >> 5) & 1, i0 = P0 & 31;
            bf16* z1p = pret + (size_t)R * PLD + T * 512 + hd * 128 + s * 64 + i0;
            const u32x4 a = *(const u32x4*)z1p, b = *(const u32x4*)(z1p + 32);
            const unsigned aw[4] = {a.x, a.y, a.z, a.w}, bw[4] = {b.x, b.y, b.z, b.w};
            float z1[8], z2[8], o1[8], o2[8];
#pragma unroll
            for (int e = 0; e < 4; ++e) { z1[2 * e] = bflo(aw[e]); z1[2 * e + 1] = bfhi(aw[e]); z2[2 * e] = bflo(bw[e]); z2[2 * e + 1] = bfhi(bw[e]); }
            const bool lat = R < ML; const int t = R & (SEQ - 1); const float pos = (float)(s == 0 ? (t >> 6) : (t & 63));
            const float ksc = T == 1 ? 0.08838834764831845f : 1.0f;
#pragma unroll
            for (int e = 0; e < 8; ++e) {
                float cs = 1.f, sn = 0.f;
                if (lat) { const float inv = exp2f(-(float)(i0 + e) * 0.4152410118609203f); const float rev = pos * inv * 0.15915494309189535f; sn = __builtin_amdgcn_sinf(rev); cs = __builtin_amdgcn_cosf(rev); }
                o1[e] = (z1[e] * cs - z2[e] * sn) * ksc; o2[e] = (z1[e] * sn + z2[e] * cs) * ksc;
            }
            u32x4 w1, w2; w1.x = pk2(o1[0], o1[1]); w1.y = pk2(o1[2], o1[3]); w1.z = pk2(o1[4], o1[5]); w1.w = pk2(o1[6], o1[7]);
            w2.x = pk2(o2[0], o2[1]); w2.y = pk2(o2[2], o2[3]); w2.z = pk2(o2[4], o2[5]); w2.w = pk2(o2[6], o2[7]);
            *(u32x4*)z1p = w1; *(u32x4*)(z1p + 32) = w2;
        }
        const bool hp = has_prev(R), hn = has_next(R);
        const bf16* row = prw + (size_t)R * PLD; const bf16* rowp = row - PLD; const bf16* rown = row + PLD;
#pragma unroll
        for (int jj = 0; jj < 4; ++jj) { const int j = lane + 64 * jj;
            if (j < 224) { const float la = bf1(row[RW_LA + j]); const float lp = hp ? bf1(rowp[RW_LB + j]) : 0.f, ln = hn ? bf1(rown[RW_LB + j]) : 0.f;
                const float hv = la + 0.5f * (lp + ln);
                if (j < 64) HW[((size_t)(j >> 5) * MT + R) * 32 + (j & 31)] = 1.0f - 2.0f * __builtin_amdgcn_rcpf(__expf(2.0f * hv) + 1.0f);
                else if (j < 128) HA[((size_t)((j - 64) >> 5) * MT + R) * 32 + ((j - 64) & 31)] = hv;
                else HG[(size_t)R * 96 + (j - 128)] = sigmoidf_(hv); } }
        {
            const u32x4 kc = *(const u32x4*)(row + 512 + 8 * lane); u32x4 kp = {0u, 0u, 0u, 0u}, kn = {0u, 0u, 0u, 0u};
            if (hp) kp = *(const u32x4*)(rowp + 512 + 8 * lane); if (hn) kn = *(const u32x4*)(rown + 512 + 8 * lane);
            const unsigned cw[4] = {kc.x, kc.y, kc.z, kc.w}, pw[4] = {kp.x, kp.y, kp.z, kp.w}, nw[4] = {kn.x, kn.y, kn.z, kn.w};
            float ss = 0.f;
#pragma unroll
            for (int e = 0; e < 8; ++e) { const int c = 8 * lane + e; const float kcv = (e & 1) ? bfhi(cw[e >> 1]) : bflo(cw[e >> 1]), kpv = (e & 1) ? bfhi(pw[e >> 1]) : bflo(pw[e >> 1]), knv = (e & 1) ? bfhi(nw[e >> 1]) : bflo(nw[e >> 1]);
                const float k = kcv + mu_k[c] * (0.5f * (kpv + knv) - kcv); const float kr = k * k_k[c]; ss += kr * kr; }
            ss = sum8(ss);
            if ((lane & 7) == 0) INVN[(size_t)R * 8 + (lane >> 3)] = 1.0f / fmaxf(sqrtf(ss), 1e-12f);
        }
    }
}

__device__ __forceinline__ float ret_loggamma(const Params& p, int d, int h) { const float x = p.in[12][d * 4 + h]; return -log1pf(expf(-x)); }
__device__ __forceinline__ bf16x8 ld8(const bf16* ptr) { return *(const bf16x8*)ptr; }
__device__ __forceinline__ void ret_kv_local(const Params& p, LAS unsigned char* lds, int wave, int lane) {
    const bf16* pret = (const bf16*)(p.ws + WS_PRET); bf16* KV = (bf16*)(p.ws + WS_RETKV);
    LAS bf16* KT = (LAS bf16*)lds; LAS bf16* VT0 = KT + 128 * 136; LAS bf16* VT1 = VT0 + 128 * 136;
    const int tid = threadIdx.x, i16 = lane & 15, q = lane >> 4;
    for (int it = blockIdx.x; it < 2 * 4 * NCH_RET; it += gridDim.x) {
        const int cc = it % NCH_RET, h = (it / NCH_RET) & 3, b = it / (NCH_RET * 4);
        const int R0 = cc < 2 ? ML + b * CTXL + cc * 128 : b * SEQ + (cc - 2) * 128;
        const float l0 = ret_loggamma(p, 0, h) * 1.4426950408889634f, l1 = ret_loggamma(p, 1, h) * 1.4426950408889634f;
        __syncthreads();
#pragma unroll
        for (int i = 0; i < 4; ++i) { const int idx = tid + NTHR * i, tok = idx & 127, c8 = idx >> 7;
            const bf16* rp = pret + (size_t)(R0 + tok) * PLD + h * 128 + 8 * c8;
            const u32x4 kk = *(const u32x4*)(rp + 512), vv = *(const u32x4*)(rp + 1024);
            const unsigned kw[4] = {kk.x, kk.y, kk.z, kk.w}, vw[4] = {vv.x, vv.y, vv.z, vv.w};
            const float w0 = exp2f(l0 * (float)(127 - tok)), w1 = exp2f(l1 * (float)tok);
#pragma unroll
            for (int e = 0; e < 8; ++e) { const unsigned ke = (e & 1) ? (kw[e >> 1] >> 16) : (kw[e >> 1] & 0xffffu); const float ve = (e & 1) ? bfhi(vw[e >> 1]) : bflo(vw[e >> 1]);
                KT[(8 * c8 + e) * 136 + tok] = (bf16)ke; VT0[(8 * c8 + e) * 136 + tok] = (bf16)f2bf(ve * w0); VT1[(8 * c8 + e) * 136 + tok] = (bf16)f2bf(ve * w1); } }
        __syncthreads();
#pragma unroll
        for (int d = 0; d < 2; ++d) {
            const LAS bf16* VT = d ? VT1 : VT0;
            f32x4 acc[8];
#pragma unroll
            for (int ct = 0; ct < 8; ++ct) acc[ct] = (f32x4){0.f, 0.f, 0.f, 0.f};
#pragma unroll
            for (int ks = 0; ks < 4; ++ks) {
                const bf16x8 af = *(const LAS bf16x8*)(VT + (16 * wave + i16) * 136 + 32 * ks + 8 * q);
#pragma unroll
                for (int ct = 0; ct < 8; ++ct) { const bf16x8 bfr = *(const LAS bf16x8*)(KT + (16 * ct + i16) * 136 + 32 * ks + 8 * q);
                    acc[ct] = __builtin_amdgcn_mfma_f32_16x16x32_bf16(bfr, af, acc[ct], 0, 0, 0); }
            }
            bf16* o = KV + ((size_t)(((b * 4 + h) * 2 + d) * NCH_RET + cc) * 128 + 16 * wave + i16) * 128 + 4 * q;
#pragma unroll
            for (int ct = 0; ct < 8; ++ct) { u32x2 w; w.x = pk2(acc[ct][0], acc[ct][1]); w.y = pk2(acc[ct][2], acc[ct][3]); *(u32x2*)(o + 16 * ct) = w; }
        }
    }
}
__device__ __forceinline__ void ret_scan(const Params& p) {
    bf16* KV = (bf16*)(p.ws + WS_RETKV);
    for (int idx = blockIdx.x * NTHR + threadIdx.x; idx < 2 * 4 * 2 * 16384; idx += gridDim.x * NTHR) {
        const int e = idx & 16383, d = (idx >> 14) & 1, h = (idx >> 15) & 3, b = idx >> 17;
        const float dec = expf(128.0f * ret_loggamma(p, d, h));
        bf16* base = KV + (size_t)(((b * 4 + h) * 2 + d) * NCH_RET) * 16384 + e;
        float st = 0.f;
#pragma unroll 1
        for (int s0 = 0; s0 < NCH_RET; s0 += 22) {
            float t[22];
#pragma unroll
            for (int j = 0; j < 22; ++j) { const int s = s0 + j, cc = d == 0 ? s : (s < 2 ? 1 - s : NCH_RET + 1 - s); t[j] = bf1(base[(size_t)cc * 16384]); }
#pragma unroll
            for (int j = 0; j < 22; ++j) { const int s = s0 + j, cc = d == 0 ? s : (s < 2 ? 1 - s : NCH_RET + 1 - s); base[(size_t)cc * 16384] = (bf16)f2bf(st); st = dec * st + t[j]; }
        }
    }
}
__device__ __forceinline__ void ret_out(const Params& p, LAS unsigned char* lds, int wave, int lane, int first, int nblk) {
    bf16* pret = (bf16*)(p.ws + WS_PRET); const bf16* KV = (const bf16*)(p.ws + WS_RETKV);
    LAS bf16* VT = (LAS bf16*)lds;
    const int tid = threadIdx.x, i16 = lane & 15, q = lane >> 4;
    for (int it = (int)blockIdx.x - first; it < 2 * 4 * 64; it += nblk) {
        const int c = it & 63, h = (it >> 6) & 3, b = it >> 8;
        const int R0 = b * SEQ + c * 128;
        const float l0 = ret_loggamma(p, 0, h) * 1.4426950408889634f, l1 = ret_loggamma(p, 1, h) * 1.4426950408889634f;
        __syncthreads();
#pragma unroll
        for (int i = 0; i < 4; ++i) { const int idx = tid + NTHR * i, tok = idx & 127, c8 = idx >> 7;
            const u32x4 vv = *(const u32x4*)(pret + (size_t)(R0 + tok) * PLD + 1024 + h * 128 + 8 * c8);
            const unsigned vw[4] = {vv.x, vv.y, vv.z, vv.w};
#pragma unroll
            for (int e = 0; e < 8; ++e) VT[(8 * c8 + e) * 136 + tok] = (bf16)((e & 1) ? (vw[e >> 1] >> 16) : (vw[e >> 1] & 0xffffu)); }
        __syncthreads();
        const int tk = 16 * wave + i16;
        bf16* qrow = pret + (size_t)(R0 + tk) * PLD + h * 128;
        bf16x8 aq[4];
#pragma unroll
        for (int ks = 0; ks < 4; ++ks) aq[ks] = ld8(qrow + 32 * ks + 8 * q);
        bf16x8 pf[4];
        {
            f32x4 sacc[8];
#pragma unroll
            for (int ct = 0; ct < 8; ++ct) { sacc[ct] = (f32x4){0.f, 0.f, 0.f, 0.f};
                const bf16* krow = pret + (size_t)(R0 + 16 * ct + i16) * PLD + 512 + h * 128 + 8 * q;
#pragma unroll
                for (int ks = 0; ks < 4; ++ks) sacc[ct] = __builtin_amdgcn_mfma_f32_16x16x32_bf16(ld8(krow + 32 * ks), aq[ks], sacc[ct], 0, 0, 0); }
#pragma unroll
            for (int ct = 0; ct < 8; ++ct)
#pragma unroll
                for (int r = 0; r < 4; ++r) { const int s = 16 * ct + 4 * q + r; const int df = tk - s; sacc[ct][r] *= df >= 0 ? exp2f(l0 * (float)df) : exp2f(l1 * (float)(-df)); }
#pragma unroll
            for (int ks = 0; ks < 4; ++ks) { u32x4 w; w.x = pk2(sacc[2 * ks][0], sacc[2 * ks][1]); w.y = pk2(sacc[2 * ks][2], sacc[2 * ks][3]); w.z = pk2(sacc[2 * ks + 1][0], sacc[2 * ks + 1][1]); w.w = pk2(sacc[2 * ks + 1][2], sacc[2 * ks + 1][3]);
                pf[ks] = __builtin_bit_cast(bf16x8, w); }
        }
        const bf16* F = KV + (size_t)(((b * 4 + h) * 2 + 0) * NCH_RET + c + 2) * 16384; const bf16* G = KV + (size_t)(((b * 4 + h) * 2 + 1) * NCH_RET + c + 2) * 16384;
        const float s0 = exp2f(l0 * (float)(tk + 1)), s1 = exp2f(l1 * (float)(128 - tk));
        f32x4 y[8]; float sum = 0.f;
#pragma unroll
        for (int vt = 0; vt < 8; ++vt) {
            f32x4 ay = {0.f, 0.f, 0.f, 0.f}, a0 = ay, a1 = ay;
#pragma unroll
            for (int ks = 0; ks < 4; ++ks) {
                const LAS bf16* vp = VT + (16 * vt + i16) * 136 + 32 * ks + 4 * q;
                const u32x2 lo = *(const LAS u32x2*)vp, hi = *(const LAS u32x2*)(vp + 16);
                u32x4 w; w.x = lo.x; w.y = lo.y; w.z = hi.x; w.w = hi.y;
                ay = __builtin_amdgcn_mfma_f32_16x16x32_bf16(__builtin_bit_cast(bf16x8, w), pf[ks], ay, 0, 0, 0);
                a0 = __builtin_amdgcn_mfma_f32_16x16x32_bf16(ld8(F + (size_t)(16 * vt + i16) * 128 + 32 * ks + 8 * q), aq[ks], a0, 0, 0, 0);
                a1 = __builtin_amdgcn_mfma_f32_16x16x32_bf16(ld8(G + (size_t)(16 * vt + i16) * 128 + 32 * ks + 8 * q), aq[ks], a1, 0, 0, 0);
            }
            y[vt] = ay + a0 * s0 + a1 * s1; sum += (y[vt][0] + y[vt][1]) + (y[vt][2] + y[vt][3]);
        }
        sum += __shfl_xor(sum, 16); sum += __shfl_xor(sum, 32);
        const float mu = sum * (1.0f / 128.0f); float sq = 0.f;
#pragma unroll
        for (int vt = 0; vt < 8; ++vt) { y[vt] = y[vt] - mu; sq += (y[vt][0] * y[vt][0] + y[vt][1] * y[vt][1]) + (y[vt][2] * y[vt][2] + y[vt][3] * y[vt][3]); }
        sq += __shfl_xor(sq, 16); sq += __shfl_xor(sq, 32);
        const float rstd = 1.0f / sqrtf(sq * (1.0f / 128.0f) + 1e-5f);
#pragma unroll
        for (int vt = 0; vt < 8; ++vt) {
            const u32x2 gw = *(const u32x2*)(qrow + 1536 + 16 * vt + 4 * q);
            const float g0 = bflo(gw.x), g1 = bfhi(gw.x), g2 = bflo(gw.y), g3 = bfhi(gw.y);
            u32x2 w; w.x = pk2(y[vt][0] * rstd * g0 * sigmoidf_(g0), y[vt][1] * rstd * g1 * sigmoidf_(g1)); w.y = pk2(y[vt][2] * rstd * g2 * sigmoidf_(g2), y[vt][3] * rstd * g3 * sigmoidf_(g3));
            *(u32x2*)(qrow + 16 * vt + 4 * q) = w;
        }
    }
}

__device__ __forceinline__ int rw_row(int z, int b, int pp) {
    if (pp < CTXL) return ML + b * CTXL + (z ? CTXL - 1 - pp : pp);
    const int t = pp - CTXL; return b * SEQ + (z ? SEQ - 1 - t : t);
}

constexpr int RW_NSEG = 33, RW_WLDS = 18432;
constexpr size_t WS_SEGQ = WS_GU2;
constexpr size_t WS_SEGP0 = MiB / 4, WS_SEGP1 = WS_Y1 + 16 * MiB;
static_assert(WS_SEGQ + (size_t)32 * 32 * 16384 <= WS_U && WS_SEGP0 + (size_t)16 * 31 * 16384 <= WS_GU1 && WS_SEGP1 + (size_t)16 * 31 * 16384 <= 256 * MiB, "rwkv segment state map");
__device__ __forceinline__ float* segp_ptr(unsigned char* ws, int scan, int j) { return (float*)(ws + ((scan < 16) ? WS_SEGP0 : WS_SEGP1)) + ((size_t)(scan & 15) * 31 + (j - 1)) * 4096; }
typedef __bf16 bf16x2_ __attribute__((ext_vector_type(2)));
__device__ __forceinline__ unsigned cvtpk(float lo, float hi) { const f32x2 v = {lo, hi}; return __builtin_bit_cast(unsigned, __builtin_convertvector(v, bf16x2_)); }
__device__ __forceinline__ bf16x8 pack8(f32x4 a, f32x4 b) { u32x4 w; w.x = cvtpk(a[0], a[1]); w.y = cvtpk(a[2], a[3]); w.z = cvtpk(b[0], b[1]); w.w = cvtpk(b[2], b[3]); return __builtin_bit_cast(bf16x8, w); }
__device__ __forceinline__ bf16x8 ldperm(const LAS unsigned char* img, int l15, int q, int ks) {
    const LAS unsigned char* a = img + l15 * 144 + 64 * ks + 8 * q; const u32x2 lo = *(const LAS u32x2*)a, hi = *(const LAS u32x2*)(a + 32);
    u32x4 w; w.x = lo.x; w.y = lo.y; w.z = hi.x; w.w = hi.y; return __builtin_bit_cast(bf16x8, w);
}
constexpr size_t WS_W2P = 128 * 1024, WS_A2P = 192 * 1024;
#define MFMA16(a, b, c) __builtin_amdgcn_mfma_f32_16x16x32_bf16((a), (b), (c), 0, 0, 0)

template <int MODE>
__device__ __forceinline__ void rw_segment(const Params& p, LAS unsigned char* wl, int lane0, int scan, int seg, bool ident) {
    const int Z = scan >> 4, dir = Z ? -1 : 1; const int b = (scan >> 3) & 1, h = scan & 7;
    unsigned char* ws = p.ws;
    const bf16* prw = (const bf16*)(ws + WS_PRW);
    const float* INVN = (const float*)(ws + WS_INVN); const float* HW = (const float*)(ws + WS_HW) + (size_t)Z * MT * 32; const float* HA = (const float*)(ws + WS_HA) + (size_t)Z * MT * 32;
    const float mu_r = p.in[14][h * 64 + lane0], mu_k = p.in[14][512 + h * 64 + lane0], mu_v = p.in[14][1024 + h * 64 + lane0], k_k = p.in[24][h * 64 + lane0], k_a = p.in[25][h * 64 + lane0];
    LAS unsigned char* const IMG_A = wl, * const IMG_R = wl + 2304, * const IMG_B = wl + 4608, * const IMG_K = wl + 6912;
    LAS unsigned char* const T1 = wl, * const DV = wl + 4096;
    LAS unsigned char* const UT = wl + 9216, * const VT = wl + 11264, * const LWB = wl + 13312, * const LAB = wl + 15360;
    LAS unsigned char* const AAB = wl + 13312, * const AAK = wl + 14336, * const A2 = wl + 15360;
    f32x4 S[4][4];
    { const int l15 = lane0 & 15, q = lane0 >> 4;
    if (MODE == 2) { const float* sst = (const float*)(ws + WS_SEGQ) + ((size_t)scan * 32 + (seg - 1)) * 4096 + l15 * 64 + 4 * q;
#pragma unroll
        for (int vt = 0; vt < 4; ++vt)
#pragma unroll
            for (int ct = 0; ct < 4; ++ct) S[vt][ct] = *(const f32x4*)(sst + (16 * vt) * 64 + 16 * ct);
    } else {
#pragma unroll
        for (int vt = 0; vt < 4; ++vt)
#pragma unroll
            for (int ct = 0; ct < 4; ++ct)
#pragma unroll
                for (int r = 0; r < 4; ++r) S[vt][ct][r] = (ident && vt == ct && l15 == 4 * q + r) ? 1.0f : 0.0f;
    }
    }
    const int pp_start = seg * 256;
#pragma unroll 1
    for (int ci = 0; ci < 16; ++ci) {
        int lane_ = lane0; asm volatile("" : "+v"(lane_));
        const int lane = lane_, l15 = lane & 15, q = lane >> 4, hc = h * 64 + lane;
        const bf16x8* w2p = (const bf16x8*)(ws + WS_W2P) + (size_t)((Z * 8 + h) * 4) * 64 + lane; const bf16x8* a2p = (const bf16x8*)(ws + WS_A2P) + (size_t)((Z * 8 + h) * 4) * 64 + lane;
        const int R0 = rw_row(Z, b, pp_start + 16 * ci);
        {
            const int Rt = R0 + dir * l15;
            const float* hwp = HW + (size_t)Rt * 32 + 8 * q; const float* hap = HA + (size_t)Rt * 32 + 8 * q;
            const bf16x8 hwf = pack8(*(const f32x4*)hwp, *(const f32x4*)(hwp + 4)), haf = pack8(*(const f32x4*)hap, *(const f32x4*)(hap + 4));
#pragma unroll
            for (int ct = 0; ct < 4; ++ct) { const f32x4 z4 = {0.f, 0.f, 0.f, 0.f};
                const f32x4 d = MFMA16(hwf, w2p[64 * ct], z4), d2 = MFMA16(haf, a2p[64 * ct], z4);
                const float w0 = p.in[16][Z * 512 + h * 64 + 16 * ct + l15], a0 = p.in[19][Z * 512 + h * 64 + 16 * ct + l15];
                u32x2 w; w.x = cvtpk(-0.6065306597126334f * sigmoidf_(w0 + d[0]), -0.6065306597126334f * sigmoidf_(w0 + d[1]));
                w.y = cvtpk(-0.6065306597126334f * sigmoidf_(w0 + d[2]), -0.6065306597126334f * sigmoidf_(w0 + d[3]));
                *(LAS u32x2*)(LWB + (16 * ct + l15) * 32 + 8 * q) = w;
                w.x = cvtpk(sigmoidf_(a0 + d2[0]), sigmoidf_(a0 + d2[1])); w.y = cvtpk(sigmoidf_(a0 + d2[2]), sigmoidf_(a0 + d2[3]));
                *(LAS u32x2*)(LAB + (16 * ct + l15) * 32 + 8 * q) = w; }
        }
        const float invl = INVN[(size_t)(R0 + dir * l15) * 8 + h];
        const bool okp = Z ? has_next(R0) : has_prev(R0), okn = Z ? has_prev(R0 - 15) : has_next(R0 + 15);
        unsigned pkw[9], prw_[9], pvw[9];
#pragma unroll
        for (int m = 0; m < 9; ++m) { const bf16* r0 = prw + (size_t)(R0 + dir * (2 * m - 1)) * PLD + hc; const bf16* r1 = prw + (size_t)(R0 + dir * (2 * m)) * PLD + hc;
            const bool ok0 = m > 0 || okp, ok1 = m < 8 || okn;
            pkw[m] = (ok0 ? (unsigned)r0[512] : 0u) | ((ok1 ? (unsigned)r1[512] : 0u) << 16);
            if (MODE == 2) prw_[m] = (ok0 ? (unsigned)r0[0] : 0u) | ((ok1 ? (unsigned)r1[0] : 0u) << 16);
            pvw[m] = ident ? 0u : ((ok0 ? (unsigned)r0[1024] : 0u) | ((ok1 ? (unsigned)r1[1024] : 0u) << 16)); }
#define RWPOS(arr, j) (((j) & 1) ? bfhi(arr[(j) >> 1]) : bflo(arr[(j) >> 1]))
        asm volatile("" ::: "memory");
        unsigned lww[8], law[8];
        { const u32x4 a = *(const LAS u32x4*)(LWB + lane * 32), c = *(const LAS u32x4*)(LWB + lane * 32 + 16), d = *(const LAS u32x4*)(LAB + lane * 32), e = *(const LAS u32x4*)(LAB + lane * 32 + 16);
          lww[0] = a.x; lww[1] = a.y; lww[2] = a.z; lww[3] = a.w; lww[4] = c.x; lww[5] = c.y; lww[6] = c.z; lww[7] = c.w;
          law[0] = d.x; law[1] = d.y; law[2] = d.z; law[3] = d.w; law[4] = e.x; law[5] = e.y; law[6] = e.z; law[7] = e.w; }
        float cum = 0.f, Eprev = 1.f, Elast = 1.f;
        float ve = 0.f;
#pragma unroll
        for (int i = 0; i < 16; ++i) {
            const int idx = i + 1;
            const float lw = (i & 1) ? bfhi(lww[i >> 1]) : bflo(lww[i >> 1]); cum += lw;
            const float E = __expf(cum), Einv = __builtin_amdgcn_rcpf(E);
            const float asig = (i & 1) ? bfhi(law[i >> 1]) : bflo(law[i >> 1]);
            const float kc_ = RWPOS(pkw, idx); const float k = kc_ + mu_k * (0.5f * (RWPOS(pkw, idx - 1) + RWPOS(pkw, idx + 1)) - kc_);
            const float invn = __int_as_float(__builtin_amdgcn_readlane(__float_as_int(invl), i));
            const float kk = k * k_k * invn, keff = k * (1.0f + (asig - 1.0f) * k_a);
            const float at = -kk * Eprev, bh = kk * asig * Einv, kh = keff * Einv;
            const unsigned wab = cvtpk(at, bh);
            *(LAS unsigned short*)(IMG_A + i * 144 + lane * 2) = (unsigned short)(wab & 0xffffu); *(LAS unsigned short*)(IMG_B + i * 144 + lane * 2) = (unsigned short)(wab >> 16);
            float rt = 0.f;
            if (MODE == 2) { const float rc_ = RWPOS(prw_, idx); const float r = rc_ + mu_r * (0.5f * (RWPOS(prw_, idx - 1) + RWPOS(prw_, idx + 1)) - rc_); rt = r * (Z == 0 ? E : Eprev); }
            const unsigned wkr = cvtpk(kh, rt);
            *(LAS unsigned short*)(IMG_K + i * 144 + lane * 2) = (unsigned short)(wkr & 0xffffu); if (MODE == 2) *(LAS unsigned short*)(IMG_R + i * 144 + lane * 2) = (unsigned short)(wkr >> 16);
            float v = 0.f;
            { const float vc_ = RWPOS(pvw, idx); v = vc_ + mu_v * (0.5f * (RWPOS(pvw, idx - 1) + RWPOS(pvw, idx + 1)) - vc_);
                if (i & 1) *(LAS unsigned*)(VT + lane * 32 + 2 * (i - 1)) = cvtpk(ve, v); else ve = v; }
            Eprev = E; Elast = E;
        }
        asm volatile("" ::: "memory");
        bf16x8 fA[2], fB[2], fK[2], fR[2];
#pragma unroll
        for (int ks = 0; ks < 2; ++ks) { fA[ks] = ldperm(IMG_A, l15, q, ks); fB[ks] = ldperm(IMG_B, l15, q, ks); fK[ks] = ldperm(IMG_K, l15, q, ks); if (MODE == 2) fR[ks] = ldperm(IMG_R, l15, q, ks); }
        bf16x8 bkf[4];
        { const unsigned ta = (unsigned)(size_t)(q < 2 ? IMG_B : IMG_K) + (unsigned)((8 * (q & 1) + (l15 >> 2)) * 144 + 8 * (l15 & 3));
          u32x2 t0, t1, t2, t3, t4, t5, t6, t7;
          asm volatile("ds_read_b64_tr_b16 %0, %8\n\tds_read_b64_tr_b16 %1, %8 offset:576\n\tds_read_b64_tr_b16 %2, %8 offset:32\n\tds_read_b64_tr_b16 %3, %8 offset:608\n\t"
                       "ds_read_b64_tr_b16 %4, %8 offset:64\n\tds_read_b64_tr_b16 %5, %8 offset:640\n\tds_read_b64_tr_b16 %6, %8 offset:96\n\tds_read_b64_tr_b16 %7, %8 offset:672\n\ts_waitcnt lgkmcnt(0)"
                       : "=&v"(t0), "=&v"(t1), "=&v"(t2), "=&v"(t3), "=&v"(t4), "=&v"(t5), "=&v"(t6), "=&v"(t7) : "v"(ta) : "memory");
          bkf[0] = __builtin_bit_cast(bf16x8, (u32x4){t0.x, t0.y, t1.x, t1.y}); bkf[1] = __builtin_bit_cast(bf16x8, (u32x4){t2.x, t2.y, t3.x, t3.y});
          bkf[2] = __builtin_bit_cast(bf16x8, (u32x4){t4.x, t4.y, t5.x, t5.y}); bkf[3] = __builtin_bit_cast(bf16x8, (u32x4){t6.x, t6.y, t7.x, t7.y}); }
        asm volatile("" ::: "memory");
        {
            f32x4 gab = {0.f, 0.f, 0.f, 0.f}, gak = gab, grb = gab, grk = gab;
#pragma unroll
            for (int ks = 0; ks < 2; ++ks) { gab = MFMA16(fB[ks], fA[ks], gab); gak = MFMA16(fK[ks], fA[ks], gak); if (MODE == 2) { grb = MFMA16(fB[ks], fR[ks], grb); grk = MFMA16(fK[ks], fR[ks], grk); } }
#pragma unroll
            for (int r = 0; r < 4; ++r) { const int s = 4 * q + r; if (!(s < l15)) { gab[r] = 0.f; gak[r] = 0.f; } if (!(Z == 0 ? s <= l15 : s < l15)) { grb[r] = 0.f; grk[r] = 0.f; } }
            *(LAS f32x4*)(AAB + l15 * 64 + 16 * q) = gab; *(LAS f32x4*)(AAK + l15 * 64 + 16 * q) = gak;
            if (MODE == 2) { u32x2 w; w.x = cvtpk(grb[0], grb[1]); w.y = cvtpk(grb[2], grb[3]); *(LAS u32x2*)(A2 + l15 * 80 + 8 * q) = w;
                             w.x = cvtpk(grk[0], grk[1]); w.y = cvtpk(grk[2], grk[3]); *(LAS u32x2*)(A2 + l15 * 80 + 32 + 8 * q) = w; }
            *(LAS float*)(DV + lane * 4) = Elast;
        }
        f32x4 yp[4];
#pragma unroll
        for (int vt = 0; vt < 4; ++vt) { const bf16x8 sf0 = pack8(S[vt][0], S[vt][1]), sf1 = pack8(S[vt][2], S[vt][3]);
            f32x4 t1 = {0.f, 0.f, 0.f, 0.f}; t1 = MFMA16(fA[0], sf0, t1); t1 = MFMA16(fA[1], sf1, t1);
            *(LAS f32x4*)(T1 + (16 * vt + l15) * 64 + 16 * q) = t1;
            if (MODE == 2) { f32x4 y = {0.f, 0.f, 0.f, 0.f}; y = MFMA16(sf0, fR[0], y); y = MFMA16(sf1, fR[1], y); yp[vt] = y; } }
        asm volatile("" ::: "memory");
        float U[16]; unsigned vw_[8];
        { const u32x4 a = *(const LAS u32x4*)(VT + lane * 32), c = *(const LAS u32x4*)(VT + lane * 32 + 16); vw_[0] = a.x; vw_[1] = a.y; vw_[2] = a.z; vw_[3] = a.w; vw_[4] = c.x; vw_[5] = c.y; vw_[6] = c.z; vw_[7] = c.w; }
        { const f32x4 t0 = *(const LAS f32x4*)(T1 + lane * 64), t1 = *(const LAS f32x4*)(T1 + lane * 64 + 16), t2 = *(const LAS f32x4*)(T1 + lane * 64 + 32), t3 = *(const LAS f32x4*)(T1 + lane * 64 + 48);
#pragma unroll
          for (int r = 0; r < 4; ++r) { U[r] = t0[r]; U[4 + r] = t1[r]; U[8 + r] = t2[r]; U[12 + r] = t3[r]; } }
#pragma unroll
        for (int i = 1; i < 16; ++i) {
            float acc = U[i];
#pragma unroll
            for (int g = 0; g <= (i - 1) >> 2; ++g) { const f32x4 ab = *(const LAS f32x4*)(AAB + i * 64 + 16 * g);
#pragma unroll
                for (int r = 0; r < 4; ++r) if (4 * g + r < i) acc += ab[r] * U[4 * g + r];
                { const f32x4 ak = *(const LAS f32x4*)(AAK + i * 64 + 16 * g);
#pragma unroll
                    for (int r = 0; r < 4; ++r) if (4 * g + r < i) acc += ak[r] * ((r & 1) ? bfhi(vw_[(4 * g + r) >> 1]) : bflo(vw_[(4 * g + r) >> 1])); } }
            U[i] = acc;
        }
        { u32x4 w0_, w1_; w0_.x = cvtpk(U[0], U[1]); w0_.y = cvtpk(U[2], U[3]); w0_.z = cvtpk(U[4], U[5]); w0_.w = cvtpk(U[6], U[7]);
          w1_.x = cvtpk(U[8], U[9]); w1_.y = cvtpk(U[10], U[11]); w1_.z = cvtpk(U[12], U[13]); w1_.w = cvtpk(U[14], U[15]);
          *(LAS u32x4*)(UT + lane * 32) = w0_; *(LAS u32x4*)(UT + lane * 32 + 16) = w1_; }
        asm volatile("" ::: "memory");
        bf16x8 uvf[4];
#pragma unroll
        for (int t = 0; t < 4; ++t) uvf[t] = *(const LAS bf16x8*)((q < 2 ? UT : VT) + (16 * t + l15) * 32 + 16 * (q & 1));
        if (MODE == 2) {
            const bf16x8 a2f_ = *(const LAS bf16x8*)(A2 + l15 * 80 + 16 * q);
            const int Rt = R0 + dir * l15;
            bf16* yo = Z == 0 ? (bf16*)(ws + WS_PRW) + (size_t)Rt * PLD + RW_Y + h * 64 + 4 * q : (bf16*)(ws + WS_Y1) + (size_t)Rt * 512 + h * 64 + 4 * q;
#pragma unroll
            for (int vt = 0; vt < 4; ++vt) { const f32x4 y = MFMA16(uvf[vt], a2f_, yp[vt]);
                u32x2 w; w.x = cvtpk(y[0], y[1]); w.y = cvtpk(y[2], y[3]); *(u32x2*)(yo + 16 * vt) = w; }
        }
#pragma unroll
        for (int ct = 0; ct < 4; ++ct) { const f32x4 dv = *(const LAS f32x4*)(DV + (16 * ct + 4 * q) * 4);
#pragma unroll
            for (int vt = 0; vt < 4; ++vt) S[vt][ct] = MFMA16(bkf[ct], uvf[vt], S[vt][ct]) * dv; }
        asm volatile("s_waitcnt lgkmcnt(0)" ::: "memory");
    }
    const int l15 = lane0 & 15, q = lane0 >> 4;
    if (MODE == 0 && !ident) { float* o = (float*)(ws + WS_SEGQ) + ((size_t)scan * 32 + seg) * 4096 + l15 * 64 + 4 * q; asm volatile("" : "+v"(o));
#pragma unroll
        for (int vt = 0; vt < 4; ++vt)
#pragma unroll
            for (int ct = 0; ct < 4; ++ct) *(f32x4*)(o + (16 * vt) * 64 + 16 * ct) = S[vt][ct]; }
    if (MODE == 0 && ident) { float* o = segp_ptr(ws, scan, seg) + (4 * q) * 64 + l15;
        asm volatile("" : "+v"(o));
#pragma unroll
        for (int vt = 0; vt < 4; ++vt)
#pragma unroll
            for (int ct = 0; ct < 4; ++ct)
#pragma unroll
                for (int r = 0; r < 4; ++r) o[(16 * ct + r) * 64 + 16 * vt] = S[vt][ct][r]; }
}
__device__ __forceinline__ void rw_pass_a(const Params& p, LAS unsigned char* lds, int wave, int lane) {
    LAS unsigned char* wl = lds + wave * RW_WLDS;
#pragma unroll 1
    for (int it = blockIdx.x * NWAVES + wave; it < 1024 + 992; it += gridDim.x * NWAVES) {
        const bool ident = it >= 1024; const int t = it - 1024; const int scan = ident ? t / 31 : it >> 5, seg = ident ? 1 + t % 31 : it & 31;
        rw_segment<0>(p, wl, lane, scan, seg, ident);
    }
}
__device__ __forceinline__ void rw_pass_c(const Params& p, LAS unsigned char* lds, int wave, int lane) {
    LAS unsigned char* wl = lds + wave * RW_WLDS;
    if (wave < 4)
#pragma unroll 1
    for (int it = blockIdx.x * 4 + wave; it < 1024; it += gridDim.x * 4) rw_segment<2>(p, wl, lane, it >> 5, 1 + (it & 31), false);
}
__device__ __forceinline__ void rw_pass_b(const Params& p, int wave, int lane) {
    const int l15 = lane & 15, q = lane >> 4;
    for (int it = blockIdx.x * NWAVES + wave; it < 128; it += gridDim.x * NWAVES) {
        const int scan = it >> 2, vt = it & 3;
        float* qb = (float*)(p.ws + WS_SEGQ) + (size_t)scan * 32 * 4096 + (16 * vt + l15) * 64 + 4 * q;
        f32x4 S[4];
#pragma unroll
        for (int ct = 0; ct < 4; ++ct) S[ct] = *(const f32x4*)(qb + 16 * ct);
        f32x4 pa[4][2], pb[4][2];
#define RWB_LOADP(m_) do { const float* pt_ = segp_ptr(p.ws, scan, (m_)); _Pragma("unroll") for (int ct = 0; ct < 4; ++ct) _Pragma("unroll") for (int ks = 0; ks < 2; ++ks) { \
            const float* pr_ = pt_ + (16 * ct + l15) * 64 + 32 * ks + 4 * q; pa[ct][ks] = *(const f32x4*)pr_; pb[ct][ks] = *(const f32x4*)(pr_ + 16); } } while (0)
        RWB_LOADP(1);
#pragma unroll 1
        for (int m = 1; m < 32; ++m) {
            bf16x8 shi[2], slo[2];
#pragma unroll
            for (int ks = 0; ks < 2; ++ks) { const f32x4 a = S[2 * ks], bq = S[2 * ks + 1]; shi[ks] = pack8(a, bq);
                const u32x4 hw = __builtin_bit_cast(u32x4, shi[ks]);
                const f32x4 ah = {bflo(hw.x), bfhi(hw.x), bflo(hw.y), bfhi(hw.y)}, bh = {bflo(hw.z), bfhi(hw.z), bflo(hw.w), bfhi(hw.w)};
                slo[ks] = pack8(a - ah, bq - bh); }
            bf16x8 phi[4][2], plo[4][2];
#pragma unroll
            for (int ct = 0; ct < 4; ++ct)
#pragma unroll
                for (int ks = 0; ks < 2; ++ks) { const f32x4 a = pa[ct][ks], bq = pb[ct][ks]; phi[ct][ks] = pack8(a, bq); const u32x4 hw = __builtin_bit_cast(u32x4, phi[ct][ks]);
                    const f32x4 ah = {bflo(hw.x), bfhi(hw.x), bflo(hw.y), bfhi(hw.y)}, bh = {bflo(hw.z), bfhi(hw.z), bflo(hw.w), bfhi(hw.w)};
                    plo[ct][ks] = pack8(a - ah, bq - bh); }
            f32x4 N[4];
#pragma unroll
            for (int ct = 0; ct < 4; ++ct) N[ct] = *(const f32x4*)(qb + (size_t)m * 4096 + 16 * ct);
            if (m < 31) RWB_LOADP(m + 1);
#pragma unroll
            for (int ct = 0; ct < 4; ++ct) { f32x4 acc = N[ct];
#pragma unroll
                for (int ks = 0; ks < 2; ++ks) { acc = MFMA16(phi[ct][ks], shi[ks], acc); acc = MFMA16(plo[ct][ks], shi[ks], acc); acc = MFMA16(phi[ct][ks], slo[ks], acc); }
                N[ct] = acc; }
#pragma unroll
            for (int ct = 0; ct < 4; ++ct) { S[ct] = N[ct]; *(f32x4*)(qb + (size_t)m * 4096 + 16 * ct) = N[ct]; }
        }
#undef RWB_LOADP
    }
}
template <class F>
__device__ __forceinline__ void small_gemm(const bf16* A, int lda, const bf16* Bt, int K, int ntn, int ntiles, int wave, int lane, F f) {
    const int l15 = lane & 15, q = lane >> 4;
    for (int tile = blockIdx.x; tile < ntiles; tile += gridDim.x) {
        const int tm = tile / ntn, tn = tile % ntn, row0 = tm * 64 + 16 * (wave & 3), col0 = tn * 32 + 16 * (wave >> 2);
        const bf16* ap = A + (size_t)(row0 + l15) * lda + 8 * q; const bf16* bp = Bt + (size_t)(col0 + l15) * K + 8 * q;
        f32x4 acc0 = {0.f, 0.f, 0.f, 0.f}, acc1 = acc0;
#pragma unroll 4
        for (int ks = 0; ks < K / 32; ks += 2) { acc0 = MFMA16(ld8(bp + 32 * ks), ld8(ap + 32 * ks), acc0); acc1 = MFMA16(ld8(bp + 32 * ks + 32), ld8(ap + 32 * ks + 32), acc1); }
        f(row0 + l15, col0 + 4 * q, acc0 + acc1);
    }
}
struct CtxDownEpi { const float* xin; float* out; const float* gate; float sc;
    __device__ __forceinline__ void operator()(int row, int col, f32x4 acc) const { const size_t o = (size_t)row * DM + col; *(f32x4*)(out + o) = *(const f32x4*)(xin + o) + *(const f32x4*)(gate + col) * sc * acc; } };
__device__ __forceinline__ void p0_lora_frags(const Params& p) {
    for (int idx = blockIdx.x * NTHR + threadIdx.x; idx < 2 * 4096; idx += gridDim.x * NTHR) {
        const int which = idx >> 12, t = idx & 4095, lane = t & 63, ct = (t >> 6) & 3, h = (t >> 8) & 7, z = t >> 11, l15 = lane & 15, q = lane >> 4;
        const float* W = which ? p.in[21] : p.in[18]; float v[8];
#pragma unroll
        for (int e = 0; e < 8; ++e) v[e] = W[(size_t)(z * 32 + 8 * q + e) * 512 + h * 64 + 16 * ct + l15];
        u32x4 w; w.x = pk2(v[0], v[1]); w.y = pk2(v[2], v[3]); w.z = pk2(v[4], v[5]); w.w = pk2(v[6], v[7]);
        *(u32x4*)(p.ws + (which ? WS_A2P : WS_W2P) + (size_t)t * 16) = w;
    }
}

__device__ __forceinline__ void rwkv_readout(const Params& p, LAS unsigned char* lds, int wave, int lane) {
    LAS bf16* g2s = (LAS bf16*)lds; LAS bf16* a2s = g2s + 96 * 512;
    for (int i = threadIdx.x; i < 96 * 512; i += NTHR) g2s[i] = (bf16)f2bf(p.in[23][i]);
    for (int i = threadIdx.x; i < 32 * 512; i += NTHR) a2s[i] = (bf16)f2bf(p.in[21][i]);
    __syncthreads();
    bf16* prw = (bf16*)(p.ws + WS_PRW); const bf16* Y1 = (const bf16*)(p.ws + WS_Y1);
    const float* HA = (const float*)(p.ws + WS_HA); const float* HG = (const float*)(p.ws + WS_HG);
    const int gw = blockIdx.x * NWAVES + wave, NGW = gridDim.x * NWAVES;
    const int c0 = 8 * lane;
    float mur[8], muk[8], muv[8], kav[8], rkv[8], lnw[8], lnb[8], a0v[8];
#pragma unroll
    for (int e = 0; e < 8; ++e) { mur[e] = p.in[14][c0 + e]; muk[e] = p.in[14][512 + c0 + e]; muv[e] = p.in[14][1024 + c0 + e]; kav[e] = p.in[25][c0 + e]; rkv[e] = p.in[26][c0 + e];
        lnw[e] = p.in[27][c0 + e]; lnb[e] = p.in[28][c0 + e]; a0v[e] = p.in[19][c0 + e]; }
    for (int R = gw; R < ML; R += NGW) {
        bf16* row = prw + (size_t)R * PLD; const bool hp = has_prev(R), hn = has_next(R);
        float y[8], r[8], k[8], v[8];
        { const u32x4 a = *(const u32x4*)(row + RW_Y + c0), bb = *(const u32x4*)(Y1 + (size_t)R * 512 + c0); const unsigned aw[4] = {a.x, a.y, a.z, a.w}, bw[4] = {bb.x, bb.y, bb.z, bb.w};
#pragma unroll
          for (int e = 0; e < 4; ++e) { y[2 * e] = bflo(aw[e]) + bflo(bw[e]); y[2 * e + 1] = bfhi(aw[e]) + bfhi(bw[e]); } }
#pragma unroll
        for (int tns = 0; tns < 3; ++tns) {
            const u32x4 cc = *(const u32x4*)(row + 512 * tns + c0); u32x4 pp = {0u, 0u, 0u, 0u}, nn = {0u, 0u, 0u, 0u};
            if (hp) pp = *(const u32x4*)(row - PLD + 512 * tns + c0); if (hn) nn = *(const u32x4*)(row + PLD + 512 * tns + c0);
            const unsigned cw[4] = {cc.x, cc.y, cc.z, cc.w}, pw[4] = {pp.x, pp.y, pp.z, pp.w}, nw[4] = {nn.x, nn.y, nn.z, nn.w};
#pragma unroll
            for (int e = 0; e < 8; ++e) { const float cv = (e & 1) ? bfhi(cw[e >> 1]) : bflo(cw[e >> 1]), pv = (e & 1) ? bfhi(pw[e >> 1]) : bflo(pw[e >> 1]), nv = (e & 1) ? bfhi(nw[e >> 1]) : bflo(nw[e >> 1]);
                const float mu = tns == 0 ? mur[e] : (tns == 1 ? muk[e] : muv[e]); const float o = cv + mu * (0.5f * (pv + nv) - cv);
                if (tns == 0) r[e] = o; else if (tns == 1) k[e] = o; else v[e] = o; }
        }
        float s = 0.f;
#pragma unroll
        for (int e = 0; e < 8; ++e) s += y[e];
        const float mu = sum8(s) * (1.0f / 64.0f); float sq = 0.f;
#pragma unroll
        for (int e = 0; e < 8; ++e) { y[e] -= mu; sq += y[e] * y[e]; }
        const float rstd = 1.0f / sqrtf(sum8(sq) * (1.0f / 64.0f) + 64e-5f);
        float ap[8], g[8];
#pragma unroll
        for (int e = 0; e < 8; ++e) { ap[e] = a0v[e]; g[e] = 0.f; }
        const float hav = HA[(size_t)R * 32 + (lane & 31)];
#pragma unroll 4
        for (int j = 0; j < 32; ++j) { const float hv = __shfl(hav, j); const u32x4 w = *(const LAS u32x4*)(a2s + j * 512 + c0); const unsigned ww[4] = {w.x, w.y, w.z, w.w};
#pragma unroll
            for (int e = 0; e < 4; ++e) { ap[2 * e] += hv * bflo(ww[e]); ap[2 * e + 1] += hv * bfhi(ww[e]); } }
        const float hg0 = HG[(size_t)R * 96 + lane], hg1 = HG[(size_t)R * 96 + 64 + (lane & 31)];
#pragma unroll 4
        for (int j = 0; j < 96; ++j) { const float hv = j < 64 ? __shfl(hg0, j) : __shfl(hg1, j - 64); const u32x4 w = *(const LAS u32x4*)(g2s + j * 512 + c0); const unsigned ww[4] = {w.x, w.y, w.z, w.w};
#pragma unroll
            for (int e = 0; e < 4; ++e) { g[2 * e] += hv * bflo(ww[e]); g[2 * e + 1] += hv * bfhi(ww[e]); } }
        float bs = 0.f;
#pragma unroll
        for (int e = 0; e < 8; ++e) { const float asig = sigmoidf_(ap[e]); const float keff = k[e] * (1.0f + (asig - 1.0f) * kav[e]); bs += r[e] * keff * rkv[e]; }
        bs = sum8(bs);
        float o[8];
#pragma unroll
        for (int e = 0; e < 8; ++e) o[e] = (y[e] * rstd * lnw[e] + lnb[e] + bs * v[e]) * g[e];
        u32x4 w; w.x = pk2(o[0], o[1]); w.y = pk2(o[2], o[3]); w.z = pk2(o[4], o[5]); w.w = pk2(o[6], o[7]);
        *(u32x4*)(row + RW_Y + c0) = w;
    }
}

constexpr int LDS_BYTES = 147456 + 64;
constexpr int LDS_BARW = 147456;
constexpr int NPHASE = 17;
__global__ void __launch_bounds__(NTHR, 2) fwd_megakernel(Params p) {
    extern __shared__ __attribute__((aligned(16))) unsigned char lds_raw[];
    LAS unsigned char* lds = (LAS unsigned char*)lds_raw;
    cg::grid_group grid = cg::this_grid();
    const int tid = threadIdx.x, lane = tid & 63, wave = __builtin_amdgcn_readfirstlane(tid >> 6);
    unsigned char* ws = p.ws;
    const float* x = p.in[0]; const float* ctx = p.in[2];
    float* Hl = p.out; float* Hc = (float*)(ws + WS_HC);
    const float* modv = (const float*)(ws + WS_MODV);
    bf16* U = (bf16*)(ws + WS_U); bf16* ACT = (bf16*)(ws + WS_ACT); bf16* PRET = (bf16*)(ws + WS_PRET); bf16* PRW = (bf16*)(ws + WS_PRW);
    const int lo = p.ph_lo, hi = p.ph_hi, G = gridDim.x, bx = blockIdx.x;
#define IN(k) (lo <= (k) && (k) < hi)
#define SEAM(k) do { if (IN(k) && IN((k) + 1)) { xcd_barrier(bar); } } while (0)
    if (tid < 16) ((LAS unsigned*)(lds + LDS_BARW))[tid] = 0u;
    __syncthreads();
    if (p.ph_hi < 0) grid.sync();
    const XcdBarrier bar = xcd_barrier_post((unsigned*)(ws + WS_BAR), (volatile LAS unsigned*)(lds + LDS_BARW));

    if (IN(0)) { p0_modv(p, lds); p0_lora_frags(p); p0_weights(p, lds, wave, lane, 0, 18); } SEAM(0);
    if (IN(1)) norm_rows(x, ctx, p.in[6], modv, 0 * DM, 1 * DM, U, MT, wave, lane); SEAM(1);
    if (IN(2)) { pg8::Gemm g{U, (const bf16*)(ws + WS_GU1), MT, 2 * DFF, DM, DM}; pg8::StaticOrder S; S.init(MT, 2 * DFF, G, bx); EpiSwiGLU E{ACT, DFF};
        pg8::gemm_phase<EpiSwiGLU, pg8::StaticOrder, true, true>(lds, g, S, E); } SEAM(2);
    if (IN(3)) {
        small_gemm(ACT + (size_t)ML * DFF, DFF, (const bf16*)(ws + WS_D1), DFF, DM / 32, (MC / 64) * (DM / 32), wave, lane, CtxDownEpi{ctx, Hc, modv + 2 * NMODV + 2 * DM, 0.5f});
        pg8::Gemm g{ACT, (const bf16*)(ws + WS_D1), ML, DM, DFF, DFF}; pg8::StaticOrder S; S.init(ML, DM, G, bx); EpiResid E{x, ctx, Hl, Hc, modv, 2 * DM, 0.5f};
        pg8::gemm_phase<EpiResid, pg8::StaticOrder, false, true>(lds, g, S, E); } SEAM(3);
    if (IN(4)) norm_rows(Hl, Hc, p.in[10], modv, 3 * DM, 4 * DM, U, MT, wave, lane); SEAM(4);
    if (IN(5)) { pg8::Gemm g{U, (const bf16*)(ws + WS_WIN), MT, 4096, DM, DM}; pg8::StaticOrder S; S.init(MT, 4096, G, bx); EpiB<0, true> E{PRET, PRW, nullptr, PLD};
        pg8::gemm_phase<EpiB<0, true>, pg8::StaticOrder, true, true>(lds, g, S, E); } SEAM(5);
    if (IN(6)) p6_token_prep(p, wave, lane); SEAM(6);
    if (IN(7)) { rw_pass_a(p, lds, wave, lane); __syncthreads(); ret_kv_local(p, lds, wave, lane); } SEAM(7);
    if (IN(8)) { rw_pass_b(p, wave, lane); ret_scan(p); } SEAM(8);
    if (IN(9)) { rw_pass_c(p, lds, wave, lane); __syncthreads(); ret_out(p, lds, wave, lane, 0, G); } SEAM(9);
    if (IN(10)) { rwkv_readout(p, lds, wave, lane); norm_rows(Hl, Hc, p.in[10], modv, 3 * DM, 4 * DM, U, ML, wave, lane); __syncthreads(); p0_weights(p, lds, wave, lane, 18, NTRJOB); } SEAM(10);
    if (IN(11)) {
        pg8::StaticOrder S; S.init(ML, DM, G, bx);
        { pg8::Gemm g{PRET, (const bf16*)(ws + WS_RO), ML, DM, 512, PLD}; EpiB<0, false> E{PRET + 1024, nullptr, nullptr, PLD}; pg8::gemm_phase<EpiB<0, false>, pg8::StaticOrder, false, true>(lds, g, S, E); }
        { pg8::Gemm g{U, (const bf16*)(ws + WS_WG), ML, DM, DM, DM}; EpiB<1, false> E{PRET + 1024, nullptr, nullptr, PLD}; pg8::gemm_phase<EpiB<1, false>, pg8::StaticOrder, false, true>(lds, g, S, E); }
        { pg8::Gemm g{PRW + RW_Y, (const bf16*)(ws + WS_RWO), ML, DM, 512, PLD}; EpiB<0, false> E{PRW, nullptr, nullptr, PLD}; pg8::gemm_phase<EpiB<0, false>, pg8::StaticOrder, false, true>(lds, g, S, E); }
        { pg8::Gemm g{U, (const bf16*)(ws + WS_WG) + (size_t)DM * DM, ML, DM, DM, DM}; EpiB<2, false> E{PRET + 1024, nullptr, PRW, PLD}; pg8::gemm_phase<EpiB<2, false>, pg8::StaticOrder, false, true>(lds, g, S, E); }
    } SEAM(11);
    if (IN(12)) { pg8::Gemm g{PRET + 1024, (const bf16*)(ws + WS_WOUT), ML, DM, DM, PLD}; pg8::StaticOrder S; S.init(ML, DM, G, bx); EpiResid E{Hl, Hc, Hl, Hc, modv, 5 * DM, 1.0f};
        pg8::gemm_phase<EpiResid, pg8::StaticOrder, false, true>(lds, g, S, E); } SEAM(12);
    if (IN(13)) norm_rows(Hl, Hc, p.in[31], modv, 6 * DM, 7 * DM, U, ML, wave, lane); SEAM(13);
    if (IN(14)) { pg8::Gemm g{U, (const bf16*)(ws + WS_GU2), ML, 2 * DFF, DM, DM}; pg8::StaticOrder S; S.init(ML, 2 * DFF, G, bx); EpiSwiGLU E{ACT, DFF};
        pg8::gemm_phase<EpiSwiGLU, pg8::StaticOrder, true, true>(lds, g, S, E); } SEAM(14);
    if (IN(15)) { pg8::Gemm g{ACT, (const bf16*)(ws + WS_D2), ML, DM, DFF, DFF}; pg8::StaticOrder S; S.init(ML, DM, G, bx); EpiResid E{Hl, Hc, Hl, Hc, modv, 8 * DM, 0.5f};
        pg8::gemm_phase<EpiResid, pg8::StaticOrder, false, true>(lds, g, S, E); } SEAM(15);
    if (IN(16)) {
        const int gw = bx * NWAVES + wave, NGW = G * NWAVES; const float* gf = p.in[35];
        for (int R = gw; R < ML; R += NGW) { float* xr = Hl + (size_t)R * DM + 4 * lane; f32x4 v[4]; float s = 0.f;
#pragma unroll
            for (int j = 0; j < 4; ++j) { v[j] = *(const f32x4*)(xr + 256 * j); s += (v[j].x * v[j].x + v[j].y * v[j].y) + (v[j].z * v[j].z + v[j].w * v[j].w); }
            const float rstd = 1.0f / sqrtf(wave_sum(s) * (1.0f / DM) + 1e-6f);
#pragma unroll
            for (int j = 0; j < 4; ++j) *(f32x4*)(xr + 256 * j) = (v[j] * rstd) * *(const f32x4*)(gf + 4 * lane + 256 * j); }
    }
#undef IN
#undef SEAM
}

extern "C" void kernel_launch(void* const* d_in, const int* in_sizes, int n_in, void* d_out, int out_size, void* d_ws, size_t ws_size, hipStream_t stream) {
    static int grid = 0;
    if (grid == 0) {
        if (n_in != 36 || out_size != ML * DM || ws_size < 256 * MiB) { fprintf(stderr, "kernel_launch: unexpected problem (n_in %d out %d ws %zu)\n", n_in, out_size, ws_size); grid = -1; return; }
        int dev = 0, cus = 0, per_cu = 0;
        (void)hipGetDevice(&dev); (void)hipDeviceGetAttribute(&cus, hipDeviceAttributeMultiprocessorCount, dev);
        if (hipFuncSetAttribute((const void*)fwd_megakernel, hipFuncAttributeMaxDynamicSharedMemorySize, LDS_BYTES) != hipSuccess) { fprintf(stderr, "kernel_launch: hipFuncSetAttribute failed\n"); grid = -1; return; }
        if (hipOccupancyMaxActiveBlocksPerMultiprocessor(&per_cu, (const void*)fwd_megakernel, NTHR, LDS_BYTES) != hipSuccess || per_cu < 1) { fprintf(stderr, "kernel_launch: occupancy query says %d\n", per_cu); per_cu = 1; }
        (void)hipGetLastError();
        grid = cus * (per_cu > 1 ? 1 : per_cu);
        fprintf(stderr, "kernel_launch: cus %d per_cu %d grid %d\n", cus, per_cu, grid);
    }
    if (grid < 0) return;
    if (hipMemsetAsync((char*)d_ws + WS_BAR, 0, XCD_BAR_WORDS * 4, stream) != hipSuccess) { fprintf(stderr, "kernel_launch: memset of the barrier words failed\n"); return; }
    Params p{};
    for (int i = 0; i < 36; ++i) p.in[i] = (const float*)d_in[i];
    p.out = (float*)d_out; p.ws = (unsigned char*)d_ws; p.ph_lo = 0; p.ph_hi = NPHASE;
    void* args[] = {&p};
    hipError_t e = hipLaunchCooperativeKernel((const void*)fwd_megakernel, dim3(grid), dim3(NTHR), args, LDS_BYTES, stream);
    if (e != hipSuccess) fprintf(stderr, "kernel_launch: cooperative launch failed: %s (grid %d)\n", hipGetErrorString(e), grid);
}
```

```cpp
#include <hip/hip_runtime.h>
#include <hip/hip_cooperative_groups.h>
#include <cstdio>
#include <cstdint>
namespace cg = cooperative_groups;


namespace pg8 {
#define PG8_LAS __attribute__((address_space(3)))
typedef unsigned short bf16_t;
typedef short bf16x8 __attribute__((ext_vector_type(8)));
typedef float f32x4 __attribute__((ext_vector_type(4)));
typedef unsigned u32x4 __attribute__((ext_vector_type(4)));
constexpr int BM = 256, BK = 64, HALF = 128, HTB = HALF * BK * 2  , STAGE_BYTES = 8 * HTB, NXCD = 8, WGM = 8;

__host__ __device__ __forceinline__ int lds_byte(int r, int c) { const int st = (r >> 4) * 2 + (c >> 5), rr = r & 15, cc = c & 31, ob = rr * 64 + cc * 2; return st * 1024 + (ob ^ (((ob >> 9) & 1) << 5)); }
__host__ __device__ __forceinline__ void stage_rc(int b, int& R, int& C) { const int st = b / 1024, sb = b % 1024, swz = sb ^ (((sb >> 9) & 1) << 5); R = (st >> 1) * 16 + swz / 64; C = (st & 1) * 32 + (swz % 64) / 2; }
__host__ __device__ __forceinline__ int perm32(int rho) { const int n = rho >> 4, i = rho & 15; return 8 * (i >> 2) + 4 * n + (i & 3); }

struct Unit { int pm, pn; };
struct Gemm { const bf16_t* A; const bf16_t* Bt; int M, N, K, lda; };

struct StaticOrder {
    int nM, nN, nwg, G, c;
    __host__ __device__ void init(int M, int N, int G_, int c_) { nM = M / BM; nN = N / BM; nwg = nM * nN; G = G_; c = c_; }
    __host__ __device__ bool next(int i, Unit& u) const {
        const long L = (long)i * G + c; if (L >= nwg) return false;
        int wgid = (int)L; { const int q = nwg / NXCD, r = nwg % NXCD, xcd = wgid % NXCD, off = wgid / NXCD; wgid = (xcd < r ? xcd * (q + 1) : r * (q + 1) + (xcd - r) * q) + off; }
        const int nig = WGM * nN, gid = wgid / nig, fm = gid * WGM, gsz = (nM - fm) < WGM ? (nM - fm) : WGM;
        u.pm = fm + ((wgid % nig) % gsz); u.pn = (wgid % nig) / gsz; return true;
    }
    __device__ __forceinline__ void a_ready(const Unit&) const {}
    __device__ __forceinline__ void done(const Unit&) const {}
};

__device__ __forceinline__ unsigned cvt_pk_bf16(float lo, float hi) { unsigned r; asm volatile("v_cvt_pk_bf16_f32 %0, %1, %2" : "=v"(r) : "v"(lo), "v"(hi)); return r; }
template <class Epi, class Sched, bool ALIGN_EPI = false, bool SP2 = false>
__device__ __forceinline__ void gemm_phase(PG8_LAS unsigned char* lds, const Gemm g, const Sched& S, const Epi& E) {
    const int tid = threadIdx.x, wid = __builtin_amdgcn_readfirstlane(tid >> 6), lane = tid & 63, wr = wid >> 2, wc = wid & 3, fr = lane & 15, fq = lane >> 4;
    const int K = g.K, nt = K / BK;
    unsigned voffA[2], voffB[2];
#pragma unroll
    for (int i = 0; i < 2; ++i) { int R, C; stage_rc(tid * 16 + i * 8192, R, C); const int Rb = Epi::PERM ? ((R & ~31) + perm32(R & 31)) : R;
        voffA[i] = (unsigned)(R * g.lda + C) * 2u; voffB[i] = (unsigned)(Rb * K + C) * 2u; }
    const size_t kstep = (size_t)(BK * 2);
    const size_t hstepA = (size_t)HALF * g.lda * 2, hstepB = (size_t)HALF * K * 2;
    const size_t tstepA = 2 * hstepA, tstepB = 2 * hstepB;
    const unsigned ldsw = (unsigned)wid * 1024u;
    const int aoff = lds_byte(wr * 64 + fr, fq * 8), boff = lds_byte(wc * 32 + fr, fq * 8);
#define PG8_SA(b, h) (((b) * 2 + (h)) * HTB)
#define PG8_SB(b, h) ((4 + (b) * 2 + (h)) * HTB)
#define PG8_STAGE(bufoff, gbase, voff) do { _Pragma("unroll") for (int _i = 0; _i < 2; ++_i) \
        __builtin_amdgcn_global_load_lds((const unsigned*)((const char*)(gbase) + (voff)[_i]), (PG8_LAS unsigned*)(lds + (bufoff) + ldsw + _i * 8192), 16, 0, 0); } while (0)
#define PG8_LDA(dst, b, h) do { _Pragma("unroll") for (int m = 0; m < 4; ++m) _Pragma("unroll") for (int k = 0; k < 2; ++k) dst[m][k] = *(const PG8_LAS bf16x8*)(lds + PG8_SA(b, h) + aoff + m * 2048 + k * 1024); } while (0)
#define PG8_LDB(dst, b, h) do { _Pragma("unroll") for (int n = 0; n < 2; ++n) _Pragma("unroll") for (int k = 0; k < 2; ++k) dst[n][k] = *(const PG8_LAS bf16x8*)(lds + PG8_SB(b, h) + boff + n * 2048 + k * 1024); } while (0)
#define PG8_MMA(ai, bj, At, Bt) do { __builtin_amdgcn_s_setprio(1); _Pragma("unroll") for (int m = 0; m < 4; ++m) _Pragma("unroll") for (int n = 0; n < 2; ++n) _Pragma("unroll") for (int k = 0; k < 2; ++k) \
        acc[ai][bj][m][n] = __builtin_amdgcn_mfma_f32_16x16x32_bf16(Bt[n][k], At[m][k], acc[ai][bj][m][n], 0, 0, 0); __builtin_amdgcn_s_setprio(0); } while (0)
#define PG8_WAIT_V(n) asm volatile("s_waitcnt vmcnt(" #n ")" ::: "memory")
#define PG8_WAIT_L(n) asm volatile("s_waitcnt lgkmcnt(" #n ")" ::: "memory")
#define PG8_BAR __builtin_amdgcn_s_barrier()
#define PG8_SCHED __builtin_amdgcn_sched_barrier(0)
    Unit cur, nxt; int ui = 0;
    if (!S.next(0, cur)) return;
    f32x4 acc[2][2][4][2];
#pragma unroll
    for (int a = 0; a < 2; ++a)
#pragma unroll
        for (int b = 0; b < 2; ++b)
#pragma unroll
            for (int m = 0; m < 4; ++m)
#pragma unroll
                for (int n = 0; n < 2; ++n) acc[a][b][m][n] = (f32x4){0.f, 0.f, 0.f, 0.f};
    bf16x8 At[4][2], B0[2][2], B1[2][2];
    const char* cA = (const char*)g.A + (size_t)cur.pm * tstepA; const char* cB = (const char*)g.Bt + (size_t)cur.pn * tstepB;
    S.a_ready(cur);
    if constexpr (SP2) {
        PG8_STAGE(PG8_SB(0, 0), cB, voffB); PG8_STAGE(PG8_SB(0, 1), cB + hstepB, voffB); PG8_STAGE(PG8_SA(0, 0), cA, voffA); PG8_STAGE(PG8_SA(0, 1), cA + hstepA, voffA);
        if (wr == 1) PG8_BAR;
        PG8_WAIT_V(2); PG8_BAR;
        PG8_STAGE(PG8_SB(1, 0), cB + kstep, voffB); PG8_STAGE(PG8_SA(1, 0), cA + kstep, voffA); PG8_STAGE(PG8_SB(1, 1), cB + hstepB + kstep, voffB);
        PG8_WAIT_V(6); PG8_BAR;
    } else {
        PG8_STAGE(PG8_SB(0, 0), cB, voffB); PG8_STAGE(PG8_SA(0, 0), cA, voffA); PG8_STAGE(PG8_SB(0, 1), cB + hstepB, voffB); PG8_STAGE(PG8_SA(0, 1), cA + hstepA, voffA);
        if (wr == 1) PG8_BAR;
        PG8_WAIT_V(4); PG8_BAR;
        PG8_STAGE(PG8_SB(1, 0), cB + kstep, voffB); PG8_STAGE(PG8_SA(1, 0), cA + kstep, voffA); PG8_STAGE(PG8_SB(1, 1), cB + hstepB + kstep, voffB);
        PG8_WAIT_V(6); PG8_BAR;
    }
    for (;;) {
        const bool has_next = S.next(ui + 1, nxt);
        const char* nA = has_next ? (const char*)g.A + (size_t)nxt.pm * tstepA : cA; const char* nB = has_next ? (const char*)g.Bt + (size_t)nxt.pn * tstepB : cB;
        for (int t = 0; t < nt; t += 2) {
            const bool last = (t == nt - 2);
            const char* a1 = cA + (size_t)(t + 1) * kstep;
            const char* a2 = last ? nA : cA + (size_t)(t + 2) * kstep; const char* b2 = last ? nB : cB + (size_t)(t + 2) * kstep;
            const char* a3 = a2 + kstep; const char* b3 = b2 + kstep;
            if (last && has_next) S.a_ready(nxt);
            if constexpr (SP2) {
            PG8_LDB(B0, 0, 0); PG8_LDB(B1, 0, 1); PG8_SCHED; PG8_LDA(At, 0, 0); PG8_STAGE(PG8_SA(1, 1), a1 + hstepA, voffA);
            PG8_WAIT_V(8); PG8_WAIT_L(0); PG8_BAR; PG8_MMA(0, 0, At, B0); PG8_MMA(0, 1, At, B1); PG8_BAR; PG8_SCHED;
            PG8_LDA(At, 0, 1); PG8_STAGE(PG8_SB(0, 0), b2, voffB); PG8_STAGE(PG8_SB(0, 1), b2 + hstepB, voffB); PG8_STAGE(PG8_SA(0, 0), a2, voffA);
            PG8_WAIT_V(8); PG8_WAIT_L(0); PG8_BAR; PG8_MMA(1, 0, At, B0); PG8_MMA(1, 1, At, B1); PG8_BAR; PG8_SCHED;
            PG8_LDB(B0, 1, 0); PG8_LDB(B1, 1, 1); PG8_SCHED; PG8_LDA(At, 1, 0); PG8_STAGE(PG8_SA(0, 1), a2 + hstepA, voffA);
            PG8_WAIT_V(8); PG8_WAIT_L(0); PG8_BAR; PG8_MMA(0, 0, At, B0); PG8_MMA(0, 1, At, B1); PG8_BAR; PG8_SCHED;
            PG8_LDA(At, 1, 1); PG8_STAGE(PG8_SB(1, 0), b3, voffB); PG8_STAGE(PG8_SB(1, 1), b3 + hstepB, voffB); PG8_STAGE(PG8_SA(1, 0), a3, voffA);
            PG8_WAIT_V(8); PG8_WAIT_L(0); PG8_BAR; PG8_MMA(1, 0, At, B0); PG8_MMA(1, 1, At, B1); PG8_BAR; PG8_SCHED;
            } else {
            PG8_LDB(B0, 0, 0); PG8_SCHED; PG8_LDA(At, 0, 0); PG8_STAGE(PG8_SA(1, 1), a1 + hstepA, voffA);
            PG8_WAIT_L(8); PG8_BAR; PG8_WAIT_L(0); PG8_MMA(0, 0, At, B0); PG8_BAR; PG8_SCHED;
            PG8_LDB(B1, 0, 1); PG8_STAGE(PG8_SB(0, 0), b2, voffB);
            PG8_BAR; PG8_WAIT_L(0); PG8_MMA(0, 1, At, B1); PG8_BAR;
            PG8_LDA(At, 0, 1); PG8_STAGE(PG8_SA(0, 0), a2, voffA);
            PG8_BAR; PG8_WAIT_L(0); PG8_MMA(1, 0, At, B0); PG8_BAR; PG8_SCHED;
            PG8_STAGE(PG8_SB(0, 1), b2 + hstepB, voffB);
            PG8_WAIT_V(6); PG8_BAR; PG8_MMA(1, 1, At, B1); PG8_BAR;
            PG8_LDB(B0, 1, 0); PG8_SCHED; PG8_LDA(At, 1, 0); PG8_STAGE(PG8_SA(0, 1), a2 + hstepA, voffA);
            PG8_WAIT_L(8); PG8_BAR; PG8_WAIT_L(0); PG8_MMA(0, 0, At, B0); PG8_BAR; PG8_SCHED;
            PG8_LDB(B1, 1, 1); PG8_STAGE(PG8_SB(1, 0), b3, voffB);
            PG8_BAR; PG8_WAIT_L(0); PG8_MMA(0, 1, At, B1); PG8_BAR;
            PG8_LDA(At, 1, 1); PG8_STAGE(PG8_SA(1, 0), a3, voffA);
            PG8_BAR; PG8_WAIT_L(0); PG8_MMA(1, 0, At, B0); PG8_BAR; PG8_SCHED;
            PG8_STAGE(PG8_SB(1, 1), b3 + hstepB, voffB);
            PG8_WAIT_V(6); PG8_BAR; PG8_MMA(1, 1, At, B1); PG8_BAR;
            }
        }
        if constexpr (ALIGN_EPI) { if (wr == 0) PG8_BAR; }
        if constexpr (!Epi::AFTER_DRAIN) { E(acc, cur, wr, wc, fr, fq); S.done(cur); }
        if (!has_next) break;
#pragma unroll
        for (int a = 0; a < 2; ++a)
#pragma unroll
            for (int b = 0; b < 2; ++b)
#pragma unroll
                for (int m = 0; m < 4; ++m)
#pragma unroll
                    for (int n = 0; n < 2; ++n) acc[a][b][m][n] = (f32x4){0.f, 0.f, 0.f, 0.f};
        cur = nxt; cA = nA; cB = nB; ++ui;
        if constexpr (ALIGN_EPI) { if (wr == 1) PG8_BAR; }
    }
    PG8_WAIT_V(0);
    if constexpr (!ALIGN_EPI) { if (wr == 0) PG8_BAR; }
    PG8_BAR;
    if constexpr (Epi::AFTER_DRAIN) { E.fused(acc, cur, wr, wc, fr, fq, lds, wid, lane); S.done(cur); }
#undef PG8_SA
#undef PG8_SB
#undef PG8_STAGE
#undef PG8_LDA
#undef PG8_LDB
#undef PG8_MMA
#undef PG8_WAIT_V
#undef PG8_WAIT_L
#undef PG8_BAR
#undef PG8_SCHED
}
}

#define LAS __attribute__((address_space(3)))
typedef unsigned short bf16;
typedef float f32x4 __attribute__((ext_vector_type(4)));
typedef float f32x2 __attribute__((ext_vector_type(2)));
typedef unsigned u32x4 __attribute__((ext_vector_type(4)));
typedef unsigned u32x2 __attribute__((ext_vector_type(2)));
typedef short bf16x8 __attribute__((ext_vector_type(8)));
typedef short s16x4 __attribute__((ext_vector_type(4)));

constexpr int NTHR = 512, NWAVES = 8;
constexpr int DM = 1024, BATCH = 2, SEQ = 8192, CTXL = 256;
constexpr int ML = BATCH * SEQ, MC = BATCH * CTXL, MT = ML + MC;
constexpr int DFF = 2816, NMODV = 9 * DM, INW = 5632;
constexpr int PLD = 2048;
constexpr int RW_LA = 1536, RW_LB = 1760, RW_Y = 1536;
constexpr int NCH_RET = 66;
constexpr size_t MiB = 1u << 20;
constexpr size_t WS_BAR = 112 * 1024;
constexpr size_t WS_MODV = 0;
constexpr size_t WS_GU1 = 12 * MiB, WS_D1 = 23 * MiB, WS_WIN = WS_D1 + 11 * MiB / 2, WS_WG = WS_WIN + 8 * MiB, WS_RO = WS_WG + 4 * MiB, WS_RWO = WS_RO + MiB,
                 WS_WOUT = WS_RWO + MiB, WS_GU2 = WS_WOUT + 2 * MiB, WS_D2 = WS_GU2 + 11 * MiB, WS_U = WS_D2 + 11 * MiB / 2;
static_assert(WS_U == 61 * MiB, "ws map");
constexpr size_t WS_HC = WS_U + 33 * MiB, WS_BIG = WS_HC + 2 * MiB;
constexpr size_t WS_ACT = WS_BIG, WS_PRET = WS_BIG, WS_PRW = WS_BIG + 66 * MiB, WS_Y1 = WS_BIG + 132 * MiB;
constexpr size_t WS_RETKV = WS_U;
constexpr size_t WS_INVN = WS_GU1, WS_HW = WS_INVN + 3 * MiB / 4, WS_HA = WS_HW + 17 * MiB / 4, WS_HG = WS_HA + 17 * MiB / 4;
static_assert(WS_HG + (size_t)MT * 96 * 4 <= WS_WIN, "small arrays");
static_assert(WS_Y1 + (size_t)ML * 512 * 2 <= 256 * MiB, "ws end");

struct Params { const float* in[36]; float* out; unsigned char* ws; int ph_lo, ph_hi; };

__device__ __forceinline__ unsigned f2bf(float f) { unsigned u = __float_as_uint(f); return (u + 0x7fffu + ((u >> 16) & 1u)) >> 16; }
__device__ __forceinline__ unsigned pk2(float lo, float hi) { return f2bf(lo) | (f2bf(hi) << 16); }
__device__ __forceinline__ float bflo(unsigned w) { return __uint_as_float(w << 16); }
__device__ __forceinline__ float bfhi(unsigned w) { return __uint_as_float(w & 0xffff0000u); }
__device__ __forceinline__ float bf1(bf16 h) { return __uint_as_float((unsigned)h << 16); }
__device__ __forceinline__ float sigmoidf_(float x) { return __builtin_amdgcn_rcpf(1.0f + __expf(-x)); }
__device__ __forceinline__ float wave_sum(float v) {
#pragma unroll
    for (int o = 1; o < 64; o <<= 1) v += __shfl_xor(v, o);
    return v;
}
template <int CTRL> __device__ __forceinline__ float dpp_add(float v) { return v + __int_as_float(__builtin_amdgcn_update_dpp(0, __float_as_int(v), CTRL, 0xF, 0xF, true)); }
__device__ __forceinline__ float sum4(float v) { v = dpp_add<0xB1>(v); v = dpp_add<0x4E>(v); return v; }
__device__ __forceinline__ float sum8(float v) { v = sum4(v); v = dpp_add<0x141>(v); return v; }
__device__ __forceinline__ float sum16(float v) { v = sum8(v); v = dpp_add<0x140>(v); return v; }
__device__ __forceinline__ int mod_set(int R) { return R < SEQ ? 0 : (R < ML ? 1 : 2); }
__device__ __forceinline__ bool has_prev(int R) { return R < ML ? (R & (SEQ - 1)) != 0 : ((R - ML) & (CTXL - 1)) != 0; }
__device__ __forceinline__ bool has_next(int R) { return R < ML ? (R & (SEQ - 1)) != SEQ - 1 : ((R - ML) & (CTXL - 1)) != CTXL - 1; }


#define GAS __attribute__((address_space(1)))
#define XB_TMO      128
#define XB_XCNT(j)  (256  + 64 * (j))
#define XB_XSUB(j)  (1280 + 64 * (j))
#define XB_XGEN(j)  (2304 + 64 * (j))
#define XB_TOP      3328
#define XB_TOPGEN   3392
#define XCD_BAR_WORDS 3456
#define XB_SPIN_CAP (1u << 18)

__device__ __forceinline__ unsigned xb_ld(unsigned* p)              { return __hip_atomic_load(p, __ATOMIC_RELAXED, __HIP_MEMORY_SCOPE_AGENT); }
__device__ __forceinline__ unsigned xb_add(unsigned* p, unsigned v) { return __hip_atomic_fetch_add(p, v, __ATOMIC_RELAXED, __HIP_MEMORY_SCOPE_AGENT); }
__device__ __forceinline__ unsigned xb_xcc_id() { return (unsigned)__builtin_amdgcn_s_getreg((3 << 11) | 20) & 0xFu; }
#define XB_SPIN(cond, bar) do { unsigned _sp = 0; while (cond) { __builtin_amdgcn_s_sleep(1); \
    if ((++_sp & 255u) == 0u) { if (xb_ld(&(bar)[XB_TMO])) break; if (_sp > XB_SPIN_CAP) { atomicAdd(&(bar)[XB_TMO], 1u); break; } } } } while (0)

struct XcdBarrier {
    unsigned* bar; unsigned x;
    volatile LAS unsigned* st;
};

__device__ __forceinline__ XcdBarrier xcd_barrier_post(unsigned* bar, volatile LAS unsigned* st) {
    XcdBarrier b; b.bar = bar; b.x = xb_xcc_id(); b.st = st;
    if (threadIdx.x == 0) (void)xb_add(&bar[XB_XCNT(b.x)], 1u);
    return b;
}
__device__ __forceinline__ void xcd_barrier_complete(unsigned* bar, unsigned x, unsigned& nloc, unsigned& nx) {
    const unsigned G = gridDim.x * gridDim.y * gridDim.z;
    unsigned sum, cnt, mine, sp = 0u;
    for (;;) {
        sum = 0u; cnt = 0u; mine = 0u;
#pragma unroll
        for (unsigned j = 0; j < 16; ++j) { const unsigned c = xb_ld(&bar[XB_XCNT(j)]); sum += c; cnt += (c > 0u) ? 1u : 0u; mine = (j == x) ? c : mine; }
        if (sum == G) break;
        __builtin_amdgcn_s_sleep(1);
        if ((++sp & 255u) == 0u) { if (xb_ld(&bar[XB_TMO])) break; if (sp > XB_SPIN_CAP) { atomicAdd(&bar[XB_TMO], 1u); break; } }
    }
    nloc = mine > 0u ? mine : 1u; nx = cnt > 0u ? cnt : 1u;
}

__device__ __forceinline__ void xcd_barrier(const XcdBarrier& b) {
    asm volatile("s_waitcnt vmcnt(0)" ::: "memory");
    __syncthreads();
    if (threadIdx.x == 0) {
        unsigned* bar = b.bar;
        __builtin_amdgcn_s_waitcnt(0);
        unsigned nloc = b.st[0], nx = b.st[1];
        if (nloc == 0u) { xcd_barrier_complete(bar, b.x, nloc, nx); b.st[0] = nloc; b.st[1] = nx; }
        const unsigned old = xb_add(&bar[XB_XSUB(b.x)], 1u);
        const unsigned gen = old / nloc;
        if (old + 1u == (gen + 1u) * nloc) {
            __builtin_amdgcn_fence(__ATOMIC_RELEASE, "agent");
            asm volatile("s_waitcnt vmcnt(0)" ::: "memory");
            const unsigned og = xb_add(&bar[XB_TOP], 1u);
            const unsigned tg = og / nx;
            if (og + 1u == (tg + 1u) * nx) xb_add(&bar[XB_TOPGEN], 1u);
            else XB_SPIN(xb_ld(&bar[XB_TOPGEN]) == tg, bar);
            __builtin_amdgcn_fence(__ATOMIC_ACQUIRE, "agent");
            xb_add(&bar[XB_XGEN(b.x)], 1u);
            asm volatile("s_waitcnt vmcnt(0)" ::: "memory");
        } else {
            XB_SPIN(xb_ld(&bar[XB_XGEN(b.x)]) == gen, bar);
            __builtin_amdgcn_fence(__ATOMIC_ACQUIRE, "agent");
            asm volatile("s_waitcnt vmcnt(0)" ::: "memory");
        }
    }
    __syncthreads();
}

using pg8::Unit;
struct EpiSwiGLU {
    static constexpr bool PERM = true, AFTER_DRAIN = false;
    bf16* O; int ldo;
    __device__ __forceinline__ void operator()(const f32x4 (&acc)[2][2][4][2], const Unit& u, int wr, int wc, int fr, int fq) const {
        const int row0 = u.pm * 256 + wr * 64 + fr, col0 = u.pn * 128 + wc * 32 + 8 * fq;
#pragma unroll
        for (int ai = 0; ai < 2; ++ai)
#pragma unroll
            for (int m = 0; m < 4; ++m) {
                bf16* rowp = O + (size_t)(row0 + ai * 128 + m * 16) * ldo + col0;
                float v[8];
#pragma unroll
                for (int n = 0; n < 2; ++n)
#pragma unroll
                    for (int i = 0; i < 4; ++i) { const float g = acc[ai][0][m][n][i], up = acc[ai][1][m][n][i]; v[4 * n + i] = g * sigmoidf_(g) * up; }
                u32x4 w; w.x = pg8::cvt_pk_bf16(v[0], v[1]); w.y = pg8::cvt_pk_bf16(v[2], v[3]); w.z = pg8::cvt_pk_bf16(v[4], v[5]); w.w = pg8::cvt_pk_bf16(v[6], v[7]);
                *(u32x4*)rowp = w;
            }
    }
};
struct EpiResid {
    static constexpr bool PERM = false, AFTER_DRAIN = false;
    const float* base_lat; const float* base_ctx; float* out_lat; float* out_ctx; const float* modv; int modoff; float sc;
    __device__ __forceinline__ void operator()(const f32x4 (&acc)[2][2][4][2], const Unit& u, int wr, int wc, int fr, int fq) const {
        const bool isc = u.pm >= 64; const int pml = isc ? u.pm - 64 : u.pm;
        const float* base = isc ? base_ctx : base_lat; float* out = isc ? out_ctx : out_lat;
        const float* gate = modv + (isc ? 2 : (u.pm >= 32 ? 1 : 0)) * NMODV + modoff;
        const int col0 = u.pn * 256 + wc * 32 + 4 * fq;
        f32x4 gv[2][2];
#pragma unroll
        for (int bj = 0; bj < 2; ++bj)
#pragma unroll
            for (int n = 0; n < 2; ++n) gv[bj][n] = *(const f32x4*)(gate + col0 + bj * 128 + n * 16) * sc;
#pragma unroll
        for (int ai = 0; ai < 2; ++ai)
#pragma unroll
            for (int m = 0; m < 4; ++m) {
                const size_t off = (size_t)(pml * 256 + ai * 128 + wr * 64 + m * 16 + fr) * DM + col0;
#pragma unroll
                for (int bj = 0; bj < 2; ++bj)
#pragma unroll
                    for (int n = 0; n < 2; ++n) { const f32x4 b = *(const f32x4*)(base + off + bj * 128 + n * 16); *(f32x4*)(out + off + bj * 128 + n * 16) = b + gv[bj][n] * acc[ai][bj][m][n]; }
                asm volatile("" ::: "memory");
            }
    }
};
template <int MODE, bool SPLIT> struct EpiB {
    static constexpr bool PERM = true, AFTER_DRAIN = false;
    bf16* O; bf16* O2; const bf16* X; int ld;
    __device__ __forceinline__ void operator()(const f32x4 (&acc)[2][2][4][2], const Unit& u, int wr, int wc, int fr, int fq) const {
        int pn = u.pn; bf16* Ob = O; if (SPLIT && pn >= 8) { pn -= 8; Ob = O2; }
        const int row0 = u.pm * 256 + wr * 64 + fr, col0 = pn * 256 + wc * 32 + 8 * fq;
#pragma unroll
        for (int ai = 0; ai < 2; ++ai)
#pragma unroll
            for (int m = 0; m < 4; ++m) {
                const size_t off = (size_t)(row0 + ai * 128 + m * 16) * ld + col0;
#pragma unroll
                for (int bj = 0; bj < 2; ++bj) {
                    float v[8];
#pragma unroll
                    for (int n = 0; n < 2; ++n)
#pragma unroll
                        for (int i = 0; i < 4; ++i) v[4 * n + i] = acc[ai][bj][m][n][i];
                    if (MODE == 1) { const u32x4 o = *(const u32x4*)(Ob + off + bj * 128);
                        const unsigned ow[4] = {o.x, o.y, o.z, o.w};
#pragma unroll
                        for (int i = 0; i < 4; ++i) { v[2 * i] = sigmoidf_(v[2 * i]) * bflo(ow[i]); v[2 * i + 1] = sigmoidf_(v[2 * i + 1]) * bfhi(ow[i]); } }
                    if (MODE == 2) { const u32x4 o = *(const u32x4*)(Ob + off + bj * 128); const u32x4 x = *(const u32x4*)(X + off + bj * 128);
                        const unsigned ow[4] = {o.x, o.y, o.z, o.w}, xw[4] = {x.x, x.y, x.z, x.w};
#pragma unroll
                        for (int i = 0; i < 4; ++i) { v[2 * i] = bflo(ow[i]) + sigmoidf_(v[2 * i]) * bflo(xw[i]); v[2 * i + 1] = bfhi(ow[i]) + sigmoidf_(v[2 * i + 1]) * bfhi(xw[i]); } }
                    u32x4 w; w.x = pg8::cvt_pk_bf16(v[0], v[1]); w.y = pg8::cvt_pk_bf16(v[2], v[3]); w.z = pg8::cvt_pk_bf16(v[4], v[5]); w.w = pg8::cvt_pk_bf16(v[6], v[7]);
                    *(u32x4*)(Ob + off + bj * 128) = w;
                }
                asm volatile("" ::: "memory");
            }
    }
};

__device__ __forceinline__ void tr_item(const float* W, int ldw, int K, int c0, int kb, bf16* WT, int drow, const float* mu, float sa, float sb, LAS float* scr, int lane) {
    const int k0 = 64 * kb;
#pragma unroll 8
    for (int i = 0; i < 32; ++i) { const int kk = 2 * i + (lane >> 5); float v = W[(size_t)(k0 + kk) * ldw + c0 + (lane & 31)]; if (mu) v *= sa + sb * mu[k0 + kk]; scr[kk * 33 + (lane & 31)] = v; }
    asm volatile("s_waitcnt lgkmcnt(0)" ::: "memory");
    const int c = lane & 7;
#pragma unroll
    for (int j = 0; j < 4; ++j) { const int n = (lane >> 3) + 8 * j; const LAS float* s = scr + (8 * c) * 33 + n;
        u32x4 o; o.x = pk2(s[0 * 33], s[1 * 33]); o.y = pk2(s[2 * 33], s[3 * 33]); o.z = pk2(s[4 * 33], s[5 * 33]); o.w = pk2(s[6 * 33], s[7 * 33]);
        *(u32x4*)(WT + (size_t)(drow + n) * K + k0 + 8 * c) = o; }
    asm volatile("s_waitcnt lgkmcnt(0)" ::: "memory");
}
struct TrJob { const float* W; int ldw, K, c0, nc; bf16* WT; int mode, r0; const float* mu; float sa, sb; };
constexpr int NTRJOB = 21;
__device__ __forceinline__ TrJob tr_job(int j, const Params& p) {
    unsigned char* ws = p.ws; TrJob J; J.mu = nullptr; J.sa = 1.f; J.sb = 0.f; J.mode = 0; J.r0 = 0; J.c0 = 0;
    const float* mux = p.in[15];
    switch (j) {
    case 0: J.W = p.in[7]; J.ldw = DFF; J.K = DM; J.nc = DFF; J.WT = (bf16*)(ws + WS_GU1); J.mode = 1; break;
    case 1: J.W = p.in[8]; J.ldw = DFF; J.K = DM; J.nc = DFF; J.WT = (bf16*)(ws + WS_GU1); J.mode = 2; break;
    case 2: J.W = p.in[9]; J.ldw = DM; J.K = DFF; J.nc = DM; J.WT = (bf16*)(ws + WS_D1); break;
    case 3: J.W = p.in[11]; J.ldw = INW; J.K = DM; J.nc = 3584; J.WT = (bf16*)(ws + WS_WIN); break;
    case 4: J.W = p.in[11]; J.ldw = INW; J.K = DM; J.c0 = 3584; J.nc = 2048; J.WT = (bf16*)(ws + WS_WG); break;
    case 5: J.W = p.in[17]; J.ldw = 32; J.K = DM; J.nc = 32; J.WT = (bf16*)(ws + WS_WIN); J.r0 = 3584; J.mu = mux; J.sa = 1.f; J.sb = -1.f; break;
    case 6: J.W = p.in[17] + DM * 32; J.ldw = 32; J.K = DM; J.nc = 32; J.WT = (bf16*)(ws + WS_WIN); J.r0 = 3616; J.mu = mux; J.sa = 1.f; J.sb = -1.f; break;
    case 7: J.W = p.in[20]; J.ldw = 32; J.K = DM; J.nc = 32; J.WT = (bf16*)(ws + WS_WIN); J.r0 = 3648; J.mu = mux + DM; J.sa = 1.f; J.sb = -1.f; break;
    case 8: J.W = p.in[20] + DM * 32; J.ldw = 32; J.K = DM; J.nc = 32; J.WT = (bf16*)(ws + WS_WIN); J.r0 = 3680; J.mu = mux + DM; J.sa = 1.f; J.sb = -1.f; break;
    case 9: J.W = p.in[22]; J.ldw = 96; J.K = DM; J.nc = 96; J.WT = (bf16*)(ws + WS_WIN); J.r0 = 3712; J.mu = mux + 2 * DM; J.sa = 1.f; J.sb = -1.f; break;
    case 10: J.W = p.in[17]; J.ldw = 32; J.K = DM; J.nc = 32; J.WT = (bf16*)(ws + WS_WIN); J.r0 = 3808; J.mu = mux; J.sa = 0.f; J.sb = 1.f; break;
    case 11: J.W = p.in[17] + DM * 32; J.ldw = 32; J.K = DM; J.nc = 32; J.WT = (bf16*)(ws + WS_WIN); J.r0 = 3840; J.mu = mux; J.sa = 0.f; J.sb = 1.f; break;
    case 12: J.W = p.in[20]; J.ldw = 32; J.K = DM; J.nc = 32; J.WT = (bf16*)(ws + WS_WIN); J.r0 = 3872; J.mu = mux + DM; J.sa = 0.f; J.sb = 1.f; break;
    case 13: J.W = p.in[20] + DM * 32; J.ldw = 32; J.K = DM; J.nc = 32; J.WT = (bf16*)(ws + WS_WIN); J.r0 = 3904; J.mu = mux + DM; J.sa = 0.f; J.sb = 1.f; break;
    case 14: J.W = p.in[22]; J.ldw = 96; J.K = DM; J.nc = 96; J.WT = (bf16*)(ws + WS_WIN); J.r0 = 3936; J.mu = mux + 2 * DM; J.sa = 0.f; J.sb = 1.f; break;
    case 15: J.W = p.in[13]; J.ldw = DM; J.K = 512; J.nc = DM; J.WT = (bf16*)(ws + WS_RO); break;
    case 16: J.W = p.in[29]; J.ldw = DM; J.K = 512; J.nc = DM; J.WT = (bf16*)(ws + WS_RWO); break;
    case 17: J.W = p.in[30]; J.ldw = DM; J.K = DM; J.nc = DM; J.WT = (bf16*)(ws + WS_WOUT); break;
    case 18: J.W = p.in[32]; J.ldw = DFF; J.K = DM; J.nc = DFF; J.WT = (bf16*)(ws + WS_GU2); J.mode = 1; break;
    case 19: J.W = p.in[33]; J.ldw = DFF; J.K = DM; J.nc = DFF; J.WT = (bf16*)(ws + WS_GU2); J.mode = 2; break;
    default: J.W = p.in[34]; J.ldw = DM; J.K = DFF; J.nc = DM; J.WT = (bf16*)(ws + WS_D2); break;
    }
    return J;
}
__device__ __forceinline__ void p0_weights(const Params& p, LAS unsigned char* lds, int wave, int lane, int j0, int j1) {
    LAS float* scr = (LAS float*)(lds + wave * 16384);
    const int gw = blockIdx.x * NWAVES + wave, NGW = gridDim.x * NWAVES;
    int base = 0;
    for (int j = j0; j < j1; ++j) {
        const TrJob J = tr_job(j, p);
        const int nnb = J.nc / 32, nit = (J.K / 64) * nnb;
        int it = gw - (base % NGW); if (it < 0) it += NGW;
        for (; it < nit; it += NGW) {
            const int kb = it / nnb, nb = it % nnb, n0 = 32 * nb;
            const int drow = J.mode == 0 ? J.r0 + n0 : ((n0 >> 7) * 256 + (n0 & 127) + (J.mode == 2 ? 128 : 0));
            tr_item(J.W, J.ldw, J.K, J.c0 + n0, kb, J.WT, drow, J.mu, J.sa, J.sb, scr, lane);
        }
        base += nit;
    }
    if (j0 == 0) { u32x4* z = (u32x4*)((bf16*)(p.ws + WS_WIN) + (size_t)4032 * DM); const int n16 = 64 * DM * 2 / 16;
      for (int i = blockIdx.x * NTHR + threadIdx.x; i < n16; i += gridDim.x * NTHR) z[i] = (u32x4){0u, 0u, 0u, 0u}; }
}
__device__ __forceinline__ void p0_modv(const Params& p, LAS unsigned char* lds) {
    const float* c = p.in[1]; const float* cc = p.in[3]; const float* wm = p.in[4]; const float* bm = p.in[5];
    float* modv = (float*)(p.ws + WS_MODV);
    LAS float* red = (LAS float*)lds;
    const int tid = threadIdx.x, cl = tid & 15, kg = tid >> 4;
    for (int it = blockIdx.x; it < NMODV / 64; it += gridDim.x) {
        const int n0 = it * 64 + 4 * cl;
        f32x4 a0 = {0.f, 0.f, 0.f, 0.f}, a1 = a0, a2 = a0;
#pragma unroll 4
        for (int i = 0; i < 32; ++i) { const int k = kg * 32 + i; const f32x4 w = *(const f32x4*)(wm + (size_t)k * NMODV + n0);
            const float x0 = c[k], x1 = c[DM + k], x2 = cc[k];
            a0 += w * (x0 * sigmoidf_(x0)); a1 += w * (x1 * sigmoidf_(x1)); a2 += w * (x2 * sigmoidf_(x2)); }
        *(LAS f32x4*)(red + (kg * 3 + 0) * 64 + 4 * cl) = a0; *(LAS f32x4*)(red + (kg * 3 + 1) * 64 + 4 * cl) = a1; *(LAS f32x4*)(red + (kg * 3 + 2) * 64 + 4 * cl) = a2;
        __syncthreads();
        if (tid < 192) { const int s = tid >> 6, col = tid & 63; float v = bm[it * 64 + col];
            for (int g = 0; g < 32; ++g) v += red[(g * 3 + s) * 64 + col];
            modv[s * NMODV + it * 64 + col] = v; }
        __syncthreads();
    }
}
__device__ __forceinline__ void norm_rows(const float* hl, const float* hc, const float* g, const float* modv, int shift_off, int scale_off, bf16* U, int nrows, int wave, int lane) {
    const int gw = blockIdx.x * NWAVES + wave, NGW = gridDim.x * NWAVES;
    for (int R = gw; R < nrows; R += NGW) {
        const float* xr = (R < ML ? hl + (size_t)R * DM : hc + (size_t)(R - ML) * DM) + 4 * lane;
        f32x4 v[4]; float s = 0.f;
#pragma unroll
        for (int j = 0; j < 4; ++j) { v[j] = *(const f32x4*)(xr + 256 * j); s += (v[j].x * v[j].x + v[j].y * v[j].y) + (v[j].z * v[j].z + v[j].w * v[j].w); }
        const float rstd = 1.0f / sqrtf(wave_sum(s) * (1.0f / DM) + 1e-6f);
        const float* mv = modv + mod_set(R) * NMODV;
        u32x2* o = (u32x2*)(U + (size_t)R * DM + 4 * lane);
#pragma unroll
        for (int j = 0; j < 4; ++j) { const int col = 4 * lane + 256 * j; const f32x4 gg = *(const f32x4*)(g + col), sh = *(const f32x4*)(mv + shift_off + col), sc = *(const f32x4*)(mv + scale_off + col);
            const f32x4 y = (v[j] * rstd) * gg * (sc + 1.0f) + sh; u32x2 w; w.x = pk2(y.x, y.y); w.y = pk2(y.z, y.w); o[64 * j] = w; }
    }
}

__device__ __forceinline__ void p6_token_prep(const Params& p, int wave, int lane) {
    bf16* pret = (bf16*)(p.ws + WS_PRET); const bf16* prw = (const bf16*)(p.ws + WS_PRW);
    float* INVN = (float*)(p.ws + WS_INVN); float* HW = (float*)(p.ws + WS_HW); float* HA = (float*)(p.ws + WS_HA); float* HG = (float*)(p.ws + WS_HG);
    const float* mu_k = p.in[14] + 512; const float* k_k = p.in[24];
    const int gw = blockIdx.x * NWAVES + wave, NGW = gridDim.x * NWAVES;
    for (int R = gw; R < MT; R += NGW) {
        {
            const int P0 = 8 * lane, T = P0 >> 8, hd = (P0 >> 6) & 3, s = (P0 >> 5) & 1, i0 = P0 & 31;
            bf16* z1p = pret + (size_t)R * PLD + T * 512 + hd * 128 + s * 64 + i0;
            const u32x4 a = *(const u32x4*)z1p, b = *(const u32x4*)(z1p + 32);
            const unsigned aw[4] = {a.x, a.y, a.z, a.w}, bw[4] = {b.x, b.y, b.z, b.w};
            float z1[8], z2[8], o1[8], o2[8];
#pragma unroll
            for (int e = 0; e < 4; ++e) { z1[2 * e] = bflo(aw[e]); z1[2 * e + 1] = bfhi(aw[e]); z2[2 * e] = bflo(bw[e]); z2[2 * e + 1] = bfhi(bw[e]); }
            const bool lat = R < ML; const int t = R & (SEQ - 1); const float pos = (float)(s == 0 ? (t >> 6) : (t & 63));
            const float ksc = T == 1 ? 0.08838834764831845f : 1.0f;
#pragma unroll
            for (int e = 0; e < 8; ++e) {
                float cs = 1.f, sn = 0.f;
                if (lat) { const float inv = exp2f(-(float)(i0 + e) * 0.4152410118609203f); const float rev = pos * inv * 0.15915494309189535f; sn = __builtin_amdgcn_sinf(rev); cs = __builtin_amdgcn_cosf(rev); }
                o1[e] = (z1[e] * cs - z2[e] * sn) * ksc; o2[e] = (z1[e] * sn + z2[e] * cs) * ksc;
            }
            u32x4 w1, w2; w1.x = pk2(o1[0], o1[1]); w1.y = pk2(o1[2], o1[3]); w1.z = pk2(o1[4], o1[5]); w1.w = pk2(o1[6], o1[7]);
            w2.x = pk2(o2[0], o2[1]); w2.y = pk2(o2[2], o2[3]); w2.z = pk2(o2[4], o2[5]); w2.w = pk2(o2[6], o2[7]);
            *(u32x4*)z1p = w1; *(u32x4*)(z1p + 32) = w2;
        }
        const bool hp = has_prev(R), hn = has_next(R);
        const bf16* row = prw + (size_t)R * PLD; const bf16* rowp = row - PLD; const bf16* rown = row + PLD;
#pragma unroll
        for (int jj = 0; jj < 4; ++jj) { const int j = lane + 64 * jj;
            if (j < 224) { const float la = bf1(row[RW_LA + j]); const float lp = hp ? bf1(rowp[RW_LB + j]) : 0.f, ln = hn ? bf1(rown[RW_LB + j]) : 0.f;
                const float hv = la + 0.5f * (lp + ln);
                if (j < 64) HW[((size_t)(j >> 5) * MT + R) * 32 + (j & 31)] = 1.0f - 2.0f * __builtin_amdgcn_rcpf(__expf(2.0f * hv) + 1.0f);
                else if (j < 128) HA[((size_t)((j - 64) >> 5) * MT + R) * 32 + ((j - 64) & 31)] = hv;
                else HG[(size_t)R * 96 + (j - 128)] = sigmoidf_(hv); } }
        {
            const u32x4 kc = *(const u32x4*)(row + 512 + 8 * lane); u32x4 kp = {0u, 0u, 0u, 0u}, kn = {0u, 0u, 0u, 0u};
            if (hp) kp = *(const u32x4*)(rowp + 512 + 8 * lane); if (hn) kn = *(const u32x4*)(rown + 512 + 8 * lane);
            const unsigned cw[4] = {kc.x, kc.y, kc.z, kc.w}, pw[4] = {kp.x, kp.y, kp.z, kp.w}, nw[4] = {kn.x, kn.y, kn.z, kn.w};
            float ss = 0.f;
#pragma unroll
            for (int e = 0; e < 8; ++e) { const int c = 8 * lane + e; const float kcv = (e & 1) ? bfhi(cw[e >> 1]) : bflo(cw[e >> 1]), kpv = (e & 1) ? bfhi(pw[e >> 1]) : bflo(pw[e >> 1]), knv = (e & 1) ? bfhi(nw[e >> 1]) : bflo(nw[e >> 1]);
                const float k = kcv + mu_k[c] * (0.5f * (kpv + knv) - kcv); const float kr = k * k_k[c]; ss += kr * kr; }
            ss = sum8(ss);
            if ((lane & 7) == 0) INVN[(size_t)R * 8 + (lane >> 3)] = 1.0f / fmaxf(sqrtf(ss), 1e-12f);
        }
    }
}

__device__ __forceinline__ float ret_loggamma(const Params& p, int d, int h) { const float x = p.in[12][d * 4 + h]; return -log1pf(expf(-x)); }
__device__ __forceinline__ bf16x8 ld8(const bf16* ptr) { return *(const bf16x8*)ptr; }
__device__ __forceinline__ void ret_kv_local(const Params& p, LAS unsigned char* lds, int wave, int lane) {
    const bf16* pret = (const bf16*)(p.ws + WS_PRET); bf16* KV = (bf16*)(p.ws + WS_RETKV);
    LAS bf16* KT = (LAS bf16*)lds; LAS bf16* VT0 = KT + 128 * 136; LAS bf16* VT1 = VT0 + 128 * 136;
    const int tid = threadIdx.x, i16 = lane & 15, q = lane >> 4;
    for (int it = blockIdx.x; it < 2 * 4 * NCH_RET; it += gridDim.x) {
        const int cc = it % NCH_RET, h = (it / NCH_RET) & 3, b = it / (NCH_RET * 4);
        const int R0 = cc < 2 ? ML + b * CTXL + cc * 128 : b * SEQ + (cc - 2) * 128;
        const float l0 = ret_loggamma(p, 0, h) * 1.4426950408889634f, l1 = ret_loggamma(p, 1, h) * 1.4426950408889634f;
        __syncthreads();
#pragma unroll
        for (int i = 0; i < 4; ++i) { const int idx = tid + NTHR * i, tok = idx & 127, c8 = idx >> 7;
            const bf16* rp = pret + (size_t)(R0 + tok) * PLD + h * 128 + 8 * c8;
            const u32x4 kk = *(const u32x4*)(rp + 512), vv = *(const u32x4*)(rp + 1024);
            const unsigned kw[4] = {kk.x, kk.y, kk.z, kk.w}, vw[4] = {vv.x, vv.y, vv.z, vv.w};
            const float w0 = exp2f(l0 * (float)(127 - tok)), w1 = exp2f(l1 * (float)tok);
#pragma unroll
            for (int e = 0; e < 8; ++e) { const unsigned ke = (e & 1) ? (kw[e >> 1] >> 16) : (kw[e >> 1] & 0xffffu); const float ve = (e & 1) ? bfhi(vw[e >> 1]) : bflo(vw[e >> 1]);
                KT[(8 * c8 + e) * 136 + tok] = (bf16)ke; VT0[(8 * c8 + e) * 136 + tok] = (bf16)f2bf(ve * w0); VT1[(8 * c8 + e) * 136 + tok] = (bf16)f2bf(ve * w1); } }
        __syncthreads();
#pragma unroll
        for (int d = 0; d < 2; ++d) {
            const LAS bf16* VT = d ? VT1 : VT0;
            f32x4 acc[8];
#pragma unroll
            for (int ct = 0; ct < 8; ++ct) acc[ct] = (f32x4){0.f, 0.f, 0.f, 0.f};
#pragma unroll
            for (int ks = 0; ks < 4; ++ks) {
                const bf16x8 af = *(const LAS bf16x8*)(VT + (16 * wave + i16) * 136 + 32 * ks + 8 * q);
#pragma unroll
                for (int ct = 0; ct < 8; ++ct) { const bf16x8 bfr = *(const LAS bf16x8*)(KT + (16 * ct + i16) * 136 + 32 * ks + 8 * q);
                    acc[ct] = __builtin_amdgcn_mfma_f32_16x16x32_bf16(bfr, af, acc[ct], 0, 0, 0); }
            }
            bf16* o = KV + ((size_t)(((b * 4 + h) * 2 + d) * NCH_RET + cc) * 128 + 16 * wave + i16) * 128 + 4 * q;
#pragma unroll
            for (int ct = 0; ct < 8; ++ct) { u32x2 w; w.x = pk2(acc[ct][0], acc[ct][1]); w.y = pk2(acc[ct][2], acc[ct][3]); *(u32x2*)(o + 16 * ct) = w; }
        }
    }
}
__device__ __forceinline__ void ret_scan(const Params& p) {
    bf16* KV = (bf16*)(p.ws + WS_RETKV);
    for (int idx = blockIdx.x * NTHR + threadIdx.x; idx < 2 * 4 * 2 * 16384; idx += gridDim.x * NTHR) {
        const int e = idx & 16383, d = (idx >> 14) & 1, h = (idx >> 15) & 3, b = idx >> 17;
        const float dec = expf(128.0f * ret_loggamma(p, d, h));
        bf16* base = KV + (size_t)(((b * 4 + h) * 2 + d) * NCH_RET) * 16384 + e;
        float st = 0.f;
#pragma unroll 1
        for (int s0 = 0; s0 < NCH_RET; s0 += 22) {
            float t[22];
#pragma unroll
            for (int j = 0; j < 22; ++j) { const int s = s0 + j, cc = d == 0 ? s : (s < 2 ? 1 - s : NCH_RET + 1 - s); t[j] = bf1(base[(size_t)cc * 16384]); }
#pragma unroll
            for (int j = 0; j < 22; ++j) { const int s = s0 + j, cc = d == 0 ? s : (s < 2 ? 1 - s : NCH_RET + 1 - s); base[(size_t)cc * 16384] = (bf16)f2bf(st); st = dec * st + t[j]; }
        }
    }
}
__device__ __forceinline__ void ret_out(const Params& p, LAS unsigned char* lds, int wave, int lane, int first, int nblk) {
    bf16* pret = (bf16*)(p.ws + WS_PRET); const bf16* KV = (const bf16*)(p.ws + WS_RETKV);
    LAS bf16* VT = (LAS bf16*)lds;
    const int tid = threadIdx.x, i16 = lane & 15, q = lane >> 4;
    for (int it = (int)blockIdx.x - first; it < 2 * 4 * 64; it += nblk) {
        const int c = it & 63, h = (it >> 6) & 3, b = it >> 8;
        const int R0 = b * SEQ + c * 128;
        const float l0 = ret_loggamma(p, 0, h) * 1.4426950408889634f, l1 = ret_loggamma(p, 1, h) * 1.4426950408889634f;
        __syncthreads();
#pragma unroll
        for (int i = 0; i < 4; ++i) { const int idx = tid + NTHR * i, tok = idx & 127, c8 = idx >> 7;
            const u32x4 vv = *(const u32x4*)(pret + (size_t)(R0 + tok) * PLD + 1024 + h * 128 + 8 * c8);
            const unsigned vw[4] = {vv.x, vv.y, vv.z, vv.w};
#pragma unroll
            for (int e = 0; e < 8; ++e) VT[(8 * c8 + e) * 136 + tok] = (bf16)((e & 1) ? (vw[e >> 1] >> 16) : (vw[e >> 1] & 0xffffu)); }
        __syncthreads();
        const int tk = 16 * wave + i16;
        bf16* qrow = pret + (size_t)(R0 + tk) * PLD + h * 128;
        bf16x8 aq[4];
#pragma unroll
        for (int ks = 0; ks < 4; ++ks) aq[ks] = ld8(qrow + 32 * ks + 8 * q);
        bf16x8 pf[4];
        {
            f32x4 sacc[8];
#pragma unroll
            for (int ct = 0; ct < 8; ++ct) { sacc[ct] = (f32x4){0.f, 0.f, 0.f, 0.f};
                const bf16* krow = pret + (size_t)(R0 + 16 * ct + i16) * PLD + 512 + h * 128 + 8 * q;
#pragma unroll
                for (int ks = 0; ks < 4; ++ks) sacc[ct] = __builtin_amdgcn_mfma_f32_16x16x32_bf16(ld8(krow + 32 * ks), aq[ks], sacc[ct], 0, 0, 0); }
#pragma unroll
            for (int ct = 0; ct < 8; ++ct)
#pragma unroll
                for (int r = 0; r < 4; ++r) { const int s = 16 * ct + 4 * q + r; const int df = tk - s; sacc[ct][r] *= df >= 0 ? exp2f(l0 * (float)df) : exp2f(l1 * (float)(-df)); }
#pragma unroll
            for (int ks = 0; ks < 4; ++ks) { u32x4 w; w.x = pk2(sacc[2 * ks][0], sacc[2 * ks][1]); w.y = pk2(sacc[2 * ks][2], sacc[2 * ks][3]); w.z = pk2(sacc[2 * ks + 1][0], sacc[2 * ks + 1][1]); w.w = pk2(sacc[2 * ks + 1][2], sacc[2 * ks + 1][3]);
                pf[ks] = __builtin_bit_cast(bf16x8, w); }
        }
        const bf16* F = KV + (size_t)(((b * 4 + h) * 2 + 0) * NCH_RET + c + 2) * 16384; const bf16* G = KV + (size_t)(((b * 4 + h) * 2 + 1) * NCH_RET + c + 2) * 16384;
        const float s0 = exp2f(l0 * (float)(tk + 1)), s1 = exp2f(l1 * (float)(128 - tk));
        f32x4 y[8]; float sum = 0.f;
#pragma unroll
        for (int vt = 0; vt < 8; ++vt) {
            f32x4 ay = {0.f, 0.f, 0.f, 0.f}, a0 = ay, a1 = ay;
#pragma unroll
            for (int ks = 0; ks < 4; ++ks) {
                const LAS bf16* vp = VT + (16 * vt + i16) * 136 + 32 * ks + 4 * q;
                const u32x2 lo = *(const LAS u32x2*)vp, hi = *(const LAS u32x2*)(vp + 16);
                u32x4 w; w.x = lo.x; w.y = lo.y; w.z = hi.x; w.w = hi.y;
                ay = __builtin_amdgcn_mfma_f32_16x16x32_bf16(__builtin_bit_cast(bf16x8, w), pf[ks], ay, 0, 0, 0);
                a0 = __builtin_amdgcn_mfma_f32_16x16x32_bf16(ld8(F + (size_t)(16 * vt + i16) * 128 + 32 * ks + 8 * q), aq[ks], a0, 0, 0, 0);
                a1 = __builtin_amdgcn_mfma_f32_16x16x32_bf16(ld8(G + (size_t)(16 * vt + i16) * 128 + 32 * ks + 8 * q), aq[ks], a1, 0, 0, 0);
            }
            y[vt] = ay + a0 * s0 + a1 * s1; sum += (y[vt][0] + y[vt][1]) + (y[vt][2] + y[vt][3]);
        }
        sum += __shfl_xor(sum, 16); sum += __shfl_xor(sum, 32);
        const float mu = sum * (1.0f / 128.0f); float sq = 0.f;
#pragma unroll
        for (int vt = 0; vt < 8; ++vt) { y[vt] = y[vt] - mu; sq += (y[vt][0] * y[vt][0] + y[vt][1] * y[vt][1]) + (y[vt][2] * y[vt][2] + y[vt][3] * y[vt][3]); }
        sq += __shfl_xor(sq, 16); sq += __shfl_xor(sq, 32);
        const float rstd = 1.0f / sqrtf(sq * (1.0f / 128.0f) + 1e-5f);
#pragma unroll
        for (int vt = 0; vt < 8; ++vt) {
            const u32x2 gw = *(const u32x2*)(qrow + 1536 + 16 * vt + 4 * q);
            const float g0 = bflo(gw.x), g1 = bfhi(gw.x), g2 = bflo(gw.y), g3 = bfhi(gw.y);
            u32x2 w; w.x = pk2(y[vt][0] * rstd * g0 * sigmoidf_(g0), y[vt][1] * rstd * g1 * sigmoidf_(g1)); w.y = pk2(y[vt][2] * rstd * g2 * sigmoidf_(g2), y[vt][3] * rstd * g3 * sigmoidf_(g3));
            *(u32x2*)(qrow + 16 * vt + 4 * q) = w;
        }
    }
}

__device__ __forceinline__ int rw_row(int z, int b, int pp) {
    if (pp < CTXL) return ML + b * CTXL + (z ? CTXL - 1 - pp : pp);
    const int t = pp - CTXL; return b * SEQ + (z ? SEQ - 1 - t : t);
}

constexpr int RW_NSEG = 33, RW_WLDS = 18432;
constexpr size_t WS_SEGQ = WS_GU2;
constexpr size_t WS_SEGP0 = MiB / 4, WS_SEGP1 = WS_Y1 + 16 * MiB;
static_assert(WS_SEGQ + (size_t)32 * 32 * 16384 <= WS_U && WS_SEGP0 + (size_t)16 * 31 * 16384 <= WS_GU1 && WS_SEGP1 + (size_t)16 * 31 * 16384 <= 256 * MiB, "rwkv segment state map");
__device__ __forceinline__ float* segp_ptr(unsigned char* ws, int scan, int j) { return (float*)(ws + ((scan < 16) ? WS_SEGP0 : WS_SEGP1)) + ((size_t)(scan & 15) * 31 + (j - 1)) * 4096; }
typedef __bf16 bf16x2_ __attribute__((ext_vector_type(2)));
__device__ __forceinline__ unsigned cvtpk(float lo, float hi) { const f32x2 v = {lo, hi}; return __builtin_bit_cast(unsigned, __builtin_convertvector(v, bf16x2_)); }
__device__ __forceinline__ bf16x8 pack8(f32x4 a, f32x4 b) { u32x4 w; w.x = cvtpk(a[0], a[1]); w.y = cvtpk(a[2], a[3]); w.z = cvtpk(b[0], b[1]); w.w = cvtpk(b[2], b[3]); return __builtin_bit_cast(bf16x8, w); }
__device__ __forceinline__ bf16x8 ldperm(const LAS unsigned char* img, int l15, int q, int ks) {
    const LAS unsigned char* a = img + l15 * 144 + 64 * ks + 8 * q; const u32x2 lo = *(const LAS u32x2*)a, hi = *(const LAS u32x2*)(a + 32);
    u32x4 w; w.x = lo.x; w.y = lo.y; w.z = hi.x; w.w = hi.y; return __builtin_bit_cast(bf16x8, w);
}
constexpr size_t WS_W2P = 128 * 1024, WS_A2P = 192 * 1024;
#define MFMA16(a, b, c) __builtin_amdgcn_mfma_f32_16x16x32_bf16((a), (b), (c), 0, 0, 0)

template <int MODE>
__device__ __forceinline__ void rw_segment(const Params& p, LAS unsigned char* wl, int lane0, int scan, int seg, bool ident) {
    const int Z = scan >> 4, dir = Z ? -1 : 1; const int b = (scan >> 3) & 1, h = scan & 7;
    unsigned char* ws = p.ws;
    const bf16* prw = (const bf16*)(ws + WS_PRW);
    const float* INVN = (const float*)(ws + WS_INVN); const float* HW = (const float*)(ws + WS_HW) + (size_t)Z * MT * 32; const float* HA = (const float*)(ws + WS_HA) + (size_t)Z * MT * 32;
    const float mu_r = p.in[14][h * 64 + lane0], mu_k = p.in[14][512 + h * 64 + lane0], mu_v = p.in[14][1024 + h * 64 + lane0], k_k = p.in[24][h * 64 + lane0], k_a = p.in[25][h * 64 + lane0];
    LAS unsigned char* const IMG_A = wl, * const IMG_R = wl + 2304, * const IMG_B = wl + 4608, * const IMG_K = wl + 6912;
    LAS unsigned char* const T1 = wl, * const DV = wl + 4096;
    LAS unsigned char* const UT = wl + 9216, * const VT = wl + 11264, * const LWB = wl + 13312, * const LAB = wl + 15360;
    LAS unsigned char* const AAB = wl + 13312, * const AAK = wl + 14336, * const A2 = wl + 15360;
    f32x4 S[4][4];
    { const int l15 = lane0 & 15, q = lane0 >> 4;
    if (MODE == 2) { const float* sst = (const float*)(ws + WS_SEGQ) + ((size_t)scan * 32 + (seg - 1)) * 4096 + l15 * 64 + 4 * q;
#pragma unroll
        for (int vt = 0; vt < 4; ++vt)
#pragma unroll
            for (int ct = 0; ct < 4; ++ct) S[vt][ct] = *(const f32x4*)(sst + (16 * vt) * 64 + 16 * ct);
    } else {
#pragma unroll
        for (int vt = 0; vt < 4; ++vt)
#pragma unroll
            for (int ct = 0; ct < 4; ++ct)
#pragma unroll
                for (int r = 0; r < 4; ++r) S[vt][ct][r] = (ident && vt == ct && l15 == 4 * q + r) ? 1.0f : 0.0f;
    }
    }
    const int pp_start = seg * 256;
#pragma unroll 1
    for (int ci = 0; ci < 16; ++ci) {
        int lane_ = lane0; asm volatile("" : "+v"(lane_));
        const int lane = lane_, l15 = lane & 15, q = lane >> 4, hc = h * 64 + lane;
        const bf16x8* w2p = (const bf16x8*)(ws + WS_W2P) + (size_t)((Z * 8 + h) * 4) * 64 + lane; const bf16x8* a2p = (const bf16x8*)(ws + WS_A2P) + (size_t)((Z * 8 + h) * 4) * 64 + lane;
        const int R0 = rw_row(Z, b, pp_start + 16 * ci);
        {
            const int Rt = R0 + dir * l15;
            const float* hwp = HW + (size_t)Rt * 32 + 8 * q; const float* hap = HA + (size_t)Rt * 32 + 8 * q;
            const bf16x8 hwf = pack8(*(const f32x4*)hwp, *(const f32x4*)(hwp + 4)), haf = pack8(*(const f32x4*)hap, *(const f32x4*)(hap + 4));
#pragma unroll
            for (int ct = 0; ct < 4; ++ct) { const f32x4 z4 = {0.f, 0.f, 0.f, 0.f};
                const f32x4 d = MFMA16(hwf, w2p[64 * ct], z4), d2 = MFMA16(haf, a2p[64 * ct], z4);
                const float w0 = p.in[16][Z * 512 + h * 64 + 16 * ct + l15], a0 = p.in[19][Z * 512 + h * 64 + 16 * ct + l15];
                u32x2 w; w.x = cvtpk(-0.6065306597126334f * sigmoidf_(w0 + d[0]), -0.6065306597126334f * sigmoidf_(w0 + d[1]));
                w.y = cvtpk(-0.6065306597126334f * sigmoidf_(w0 + d[2]), -0.6065306597126334f * sigmoidf_(w0 + d[3]));
                *(LAS u32x2*)(LWB + (16 * ct + l15) * 32 + 8 * q) = w;
                w.x = cvtpk(sigmoidf_(a0 + d2[0]), sigmoidf_(a0 + d2[1])); w.y = cvtpk(sigmoidf_(a0 + d2[2]), sigmoidf_(a0 + d2[3]));
                *(LAS u32x2*)(LAB + (16 * ct + l15) * 32 + 8 * q) = w; }
        }
        const float invl = INVN[(size_t)(R0 + dir * l15) * 8 + h];
        const bool okp = Z ? has_next(R0) : has_prev(R0), okn = Z ? has_prev(R0 - 15) : has_next(R0 + 15);
        unsigned pkw[9], prw_[9], pvw[9];
#pragma unroll
        for (int m = 0; m < 9; ++m) { const bf16* r0 = prw + (size_t)(R0 + dir * (2 * m - 1)) * PLD + hc; const bf16* r1 = prw + (size_t)(R0 + dir * (2 * m)) * PLD + hc;
            const bool ok0 = m > 0 || okp, ok1 = m < 8 || okn;
            pkw[m] = (ok0 ? (unsigned)r0[512] : 0u) | ((ok1 ? (unsigned)r1[512] : 0u) << 16);
            if (MODE == 2) prw_[m] = (ok0 ? (unsigned)r0[0] : 0u) | ((ok1 ? (unsigned)r1[0] : 0u) << 16);
            pvw[m] = ident ? 0u : ((ok0 ? (unsigned)r0[1024] : 0u) | ((ok1 ? (unsigned)r1[1024] : 0u) << 16)); }
#define RWPOS(arr, j) (((j) & 1) ? bfhi(arr[(j) >> 1]) : bflo(arr[(j) >> 1]))
        asm volatile("" ::: "memory");
        unsigned lww[8], law[8];
        { const u32x4 a = *(const LAS u32x4*)(LWB + lane * 32), c = *(const LAS u32x4*)(LWB + lane * 32 + 16), d = *(const LAS u32x4*)(LAB + lane * 32), e = *(const LAS u32x4*)(LAB + lane * 32 + 16);
          lww[0] = a.x; lww[1] = a.y; lww[2] = a.z; lww[3] = a.w; lww[4] = c.x; lww[5] = c.y; lww[6] = c.z; lww[7] = c.w;
          law[0] = d.x; law[1] = d.y; law[2] = d.z; law[3] = d.w; law[4] = e.x; law[5] = e.y; law[6] = e.z; law[7] = e.w; }
        float cum = 0.f, Eprev = 1.f, Elast = 1.f;
        float ve = 0.f;
#pragma unroll
        for (int i = 0; i < 16; ++i) {
            const int idx = i + 1;
            const float lw = (i & 1) ? bfhi(lww[i >> 1]) : bflo(lww[i >> 1]); cum += lw;
            const float E = __expf(cum), Einv = __builtin_amdgcn_rcpf(E);
            const float asig = (i & 1) ? bfhi(law[i >> 1]) : bflo(law[i >> 1]);
            const float kc_ = RWPOS(pkw, idx); const float k = kc_ + mu_k * (0.5f * (RWPOS(pkw, idx - 1) + RWPOS(pkw, idx + 1)) - kc_);
            const float invn = __int_as_float(__builtin_amdgcn_readlane(__float_as_int(invl), i));
            const float kk = k * k_k * invn, keff = k * (1.0f + (asig - 1.0f) * k_a);
            const float at = -kk * Eprev, bh = kk * asig * Einv, kh = keff * Einv;
            const unsigned wab = cvtpk(at, bh);
            *(LAS unsigned short*)(IMG_A + i * 144 + lane * 2) = (unsigned short)(wab & 0xffffu); *(LAS unsigned short*)(IMG_B + i * 144 + lane * 2) = (unsigned short)(wab >> 16);
            float rt = 0.f;
            if (MODE == 2) { const float rc_ = RWPOS(prw_, idx); const float r = rc_ + mu_r * (0.5f * (RWPOS(prw_, idx - 1) + RWPOS(prw_, idx + 1)) - rc_); rt = r * (Z == 0 ? E : Eprev); }
            const unsigned wkr = cvtpk(kh, rt);
            *(LAS unsigned short*)(IMG_K + i * 144 + lane * 2) = (unsigned short)(wkr & 0xffffu); if (MODE == 2) *(LAS unsigned short*)(IMG_R + i * 144 + lane * 2) = (unsigned short)(wkr >> 16);
            float v = 0.f;
            { const float vc_ = RWPOS(pvw, idx); v = vc_ + mu_v * (0.5f * (RWPOS(pvw, idx - 1) + RWPOS(pvw, idx + 1)) - vc_);
                if (i & 1) *(LAS unsigned*)(VT + lane * 32 + 2 * (i - 1)) = cvtpk(ve, v); else ve = v; }
            Eprev = E; Elast = E;
        }
        asm volatile("" ::: "memory");
        bf16x8 fA[2], fB[2], fK[2], fR[2];
#pragma unroll
        for (int ks = 0; ks < 2; ++ks) { fA[ks] = ldperm(IMG_A, l15, q, ks); fB[ks] = ldperm(IMG_B, l15, q, ks); fK[ks] = ldperm(IMG_K, l15, q, ks); if (MODE == 2) fR[ks] = ldperm(IMG_R, l15, q, ks); }
        bf16x8 bkf[4];
        { const unsigned ta = (unsigned)(size_t)(q < 2 ? IMG_B : IMG_K) + (unsigned)((8 * (q & 1) + (l15 >> 2)) * 144 + 8 * (l15 & 3));
          u32x2 t0, t1, t2, t3, t4, t5, t6, t7;
          asm volatile("ds_read_b64_tr_b16 %0, %8\n\tds_read_b64_tr_b16 %1, %8 offset:576\n\tds_read_b64_tr_b16 %2, %8 offset:32\n\tds_read_b64_tr_b16 %3, %8 offset:608\n\t"
                       "ds_read_b64_tr_b16 %4, %8 offset:64\n\tds_read_b64_tr_b16 %5, %8 offset:640\n\tds_read_b64_tr_b16 %6, %8 offset:96\n\tds_read_b64_tr_b16 %7, %8 offset:672\n\ts_waitcnt lgkmcnt(0)"
                       : "=&v"(t0), "=&v"(t1), "=&v"(t2), "=&v"(t3), "=&v"(t4), "=&v"(t5), "=&v"(t6), "=&v"(t7) : "v"(ta) : "memory");
          bkf[0] = __builtin_bit_cast(bf16x8, (u32x4){t0.x, t0.y, t1.x, t1.y}); bkf[1] = __builtin_bit_cast(bf16x8, (u32x4){t2.x, t2.y, t3.x, t3.y});
          bkf[2] = __builtin_bit_cast(bf16x8, (u32x4){t4.x, t4.y, t5.x, t5.y}); bkf[3] = __builtin_bit_cast(bf16x8, (u32x4){t6.x, t6.y, t7.x, t7.y}); }
        asm volatile("" ::: "memory");
        {
            f32x4 gab = {0.f, 0.f, 0.f, 0.f}, gak = gab, grb = gab, grk = gab;
#pragma unroll
            for (int ks = 0; ks < 2; ++ks) { gab = MFMA16(fB[ks], fA[ks], gab); gak = MFMA16(fK[ks], fA[ks], gak); if (MODE == 2) { grb = MFMA16(fB[ks], fR[ks], grb); grk = MFMA16(fK[ks], fR[ks], grk); } }
#pragma unroll
            for (int r = 0; r < 4; ++r) { const int s = 4 * q + r; if (!(s < l15)) { gab[r] = 0.f; gak[r] = 0.f; } if (!(Z == 0 ? s <= l15 : s < l15)) { grb[r] = 0.f; grk[r] = 0.f; } }
            *(LAS f32x4*)(AAB + l15 * 64 + 16 * q) = gab; *(LAS f32x4*)(AAK + l15 * 64 + 16 * q) = gak;
            if (MODE == 2) { u32x2 w; w.x = cvtpk(grb[0], grb[1]); w.y = cvtpk(grb[2], grb[3]); *(LAS u32x2*)(A2 + l15 * 80 + 8 * q) = w;
                             w.x = cvtpk(grk[0], grk[1]); w.y = cvtpk(grk[2], grk[3]); *(LAS u32x2*)(A2 + l15 * 80 + 32 + 8 * q) = w; }
            *(LAS float*)(DV + lane * 4) = Elast;
        }
        f32x4 yp[4];
#pragma unroll
        for (int vt = 0; vt < 4; ++vt) { const bf16x8 sf0 = pack8(S[vt][0], S[vt][1]), sf1 = pack8(S[vt][2], S[vt][3]);
            f32x4 t1 = {0.f, 0.f, 0.f, 0.f}; t1 = MFMA16(fA[0], sf0, t1); t1 = MFMA16(fA[1], sf1, t1);
            *(LAS f32x4*)(T1 + (16 * vt + l15) * 64 + 16 * q) = t1;
            if (MODE == 2) { f32x4 y = {0.f, 0.f, 0.f, 0.f}; y = MFMA16(sf0, fR[0], y); y = MFMA16(sf1, fR[1], y); yp[vt] = y; } }
        asm volatile("" ::: "memory");
        float U[16]; unsigned vw_[8];
        { const u32x4 a = *(const LAS u32x4*)(VT + lane * 32), c = *(const LAS u32x4*)(VT + lane * 32 + 16); vw_[0] = a.x; vw_[1] = a.y; vw_[2] = a.z; vw_[3] = a.w; vw_[4] = c.x; vw_[5] = c.y; vw_[6] = c.z; vw_[7] = c.w; }
        { const f32x4 t0 = *(const LAS f32x4*)(T1 + lane * 64), t1 = *(const LAS f32x4*)(T1 + lane * 64 + 16), t2 = *(const LAS f32x4*)(T1 + lane * 64 + 32), t3 = *(const LAS f32x4*)(T1 + lane * 64 + 48);
#pragma unroll
          for (int r = 0; r < 4; ++r) { U[r] = t0[r]; U[4 + r] = t1[r]; U[8 + r] = t2[r]; U[12 + r] = t3[r]; } }
#pragma unroll
        for (int i = 1; i < 16; ++i) {
            float acc = U[i];
#pragma unroll
            for (int g = 0; g <= (i - 1) >> 2; ++g) { const f32x4 ab = *(const LAS f32x4*)(AAB + i * 64 + 16 * g);
#pragma unroll
                for (int r = 0; r < 4; ++r) if (4 * g + r < i) acc += ab[r] * U[4 * g + r];
                { const f32x4 ak = *(const LAS f32x4*)(AAK + i * 64 + 16 * g);
#pragma unroll
                    for (int r = 0; r < 4; ++r) if (4 * g + r < i) acc += ak[r] * ((r & 1) ? bfhi(vw_[(4 * g + r) >> 1]) : bflo(vw_[(4 * g + r) >> 1])); } }
            U[i] = acc;
        }
        { u32x4 w0_, w1_; w0_.x = cvtpk(U[0], U[1]); w0_.y = cvtpk(U[2], U[3]); w0_.z = cvtpk(U[4], U[5]); w0_.w = cvtpk(U[6], U[7]);
          w1_.x = cvtpk(U[8], U[9]); w1_.y = cvtpk(U[10], U[11]); w1_.z = cvtpk(U[12], U[13]); w1_.w = cvtpk(U[14], U[15]);
          *(LAS u32x4*)(UT + lane * 32) = w0_; *(LAS u32x4*)(UT + lane * 32 + 16) = w1_; }
        asm volatile("" ::: "memory");
        bf16x8 uvf[4];
#pragma unroll
        for (int t = 0; t < 4; ++t) uvf[t] = *(const LAS bf16x8*)((q < 2 ? UT : VT) + (16 * t + l15) * 32 + 16 * (q & 1));
        if (MODE == 2) {
            const bf16x8 a2f_ = *(const LAS bf16x8*)(A2 + l15 * 80 + 16 * q);
            const int Rt = R0 + dir * l15;
            bf16* yo = Z == 0 ? (bf16*)(ws + WS_PRW) + (size_t)Rt * PLD + RW_Y + h * 64 + 4 * q : (bf16*)(ws + WS_Y1) + (size_t)Rt * 512 + h * 64 + 4 * q;
#pragma unroll
            for (int vt = 0; vt < 4; ++vt) { const f32x4 y = MFMA16(uvf[vt], a2f_, yp[vt]);
                u32x2 w; w.x = cvtpk(y[0], y[1]); w.y = cvtpk(y[2], y[3]); *(u32x2*)(yo + 16 * vt) = w; }
        }
#pragma unroll
        for (int ct = 0; ct < 4; ++ct) { const f32x4 dv = *(const LAS f32x4*)(DV + (16 * ct + 4 * q) * 4);
#pragma unroll
            for (int vt = 0; vt < 4; ++vt) S[vt][ct] = MFMA16(bkf[ct], uvf[vt], S[vt][ct]) * dv; }
        asm volatile("s_waitcnt lgkmcnt(0)" ::: "memory");
    }
    const int l15 = lane0 & 15, q = lane0 >> 4;
    if (MODE == 0 && !ident) { float* o = (float*)(ws + WS_SEGQ) + ((size_t)scan * 32 + seg) * 4096 + l15 * 64 + 4 * q; asm volatile("" : "+v"(o));
#pragma unroll
        for (int vt = 0; vt < 4; ++vt)
#pragma unroll
            for (int ct = 0; ct < 4; ++ct) *(f32x4*)(o + (16 * vt) * 64 + 16 * ct) = S[vt][ct]; }
    if (MODE == 0 && ident) { float* o = segp_ptr(ws, scan, seg) + (4 * q) * 64 + l15;
        asm volatile("" : "+v"(o));
#pragma unroll
        for (int vt = 0; vt < 4; ++vt)
#pragma unroll
            for (int ct = 0; ct < 4; ++ct)
#pragma unroll
                for (int r = 0; r < 4; ++r) o[(16 * ct + r) * 64 + 16 * vt] = S[vt][ct][r]; }
}
__device__ __forceinline__ void rw_pass_a(const Params& p, LAS unsigned char* lds, int wave, int lane) {
    LAS unsigned char* wl = lds + wave * RW_WLDS;
#pragma unroll 1
    for (int it = blockIdx.x * NWAVES + wave; it < 1024 + 992; it += gridDim.x * NWAVES) {
        const bool ident = it >= 1024; const int t = it - 1024; const int scan = ident ? t / 31 : it >> 5, seg = ident ? 1 + t % 31 : it & 31;
        rw_segment<0>(p, wl, lane, scan, seg, ident);
    }
}
__device__ __forceinline__ void rw_pass_c(const Params& p, LAS unsigned char* lds, int wave, int lane, int nblk) {
    LAS unsigned char* wl = lds + wave * RW_WLDS;
#pragma unroll 1
    for (int it = blockIdx.x * NWAVES + wave; it < 1024; it += nblk * NWAVES) rw_segment<2>(p, wl, lane, it >> 5, 1 + (it & 31), false);
}
__device__ __forceinline__ void rw_pass_b(const Params& p, int wave, int lane) {
    const int l15 = lane & 15, q = lane >> 4;
    for (int it = blockIdx.x * NWAVES + wave; it < 128; it += gridDim.x * NWAVES) {
        const int scan = it >> 2, vt = it & 3;
        float* qb = (float*)(p.ws + WS_SEGQ) + (size_t)scan * 32 * 4096 + (16 * vt + l15) * 64 + 4 * q;
        f32x4 S[4];
#pragma unroll
        for (int ct = 0; ct < 4; ++ct) S[ct] = *(const f32x4*)(qb + 16 * ct);
        f32x4 pa[4][2], pb[4][2];
#define RWB_LOADP(m_) do { const float* pt_ = segp_ptr(p.ws, scan, (m_)); _Pragma("unroll") for (int ct = 0; ct < 4; ++ct) _Pragma("unroll") for (int ks = 0; ks < 2; ++ks) { \
            const float* pr_ = pt_ + (16 * ct + l15) * 64 + 32 * ks + 4 * q; pa[ct][ks] = *(const f32x4*)pr_; pb[ct][ks] = *(const f32x4*)(pr_ + 16); } } while (0)
        RWB_LOADP(1);
#pragma unroll 1
        for (int m = 1; m < 32; ++m) {
            bf16x8 shi[2], slo[2];
#pragma unroll
            for (int ks = 0; ks < 2; ++ks) { const f32x4 a = S[2 * ks], bq = S[2 * ks + 1]; shi[ks] = pack8(a, bq);
                const u32x4 hw = __builtin_bit_cast(u32x4, shi[ks]);
                const f32x4 ah = {bflo(hw.x), bfhi(hw.x), bflo(hw.y), bfhi(hw.y)}, bh = {bflo(hw.z), bfhi(hw.z), bflo(hw.w), bfhi(hw.w)};
                slo[ks] = pack8(a - ah, bq - bh); }
            bf16x8 phi[4][2], plo[4][2];
#pragma unroll
            for (int ct = 0; ct < 4; ++ct)
#pragma unroll
                for (int ks = 0; ks < 2; ++ks) { const f32x4 a = pa[ct][ks], bq = pb[ct][ks]; phi[ct][ks] = pack8(a, bq); const u32x4 hw = __builtin_bit_cast(u32x4, phi[ct][ks]);
                    const f32x4 ah = {bflo(hw.x), bfhi(hw.x), bflo(hw.y), bfhi(hw.y)}, bh = {bflo(hw.z), bfhi(hw.z), bflo(hw.w), bfhi(hw.w)};
                    plo[ct][ks] = pack8(a - ah, bq - bh); }
            f32x4 N[4];
#pragma unroll
            for (int ct = 0; ct < 4; ++ct) N[ct] = *(const f32x4*)(qb + (size_t)m * 4096 + 16 * ct);
            if (m < 31) RWB_LOADP(m + 1);
#pragma unroll
            for (int ct = 0; ct < 4; ++ct) { f32x4 acc = N[ct];
#pragma unroll
                for (int ks = 0; ks < 2; ++ks) { acc = MFMA16(phi[ct][ks], shi[ks], acc); acc = MFMA16(plo[ct][ks], shi[ks], acc); acc = MFMA16(phi[ct][ks], slo[ks], acc); }
                N[ct] = acc; }
#pragma unroll
            for (int ct = 0; ct < 4; ++ct) { S[ct] = N[ct]; *(f32x4*)(qb + (size_t)m * 4096 + 16 * ct) = N[ct]; }
        }
#undef RWB_LOADP
    }
}
template <class F>
__device__ __forceinline__ void small_gemm(const bf16* A, int lda, const bf16* Bt, int K, int ntn, int ntiles, int wave, int lane, F f) {
    const int l15 = lane & 15, q = lane >> 4;
    for (int tile = blockIdx.x; tile < ntiles; tile += gridDim.x) {
        const int tm = tile / ntn, tn = tile % ntn, row0 = tm * 64 + 16 * (wave & 3), col0 = tn * 32 + 16 * (wave >> 2);
        const bf16* ap = A + (size_t)(row0 + l15) * lda + 8 * q; const bf16* bp = Bt + (size_t)(col0 + l15) * K + 8 * q;
        f32x4 acc0 = {0.f, 0.f, 0.f, 0.f}, acc1 = acc0;
#pragma unroll 4
        for (int ks = 0; ks < K / 32; ks += 2) { acc0 = MFMA16(ld8(bp + 32 * ks), ld8(ap + 32 * ks), acc0); acc1 = MFMA16(ld8(bp + 32 * ks + 32), ld8(ap + 32 * ks + 32), acc1); }
        f(row0 + l15, col0 + 4 * q, acc0 + acc1);
    }
}
struct CtxDownEpi { const float* xin; float* out; const float* gate; float sc;
    __device__ __forceinline__ void operator()(int row, int col, f32x4 acc) const { const size_t o = (size_t)row * DM + col; *(f32x4*)(out + o) = *(const f32x4*)(xin + o) + *(const f32x4*)(gate + col) * sc * acc; } };
__device__ __forceinline__ void p0_lora_frags(const Params& p) {
    for (int idx = blockIdx.x * NTHR + threadIdx.x; idx < 2 * 4096; idx += gridDim.x * NTHR) {
        const int which = idx >> 12, t = idx & 4095, lane = t & 63, ct = (t >> 6) & 3, h = (t >> 8) & 7, z = t >> 11, l15 = lane & 15, q = lane >> 4;
        const float* W = which ? p.in[21] : p.in[18]; float v[8];
#pragma unroll
        for (int e = 0; e < 8; ++e) v[e] = W[(size_t)(z * 32 + 8 * q + e) * 512 + h * 64 + 16 * ct + l15];
        u32x4 w; w.x = pk2(v[0], v[1]); w.y = pk2(v[2], v[3]); w.z = pk2(v[4], v[5]); w.w = pk2(v[6], v[7]);
        *(u32x4*)(p.ws + (which ? WS_A2P : WS_W2P) + (size_t)t * 16) = w;
    }
}

constexpr size_t WS_G2P = 8 * MiB, WS_A2P0 = 8 * MiB + 96 * 1024;
__device__ __forceinline__ void p0_g2_frags(const Params& p) {
    for (int idx = blockIdx.x * NTHR + threadIdx.x; idx < 6144 + 2048; idx += gridDim.x * NTHR) {
        const bool isa = idx >= 6144; const int t = isa ? idx - 6144 : idx, lane = t & 63, l15 = lane & 15, q = lane >> 4;
        const int ct = isa ? t >> 6 : (t >> 6) / 3, ks = isa ? 0 : (t >> 6) % 3;
        const float* W = isa ? p.in[21] : p.in[23]; float v[8];
#pragma unroll
        for (int e = 0; e < 8; ++e) v[e] = W[(size_t)(32 * ks + 8 * q + e) * 512 + 16 * ct + l15];
        u32x4 w; w.x = pk2(v[0], v[1]); w.y = pk2(v[2], v[3]); w.z = pk2(v[4], v[5]); w.w = pk2(v[6], v[7]);
        *(u32x4*)(p.ws + (isa ? WS_A2P0 : WS_G2P) + (size_t)t * 16) = w;
    }
}
__device__ __forceinline__ void rwkv_readout(const Params& p, LAS unsigned char* lds, int wave, int lane) {
    LAS bf16x8* g2s = (LAS bf16x8*)lds; LAS bf16x8* a2s = g2s + 6144;
    { const u32x4* src = (const u32x4*)(p.ws + WS_G2P); LAS u32x4* dst = (LAS u32x4*)lds;
      for (int i = threadIdx.x; i < 8192; i += NTHR) dst[i] = src[i]; }
    __syncthreads();
    bf16* prw = (bf16*)(p.ws + WS_PRW); const bf16* Y1 = (const bf16*)(p.ws + WS_Y1);
    const float* HA = (const float*)(p.ws + WS_HA); const float* HG = (const float*)(p.ws + WS_HG);
    const int l15 = lane & 15, q = lane >> 4;
    if (wave < 4)
#pragma unroll 1
    for (int it = blockIdx.x * 4 + wave; it < ML / 16; it += gridDim.x * 4) {
        const int R = 16 * it + l15; const bool hp = has_prev(R), hn = has_next(R);
        bf16x8 hgf[3];
#pragma unroll
        for (int ks = 0; ks < 3; ++ks) { const float* hp_ = HG + (size_t)R * 96 + 32 * ks + 8 * q; hgf[ks] = pack8(*(const f32x4*)hp_, *(const f32x4*)(hp_ + 4)); }
        const float* hap = HA + (size_t)R * 32 + 8 * q; const bf16x8 haf = pack8(*(const f32x4*)hap, *(const f32x4*)(hap + 4));
        bf16* row = prw + (size_t)R * PLD;
#pragma unroll 1
        for (int h = 0; h < 8; ++h) {
            f32x4 g[4], ap[4], yv[4], rv[4], kv[4], vv[4];
#pragma unroll
            for (int t = 0; t < 4; ++t) { const int ct = 4 * h + t; f32x4 a = {0.f, 0.f, 0.f, 0.f};
#pragma unroll
                for (int ks = 0; ks < 3; ++ks) a = MFMA16(g2s[(ct * 3 + ks) * 64 + lane], hgf[ks], a);
                g[t] = a; const f32x4 z4 = {0.f, 0.f, 0.f, 0.f}; ap[t] = MFMA16(a2s[ct * 64 + lane], haf, z4); }
            float s = 0.f;
#pragma unroll
            for (int t = 0; t < 4; ++t) { const int c0 = h * 64 + 16 * t + 4 * q;
                const u32x2 ya = *(const u32x2*)(row + RW_Y + c0), yb = *(const u32x2*)(Y1 + (size_t)R * 512 + c0);
                yv[t] = (f32x4){bflo(ya.x) + bflo(yb.x), bfhi(ya.x) + bfhi(yb.x), bflo(ya.y) + bflo(yb.y), bfhi(ya.y) + bfhi(yb.y)};
                s += (yv[t][0] + yv[t][1]) + (yv[t][2] + yv[t][3]);
#pragma unroll
                for (int tns = 0; tns < 3; ++tns) {
                    const u32x2 cc = *(const u32x2*)(row + 512 * tns + c0); u32x2 pp = {0u, 0u}, nn = {0u, 0u};
                    if (hp) pp = *(const u32x2*)(row - PLD + 512 * tns + c0); if (hn) nn = *(const u32x2*)(row + PLD + 512 * tns + c0);
                    const f32x4 cv = {bflo(cc.x), bfhi(cc.x), bflo(cc.y), bfhi(cc.y)}, pv = {bflo(pp.x), bfhi(pp.x), bflo(pp.y), bfhi(pp.y)}, nv = {bflo(nn.x), bfhi(nn.x), bflo(nn.y), bfhi(nn.y)};
                    const f32x4 mu = *(const f32x4*)(p.in[14] + 512 * tns + c0); const f32x4 o = cv + mu * ((pv + nv) * 0.5f - cv);
                    if (tns == 0) rv[t] = o; else if (tns == 1) kv[t] = o; else vv[t] = o; }
            }
            s += __shfl_xor(s, 16); s += __shfl_xor(s, 32);
            const float mu = s * (1.0f / 64.0f); float sq = 0.f, bs = 0.f;
#pragma unroll
            for (int t = 0; t < 4; ++t) { const int c0 = h * 64 + 16 * t + 4 * q; yv[t] = yv[t] - mu; sq += (yv[t][0] * yv[t][0] + yv[t][1] * yv[t][1]) + (yv[t][2] * yv[t][2] + yv[t][3] * yv[t][3]);
                const f32x4 a0 = *(const f32x4*)(p.in[19] + c0), ka = *(const f32x4*)(p.in[25] + c0), rk = *(const f32x4*)(p.in[26] + c0);
#pragma unroll
                for (int r = 0; r < 4; ++r) { const float asig = sigmoidf_(a0[r] + ap[t][r]); bs += rv[t][r] * (kv[t][r] * (1.0f + (asig - 1.0f) * ka[r])) * rk[r]; } }
            sq += __shfl_xor(sq, 16); sq += __shfl_xor(sq, 32); bs += __shfl_xor(bs, 16); bs += __shfl_xor(bs, 32);
            const float rstd = 1.0f / sqrtf(sq * (1.0f / 64.0f) + 64e-5f);
#pragma unroll
            for (int t = 0; t < 4; ++t) { const int c0 = h * 64 + 16 * t + 4 * q; const f32x4 lw = *(const f32x4*)(p.in[27] + c0), lb = *(const f32x4*)(p.in[28] + c0);
                const f32x4 o = (yv[t] * rstd * lw + lb + vv[t] * bs) * g[t];
                u32x2 w; w.x = cvtpk(o[0], o[1]); w.y = cvtpk(o[2], o[3]); *(u32x2*)(row + RW_Y + c0) = w; }
        }
    }
}

constexpr int LDS_BYTES = 147456 + 64;
constexpr int LDS_BARW = 147456;
constexpr int NPHASE = 17;
__global__ void __launch_bounds__(NTHR, 2) fwd_megakernel(Params p) {
    extern __shared__ __attribute__((aligned(16))) unsigned char lds_raw[];
    LAS unsigned char* lds = (LAS unsigned char*)lds_raw;
    cg::grid_group grid = cg::this_grid();
    const int tid = threadIdx.x, lane = tid & 63, wave = __builtin_amdgcn_readfirstlane(tid >> 6);
    unsigned char* ws = p.ws;
    const float* x = p.in[0]; const float* ctx = p.in[2];
    float* Hl = p.out; float* Hc = (float*)(ws + WS_HC);
    const float* modv = (const float*)(ws + WS_MODV);
    bf16* U = (bf16*)(ws + WS_U); bf16* ACT = (bf16*)(ws + WS_ACT); bf16* PRET = (bf16*)(ws + WS_PRET); bf16* PRW = (bf16*)(ws + WS_PRW);
    const int lo = p.ph_lo, hi = p.ph_hi, G = gridDim.x, bx = blockIdx.x;
#define IN(k) (lo <= (k) && (k) < hi)
#define SEAM(k) do { if (IN(k) && IN((k) + 1)) { xcd_barrier(bar); } } while (0)
    if (tid < 16) ((LAS unsigned*)(lds + LDS_BARW))[tid] = 0u;
    __syncthreads();
    if (p.ph_hi < 0) grid.sync();
    const XcdBarrier bar = xcd_barrier_post((unsigned*)(ws + WS_BAR), (volatile LAS unsigned*)(lds + LDS_BARW));

    if (IN(0)) { p0_modv(p, lds); p0_lora_frags(p); p0_g2_frags(p); p0_weights(p, lds, wave, lane, 0, 18); } SEAM(0);
    if (IN(1)) norm_rows(x, ctx, p.in[6], modv, 0 * DM, 1 * DM, U, MT, wave, lane); SEAM(1);
    if (IN(2)) { pg8::Gemm g{U, (const bf16*)(ws + WS_GU1), MT, 2 * DFF, DM, DM}; pg8::StaticOrder S; S.init(MT, 2 * DFF, G, bx); EpiSwiGLU E{ACT, DFF};
        pg8::gemm_phase<EpiSwiGLU, pg8::StaticOrder, true, true>(lds, g, S, E); } SEAM(2);
    if (IN(3)) {
        small_gemm(ACT + (size_t)ML * DFF, DFF, (const bf16*)(ws + WS_D1), DFF, DM / 32, (MC / 64) * (DM / 32), wave, lane, CtxDownEpi{ctx, Hc, modv + 2 * NMODV + 2 * DM, 0.5f});
        pg8::Gemm g{ACT, (const bf16*)(ws + WS_D1), ML, DM, DFF, DFF}; pg8::StaticOrder S; S.init(ML, DM, G, bx); EpiResid E{x, ctx, Hl, Hc, modv, 2 * DM, 0.5f};
        pg8::gemm_phase<EpiResid, pg8::StaticOrder, false, true>(lds, g, S, E); } SEAM(3);
    if (IN(4)) norm_rows(Hl, Hc, p.in[10], modv, 3 * DM, 4 * DM, U, MT, wave, lane); SEAM(4);
    if (IN(5)) { pg8::Gemm g{U, (const bf16*)(ws + WS_WIN), MT, 4096, DM, DM}; pg8::StaticOrder S; S.init(MT, 4096, G, bx); EpiB<0, true> E{PRET, PRW, nullptr, PLD};
        pg8::gemm_phase<EpiB<0, true>, pg8::StaticOrder, true, true>(lds, g, S, E); } SEAM(5);
    if (IN(6)) p6_token_prep(p, wave, lane); SEAM(6);
    if (IN(7)) { rw_pass_a(p, lds, wave, lane); __syncthreads(); ret_kv_local(p, lds, wave, lane); } SEAM(7);
    if (IN(8)) { rw_pass_b(p, wave, lane); ret_scan(p); } SEAM(8);
    if (IN(9)) { const int nc = G / 2; if (bx < nc) rw_pass_c(p, lds, wave, lane, nc); else ret_out(p, lds, wave, lane, nc, G - nc); } SEAM(9);
    if (IN(10)) { rwkv_readout(p, lds, wave, lane); norm_rows(Hl, Hc, p.in[10], modv, 3 * DM, 4 * DM, U, ML, wave, lane); __syncthreads(); p0_weights(p, lds, wave, lane, 18, NTRJOB); } SEAM(10);
    if (IN(11)) {
        pg8::StaticOrder S; S.init(ML, DM, G, bx);
        { pg8::Gemm g{PRET, (const bf16*)(ws + WS_RO), ML, DM, 512, PLD}; EpiB<0, false> E{PRET + 1024, nullptr, nullptr, PLD}; pg8::gemm_phase<EpiB<0, false>, pg8::StaticOrder, false, true>(lds, g, S, E); }
        { pg8::Gemm g{U, (const bf16*)(ws + WS_WG), ML, DM, DM, DM}; EpiB<1, false> E{PRET + 1024, nullptr, nullptr, PLD}; pg8::gemm_phase<EpiB<1, false>, pg8::StaticOrder, false, true>(lds, g, S, E); }
        { pg8::Gemm g{PRW + RW_Y, (const bf16*)(ws + WS_RWO), ML, DM, 512, PLD}; EpiB<0, false> E{PRW, nullptr, nullptr, PLD}; pg8::gemm_phase<EpiB<0, false>, pg8::StaticOrder, false, true>(lds, g, S, E); }
        { pg8::Gemm g{U, (const bf16*)(ws + WS_WG) + (size_t)DM * DM, ML, DM, DM, DM}; EpiB<2, false> E{PRET + 1024, nullptr, PRW, PLD}; pg8::gemm_phase<EpiB<2, false>, pg8::StaticOrder, false, true>(lds, g, S, E); }
    } SEAM(11);
    if (IN(12)) { pg8::Gemm g{PRET + 1024, (const bf16*)(ws + WS_WOUT), ML, DM, DM, PLD}; pg8::StaticOrder S; S.init(ML, DM, G, bx); EpiResid E{Hl, Hc, Hl, Hc, modv, 5 * DM, 1.0f};
        pg8::gemm_phase<EpiResid, pg8::StaticOrder, false, true>(lds, g, S, E); } SEAM(12);
    if (IN(13)) norm_rows(Hl, Hc, p.in[31], modv, 6 * DM, 7 * DM, U, ML, wave, lane); SEAM(13);
    if (IN(14)) { pg8::Gemm g{U, (const bf16*)(ws + WS_GU2), ML, 2 * DFF, DM, DM}; pg8::StaticOrder S; S.init(ML, 2 * DFF, G, bx); EpiSwiGLU E{ACT, DFF};
        pg8::gemm_phase<EpiSwiGLU, pg8::StaticOrder, true, true>(lds, g, S, E); } SEAM(14);
    if (IN(15)) { pg8::Gemm g{ACT, (const bf16*)(ws + WS_D2), ML, DM, DFF, DFF}; pg8::StaticOrder S; S.init(ML, DM, G, bx); EpiResid E{Hl, Hc, Hl, Hc, modv, 8 * DM, 0.5f};
        pg8::gemm_phase<EpiResid, pg8::StaticOrder, false, true>(lds, g, S, E); } SEAM(15);
    if (IN(16)) {
        const int gw = bx * NWAVES + wave, NGW = G * NWAVES; const float* gf = p.in[35];
        for (int R = gw; R < ML; R += NGW) { float* xr = Hl + (size_t)R * DM + 4 * lane; f32x4 v[4]; float s = 0.f;
#pragma unroll
            for (int j = 0; j < 4; ++j) { v[j] = *(const f32x4*)(xr + 256 * j); s += (v[j].x * v[j].x + v[j].y * v[j].y) + (v[j].z * v[j].z + v[j].w * v[j].w); }
            const float rstd = 1.0f / sqrtf(wave_sum(s) * (1.0f / DM) + 1e-6f);
#pragma unroll
            for (int j = 0; j < 4; ++j) *(f32x4*)(xr + 256 * j) = (v[j] * rstd) * *(const f32x4*)(gf + 4 * lane + 256 * j); }
    }
#undef IN
#undef SEAM
}

extern "C" void kernel_launch(void* const* d_in, const int* in_sizes, int n_in, void* d_out, int out_size, void* d_ws, size_t ws_size, hipStream_t stream) {
    static int grid = 0;
    if (grid == 0) {
        if (n_in != 36 || out_size != ML * DM || ws_size < 256 * MiB) { fprintf(stderr, "kernel_launch: unexpected problem (n_in %d out %d ws %zu)\n", n_in, out_size, ws_size); grid = -1; return; }
        int dev = 0, cus = 0, per_cu = 0;
        (void)hipGetDevice(&dev); (void)hipDeviceGetAttribute(&cus, hipDeviceAttributeMultiprocessorCount, dev);
        if (hipFuncSetAttribute((const void*)fwd_megakernel, hipFuncAttributeMaxDynamicSharedMemorySize, LDS_BYTES) != hipSuccess) { fprintf(stderr, "kernel_launch: hipFuncSetAttribute failed\n"); grid = -1; return; }
        if (hipOccupancyMaxActiveBlocksPerMultiprocessor(&per_cu, (const void*)fwd_megakernel, NTHR, LDS_BYTES) != hipSuccess || per_cu < 1) { fprintf(stderr, "kernel_launch: occupancy query says %d\n", per_cu); per_cu = 1; }
        (void)hipGetLastError();
        grid = cus * (per_cu > 1 ? 1 : per_cu);
        fprintf(stderr, "kernel_launch: cus %d per_cu %d grid %d\n", cus, per_cu, grid);
    }
    if (grid < 0) return;
    if (hipMemsetAsync((char*)d_ws + WS_BAR, 0, XCD_BAR_WORDS * 4, stream) != hipSuccess) { fprintf(stderr, "kernel_launch: memset of the barrier words failed\n"); return; }
    Params p{};
    for (int i = 0; i < 36; ++i) p.in[i] = (const float*)d_in[i];
    p.out = (float*)d_out; p.ws = (unsigned char*)d_ws; p.ph_lo = 0; p.ph_hi = NPHASE;
    void* args[] = {&p};
    hipError_t e = hipLaunchCooperativeKernel((const void*)fwd_megakernel, dim3(grid), dim3(NTHR), args, LDS_BYTES, stream);
    if (e != hipSuccess) fprintf(stderr, "kernel_launch: cooperative launch failed: %s (grid %d)\n", hipGetErrorString(e), grid);
}
```
